# Optimizing an MI355X kernel written in HIP

```python
import jax, jax.numpy as jnp
from jax import lax
import numpy as np

D_MODEL = 1024
BATCH = 8
SEQ = 4096
DEPTH = 2

HEAD_DIM = 64
N_HEADS = D_MODEL // HEAD_DIM
N_MOBA = N_HEADS // 4
N_FOX = (N_HEADS - N_MOBA) // 2
N_DIL = N_HEADS - N_MOBA - N_FOX
N_ALIBI = N_MOBA + N_DIL
MOBA_BLOCK = 256
MOBA_TOPK = 3
MOBA_QCHUNK = 32
FOX_QBLOCK = 128
DIL_PAIRS = ((128, 1), (512, 4), (2048, 16))
DIL_BLOCK = 128
D_FF = 4 * D_MODEL
QKV_COLS = 3 * D_MODEL
FOX_GATE_COLS = N_FOX * HEAD_DIM
N_IN_COLS = QKV_COLS + N_FOX + FOX_GATE_COLS
W_MOBA = N_MOBA * HEAD_DIM
W_FOX = N_FOX * HEAD_DIM
ATTN_SCALE = HEAD_DIM ** -0.5
EPS = 1e-6
NEG_INF = -1e30

kernel_name = "hymba_moba_fox_dilated_block"


def rms_norm(x, gain):
    xf = x.astype(jnp.float32)
    y = xf * lax.rsqrt(jnp.mean(xf * xf, axis=-1, keepdims=True) + EPS)
    return (y * gain.astype(jnp.float32)).astype(x.dtype)


def alibi_slopes():
    return jnp.exp2(-8.0 * jnp.arange(1, N_ALIBI + 1, dtype=jnp.float32) / N_ALIBI)


def moba_attention(q, k, v, slopes):
    b, h, s, dh = q.shape
    n_blk = -(-s // MOBA_BLOCK)
    s_pad = n_blk * MOBA_BLOCK
    pad = ((0, 0), (0, 0), (0, s_pad - s), (0, 0))
    q, k, v = jnp.pad(q, pad), jnp.pad(k, pad), jnp.pad(v, pad)
    k_blocks = k.reshape(b, h, n_blk, MOBA_BLOCK, dh)
    v_blocks = v.reshape(b, h, n_blk, MOBA_BLOCK, dh)
    k_mean = jnp.mean(k_blocks.astype(jnp.float32), axis=3)
    gate = jnp.einsum('bhsd,bhnd->bhsn', q.astype(jnp.float32), k_mean)
    q_blk = jnp.arange(s_pad) // MOBA_BLOCK
    past = jnp.arange(n_blk)[None, :] < q_blk[:, None]
    gate = jnp.where(past, gate, NEG_INF)
    top_k = min(MOBA_TOPK, n_blk)
    _, sel_idx = lax.top_k(gate, top_k)
    sel_ok = sel_idx < q_blk[:, None]
    gather = jax.vmap(jax.vmap(lambda blocks, idx: blocks[idx]))
    offs = jnp.arange(MOBA_BLOCK)

    def chunk(c):
        start = c * MOBA_QCHUNK
        qc = lax.dynamic_slice_in_dim(q, start, MOBA_QCHUNK, axis=2)
        idx = lax.dynamic_slice_in_dim(sel_idx, start, MOBA_QCHUNK, axis=2)
        ok = lax.dynamic_slice_in_dim(sel_ok, start, MOBA_QCHUNK, axis=2)
        q_pos = start + jnp.arange(MOBA_QCHUNK)
        k_sel = gather(k_blocks, idx)
        v_sel = gather(v_blocks, idx)
        d_sel = (q_pos[:, None, None] - (idx[..., None] * MOBA_BLOCK + offs)).astype(jnp.float32)
        l_sel = (jnp.einsum('bhqd,bhqnkd->bhqnk', qc, k_sel).astype(jnp.float32) * ATTN_SCALE
                 - slopes[:, None, None, None] * d_sel)
        l_sel = jnp.where(ok[..., None], l_sel, NEG_INF).reshape(b, h, MOBA_QCHUNK, top_k * MOBA_BLOCK)
        own_start = (start // MOBA_BLOCK) * MOBA_BLOCK
        k_own = lax.dynamic_slice_in_dim(k, own_start, MOBA_BLOCK, axis=2)
        v_own = lax.dynamic_slice_in_dim(v, own_start, MOBA_BLOCK, axis=2)
        d_own = q_pos[:, None] - (own_start + offs)[None, :]
        l_own = (jnp.einsum('bhqd,bhkd->bhqk', qc, k_own).astype(jnp.float32) * ATTN_SCALE
                 - slopes[:, None, None] * d_own.astype(jnp.float32))
        l_own = jnp.where(d_own >= 0, l_own, NEG_INF)
        p = jax.nn.softmax(jnp.concatenate([l_sel, l_own], axis=-1), axis=-1).astype(v.dtype)
        p_sel = p[..., :top_k * MOBA_BLOCK].reshape(b, h, MOBA_QCHUNK, top_k, MOBA_BLOCK)
        return (jnp.einsum('bhqnk,bhqnkd->bhqd', p_sel, v_sel)
                + jnp.einsum('bhqk,bhkd->bhqd', p[..., top_k * MOBA_BLOCK:], v_own))

    out = lax.map(chunk, jnp.arange(s_pad // MOBA_QCHUNK))
    return out.transpose(1, 2, 0, 3, 4).reshape(b, h, s_pad, dh)[:, :, :s]


def forgetting_attention(q, k, v, f_logit):
    b, h, s, dh = q.shape
    cum = jnp.cumsum(jax.nn.log_sigmoid(f_logit.astype(jnp.float32)), axis=1).transpose(0, 2, 1)
    k_pos = jnp.arange(s)

    def block(i):
        start = i * FOX_QBLOCK
        qb = lax.dynamic_slice_in_dim(q, start, FOX_QBLOCK, axis=2)
        cb = lax.dynamic_slice_in_dim(cum, start, FOX_QBLOCK, axis=2)
        q_pos = start + jnp.arange(FOX_QBLOCK)
        logits = (jnp.einsum('bhqd,bhkd->bhqk', qb, k).astype(jnp.float32) * ATTN_SCALE
                  + cb[..., None] - cum[:, :, None, :])
        logits = jnp.where(k_pos[None, :] <= q_pos[:, None], logits, NEG_INF)
        p = jax.nn.softmax(logits, axis=-1).astype(v.dtype)
        return jnp.einsum('bhqk,bhkd->bhqd', p, v)

    out = lax.map(block, jnp.arange(s // FOX_QBLOCK))
    return out.transpose(1, 2, 0, 3, 4).reshape(b, h, s, dh)


def dilated_branch(q, k, v, slopes, window, dilation):
    b, h, s, dh = q.shape
    steps = window // dilation
    sub_len = s // dilation
    n_blk = -(-sub_len // DIL_BLOCK)
    sub_pad = n_blk * DIL_BLOCK

    def to_sub(t):
        t = t.reshape(b, h, sub_len, dilation, dh).transpose(0, 1, 3, 2, 4)
        t = jnp.pad(t, ((0, 0), (0, 0), (0, 0), (0, sub_pad - sub_len), (0, 0)))
        return t.reshape(b, h, dilation, n_blk, DIL_BLOCK, dh)

    def band(t):
        prev = jnp.concatenate([jnp.zeros_like(t[:, :, :, :1]), t[:, :, :, :-1]], axis=3)
        return jnp.concatenate([prev, t], axis=4)

    qs = to_sub(q)
    kb, vb = band(to_sub(k)), band(to_sub(v))
    blk = jnp.arange(n_blk)[:, None]
    i_q = blk * DIL_BLOCK + jnp.arange(DIL_BLOCK)[None, :]
    i_k = (blk - 1) * DIL_BLOCK + jnp.arange(2 * DIL_BLOCK)[None, :]
    off = i_q[:, :, None] - i_k[:, None, :]
    allowed = (off >= 0) & (off <= steps) & (i_k[:, None, :] >= 0) & (i_k[:, None, :] < sub_len)
    dist = (off * dilation).astype(jnp.float32)
    logits = (jnp.einsum('bhrnqd,bhrnkd->bhrnqk', qs, kb).astype(jnp.float32) * ATTN_SCALE
              - slopes[:, None, None, None, None] * dist)
    logits = jnp.where(allowed, logits, NEG_INF)
    lse = jax.nn.logsumexp(logits, axis=-1)
    p = jnp.exp(logits - lse[..., None]).astype(v.dtype)
    o = jnp.einsum('bhrnqk,bhrnkd->bhrnqd', p, vb)
    o = o.reshape(b, h, dilation, sub_pad, dh)[:, :, :, :sub_len].transpose(0, 1, 3, 2, 4).reshape(b, h, s, dh)
    lse = lse.reshape(b, h, dilation, sub_pad)[..., :sub_len].transpose(0, 1, 3, 2).reshape(b, h, s)
    return o, lse


def dilated_attention(q, k, v, slopes):
    outs, lses = [], []
    for window, dilation in DIL_PAIRS:
        o, lse = dilated_branch(q, k, v, slopes, window, dilation)
        outs.append(o)
        lses.append(lse)
    w = jax.nn.softmax(jnp.stack(lses, axis=0), axis=0)
    o = jnp.sum(w[..., None] * jnp.stack(outs, axis=0).astype(jnp.float32), axis=0)
    return o.astype(q.dtype)


def to_bsd(o):
    b, h, s, dh = o.shape
    return o.transpose(0, 2, 1, 3).reshape(b, s, h * dh)


def mixer_sublayer(x, norm_g, w_in, b_f, q_gain, k_gain, out_gain, w_out):
    b, s, _ = x.shape
    hn = rms_norm(x, norm_g)
    proj = hn @ w_in
    q = proj[..., :D_MODEL].reshape(b, s, N_HEADS, HEAD_DIM)
    k = proj[..., D_MODEL:2 * D_MODEL].reshape(b, s, N_HEADS, HEAD_DIM)
    v = proj[..., 2 * D_MODEL:QKV_COLS].reshape(b, s, N_HEADS, HEAD_DIM)
    f_logit = proj[..., QKV_COLS:QKV_COLS + N_FOX] + b_f
    g_fox = proj[..., QKV_COLS + N_FOX:]
    q = rms_norm(q, q_gain).transpose(0, 2, 1, 3)
    k = rms_norm(k, k_gain).transpose(0, 2, 1, 3)
    v = v.transpose(0, 2, 1, 3)
    slopes = alibi_slopes()
    a0, a1 = N_MOBA, N_MOBA + N_FOX
    o_moba = moba_attention(q[:, :a0], k[:, :a0], v[:, :a0], slopes[N_DIL:])
    o_fox = forgetting_attention(q[:, a0:a1], k[:, a0:a1], v[:, a0:a1], f_logit)
    o_dil = dilated_attention(q[:, a1:], k[:, a1:], v[:, a1:], slopes[:N_DIL])
    y_moba = rms_norm(to_bsd(o_moba), out_gain[:W_MOBA])
    y_fox = rms_norm(to_bsd(o_fox), out_gain[W_MOBA:W_MOBA + W_FOX]) * jax.nn.sigmoid(g_fox)
    y_dil = rms_norm(to_bsd(o_dil), out_gain[W_MOBA + W_FOX:])
    y = jnp.concatenate([y_moba, y_fox, y_dil], axis=-1) @ w_out
    return x + y


def mlp_sublayer(x, norm_g, w_up, w_down):
    hn = rms_norm(x, norm_g)
    return x + jnp.square(jax.nn.relu(hn @ w_up)) @ w_down


def setup_inputs(seed: int = 0) -> dict:
    key = jax.random.key(seed)
    ks = jax.random.split(key, 11)
    f32 = jnp.float32
    return {
        "x": jax.random.normal(ks[0], (BATCH, SEQ, D_MODEL), f32),
        "attn_norm": 1.0 + 0.02 * jax.random.normal(ks[1], (DEPTH, D_MODEL), f32),
        "w_in": jax.random.normal(ks[2], (DEPTH, D_MODEL, N_IN_COLS), f32) * D_MODEL ** -0.5,
        "b_forget": 2.0 + 0.5 * jax.random.normal(ks[3], (DEPTH, N_FOX), f32),
        "q_gain": 1.0 + 0.02 * jax.random.normal(ks[4], (DEPTH, N_HEADS, HEAD_DIM), f32),
        "k_gain": 1.0 + 0.02 * jax.random.normal(ks[5], (DEPTH, N_HEADS, HEAD_DIM), f32),
        "out_gain": 1.0 + 0.02 * jax.random.normal(ks[6], (DEPTH, D_MODEL), f32),
        "w_out": jax.random.normal(ks[7], (DEPTH, D_MODEL, D_MODEL), f32) * D_MODEL ** -0.5,
        "mlp_norm": 1.0 + 0.02 * jax.random.normal(ks[8], (DEPTH, D_MODEL), f32),
        "w_up": jax.random.normal(ks[9], (DEPTH, D_MODEL, D_FF), f32) * D_MODEL ** -0.5,
        "w_down": jax.random.normal(ks[10], (DEPTH, D_FF, D_MODEL), f32) * D_FF ** -0.5,
    }


def reference(x, attn_norm, w_in, b_forget, q_gain, k_gain, out_gain, w_out, mlp_norm, w_up, w_down):
    for l in range(DEPTH):
        x = mixer_sublayer(x, attn_norm[l], w_in[l], b_forget[l], q_gain[l], k_gain[l],
                           out_gain[l], w_out[l])
        x = mlp_sublayer(x, mlp_norm[l], w_up[l], w_down[l])
    return x
```

```cpp
#include <hip/hip_runtime.h>
#include <cstdio>
#include <cstdint>
namespace pg8 {
#define PG8_LAS __attribute__((address_space(3)))
typedef unsigned short bf16_t;
typedef short bf16x8 __attribute__((ext_vector_type(8)));
typedef float f32x4 __attribute__((ext_vector_type(4)));
typedef unsigned u32x4 __attribute__((ext_vector_type(4)));
constexpr int BM = 256, BK = 64, HALF = 128, HTB = HALF * BK * 2  , STAGE_BYTES = 8 * HTB, NXCD = 8, WGM = 8;

__host__ __device__ __forceinline__ int lds_byte(int r, int c) { const int st = (r >> 4) * 2 + (c >> 5), rr = r & 15, cc = c & 31, ob = rr * 64 + cc * 2; return st * 1024 + (ob ^ (((ob >> 9) & 1) << 5)); }
__host__ __device__ __forceinline__ void stage_rc(int b, int& R, int& C) { const int st = b / 1024, sb = b % 1024, swz = sb ^ (((sb >> 9) & 1) << 5); R = (st >> 1) * 16 + swz / 64; C = (st & 1) * 32 + (swz % 64) / 2; }
__host__ __device__ __forceinline__ int perm32(int rho) { const int n = rho >> 4, i = rho & 15; return 8 * (i >> 2) + 4 * n + (i & 3); }

struct Unit { int pm, pn; };
struct Gemm { const bf16_t* A; const bf16_t* Bt; int M, N, K; };

struct StaticOrder {
    int nM, nN, nwg, G, c;
    __host__ __device__ void init(int M, int N, int G_, int c_) { nM = M / BM; nN = N / BM; nwg = nM * nN; G = G_; c = c_; }
    __host__ __device__ bool next(int i, Unit& u) const {
        const long L = (long)i * G + c; if (L >= nwg) return false;
        int wgid = (int)L; { const int q = nwg / NXCD, r = nwg % NXCD, xcd = wgid % NXCD, off = wgid / NXCD; wgid = (xcd < r ? xcd * (q + 1) : r * (q + 1) + (xcd - r) * q) + off; }
        const int nig = WGM * nN, gid = wgid / nig, fm = gid * WGM, gsz = (nM - fm) < WGM ? (nM - fm) : WGM;
        u.pm = fm + ((wgid % nig) % gsz); u.pn = (wgid % nig) / gsz; return true;
    }
    __device__ __forceinline__ void a_ready(const Unit&) const {}
    __device__ __forceinline__ void done(const Unit&) const {}
};


__device__ __forceinline__ unsigned cvt_pk_bf16(float lo, float hi) { unsigned r; asm volatile("v_cvt_pk_bf16_f32 %0, %1, %2" : "=v"(r) : "v"(lo), "v"(hi)); return r; }
constexpr float RMS_EPS = 1e-6f;
constexpr float QSCALE = 0.125f * 1.4426950408889634f;
constexpr int TAB_OFF = 131072 + 512, TAB_G = 2048;
constexpr size_t EMiB = 1u << 20;
constexpr size_t E_SSQ = 52 * EMiB, E_LS = 54 * EMiB, E_KMP = 55 * EMiB, E_PRM = 56 * EMiB, E_XB = 64 * EMiB, E_Q = 128 * EMiB, E_K = 192 * EMiB, E_V = 256 * EMiB, E_H = 128 * EMiB, E_GF = 384 * EMiB;
__device__ __forceinline__ float row_rstd(const float* ssq, unsigned row) {
    const float* p = ssq + (size_t)(row * 16u);
    const f32x4 a = *(const f32x4*)(p), b = *(const f32x4*)(p + 4), c = *(const f32x4*)(p + 8), d = *(const f32x4*)(p + 12);
    const float s = ((a[0] + a[1]) + (a[2] + a[3])) + ((b[0] + b[1]) + (b[2] + b[3])) + ((c[0] + c[1]) + (c[2] + c[3])) + ((d[0] + d[1]) + (d[2] + d[3]));
    return 1.0f / sqrtf(s * (1.0f / 1024.0f) + RMS_EPS);
}
template <class Sched>
__device__ __forceinline__ void prep_tables(const Sched& S, PG8_LAS float* tab, const unsigned char* ws, const float* qg, const float* kg  , int tid) {
    Unit u;
#pragma unroll 1
    for (int i = 0; i < 8 && S.next(i, u); ++i) {
        if (tid < 256) tab[i * 256 + tid] = row_rstd((const float*)(ws + E_SSQ), (unsigned)(u.pm * BM + tid));
        else if (qg && u.pn < 8) { const int c = tid - 256; tab[TAB_G + i * 256 + c] = (u.pn < 4 ? qg : kg)[(u.pn & 3) * 256 + c]; }
    }
}
#define PG8_PACK8(y0, y1) (u32x4){cvt_pk_bf16((y0)[0], (y0)[1]), cvt_pk_bf16((y0)[2], (y0)[3]), cvt_pk_bf16((y1)[0], (y1)[1]), cvt_pk_bf16((y1)[2], (y1)[3])}
struct EpiIn {
    static constexpr bool PERM = true, AFTER_DRAIN = false;
    unsigned char* ws; const float* bfg; PG8_LAS float* tab;
    __device__ __forceinline__ void operator()(const f32x4 (&acc)[2][2][4][2], const Unit& u, int ui, int wr, int wc, int fr, int fq) const {
        const int pn = u.pn; const unsigned row0 = (unsigned)(u.pm * BM + wr * 64 + fr);
        const PG8_LAS float* rsp = tab + ui * 256 + wr * 64 + fr;
        if (pn < 8) {
            const PG8_LAS float* gp = tab + TAB_G + ui * 256 + 64 * wc + 8 * fq;
            f32x4 g[2][2];
#pragma unroll
            for (int bj = 0; bj < 2; ++bj)
#pragma unroll
                for (int n = 0; n < 2; ++n) g[bj][n] = *(const PG8_LAS f32x4*)(gp + 32 * bj + 4 * n);
            unsigned char* dst = ws + (pn < 4 ? E_Q : E_K) + (size_t)(unsigned)(((pn & 3) * 256 + wc * 64 + 8 * fq) * 2);
            const float post = pn < 4 ? QSCALE : 1.0f;
            f32x4 ks[2][2];
#pragma unroll
            for (int bj = 0; bj < 2; ++bj)
#pragma unroll
                for (int n = 0; n < 2; ++n) ks[bj][n] = (f32x4){0.f, 0.f, 0.f, 0.f};
#pragma unroll
            for (int ai = 0; ai < 2; ++ai)
#pragma unroll
                for (int m = 0; m < 4; ++m) {
                    const unsigned row = row0 + ai * HALF + m * 16; const float rs = rsp[ai * HALF + m * 16];
                    f32x4 v[2][2]; float ss = 0.f;
#pragma unroll
                    for (int bj = 0; bj < 2; ++bj)
#pragma unroll
                        for (int n = 0; n < 2; ++n) { v[bj][n] = acc[ai][bj][m][n] * rs; const f32x4 x = v[bj][n]; ss += (x[0] * x[0] + x[1] * x[1]) + (x[2] * x[2] + x[3] * x[3]); }
                    ss += __shfl_xor(ss, 16); ss += __shfl_xor(ss, 32);
                    const float r2 = 1.0f / sqrtf(ss * (1.0f / 64.0f) + RMS_EPS);
#pragma unroll
                    for (int bj = 0; bj < 2; ++bj) {
                        const f32x4 y0 = v[bj][0] * r2 * g[bj][0], y1 = v[bj][1] * r2 * g[bj][1];
                        ks[bj][0] += y0; ks[bj][1] += y1;
                        const f32x4 z0 = y0 * post, z1 = y1 * post;
                        *(u32x4*)(dst + (size_t)(row * 2048u + 64u * bj)) = PG8_PACK8(z0, z1);
                    }
                }
            if (pn == 4) {
#pragma unroll
                for (int bj = 0; bj < 2; ++bj)
#pragma unroll
                    for (int n = 0; n < 2; ++n)
#pragma unroll
                        for (int e = 0; e < 4; ++e) { float s = ks[bj][n][e]; s += __shfl_xor(s, 1); s += __shfl_xor(s, 2); s += __shfl_xor(s, 4); s += __shfl_xor(s, 8); ks[bj][n][e] = s; }
                if (fr == 0) { float* kp = (float*)(ws + E_KMP) + (size_t)(unsigned)((((u.pm * 4 + wc) * 2 + wr) * 64 + 8 * fq));
#pragma unroll
                    for (int bj = 0; bj < 2; ++bj)
#pragma unroll
                        for (int n = 0; n < 2; ++n) *(f32x4*)(kp + 32 * bj + 4 * n) = ks[bj][n]; }
            }
        } else if (pn < 12) {
            unsigned char* dst = ws + E_V + (size_t)(unsigned)(((pn & 3) * 256 + wc * 64 + 8 * fq) * 2);
#pragma unroll
            for (int ai = 0; ai < 2; ++ai)
#pragma unroll
                for (int m = 0; m < 4; ++m) {
                    const unsigned row = row0 + ai * HALF + m * 16; const float rs = rsp[ai * HALF + m * 16];
#pragma unroll
                    for (int bj = 0; bj < 2; ++bj) { const f32x4 y0 = acc[ai][bj][m][0] * rs, y1 = acc[ai][bj][m][1] * rs;
                        *(u32x4*)(dst + (size_t)(row * 2048u + 64u * bj)) = PG8_PACK8(y0, y1); }
                }
        } else {
#pragma unroll
            for (int ai = 0; ai < 2; ++ai)
#pragma unroll
                for (int m = 0; m < 4; ++m) {
                    const unsigned row = row0 + ai * HALF + m * 16; const float rs = rsp[ai * HALF + m * 16];
#pragma unroll
                    for (int bj = 0; bj < 2; ++bj) {
                        const f32x4 y0 = acc[ai][bj][m][0] * rs, y1 = acc[ai][bj][m][1] * rs;
                        if (pn == 12 || bj == 0) {
                            const unsigned gcol = (unsigned)((pn == 12 ? 0 : 256) + 128 * bj + 32 * wc + 8 * fq);
                            f32x4 s0, s1;
#pragma unroll
                            for (int e = 0; e < 4; ++e) { s0[e] = 1.0f / (1.0f + __expf(-y0[e])); s1[e] = 1.0f / (1.0f + __expf(-y1[e])); }
                            *(u32x4*)(ws + E_GF + (size_t)((row * 384u + gcol) * 2u)) = PG8_PACK8(s0, s1);
                        } else if (wc == 0 && fq == 0) {
                            float z[6] = {y0[0], y0[1], y0[2], y0[3], y1[0], y1[1]};
#pragma unroll
                            for (int e = 0; e < 6; ++e) { const float zz = z[e] + bfg[e]; z[e] = fminf(zz, 0.f) - log1pf(__expf(-fabsf(zz))); }
                            float* lp = (float*)(ws + E_LS) + (size_t)(row * 8u);
                            *(f32x4*)(lp) = (f32x4){z[0], z[1], z[2], z[3]}; *(f32x4*)(lp + 4) = (f32x4){z[4], z[5], 0.f, 0.f};
                        }
                    }
                }
        }
    }
};
struct EpiRes {
    static constexpr bool PERM = true, AFTER_DRAIN = false;
    const float* res; float* out; unsigned char* ws;
    __device__ __forceinline__ void operator()(const f32x4 (&acc)[2][2][4][2], const Unit& u, int ui, int wr, int wc, int fr, int fq) const {
        const unsigned row0 = (unsigned)(u.pm * BM + wr * 64 + fr), col0 = (unsigned)(u.pn * BM + wc * 32 + 8 * fq);
#pragma unroll
        for (int ai = 0; ai < 2; ++ai)
#pragma unroll
            for (int m = 0; m < 4; ++m) {
                const unsigned row = row0 + ai * HALF + m * 16; float ss = 0.f;
#pragma unroll
                for (int bj = 0; bj < 2; ++bj) {
                    const unsigned off = row * 1024u + col0 + bj * HALF;
                    const f32x4 o0 = *(const f32x4*)(res + (size_t)off) + acc[ai][bj][m][0], o1 = *(const f32x4*)(res + (size_t)off + 4) + acc[ai][bj][m][1];
                    *(f32x4*)(out + (size_t)off) = o0; *(f32x4*)(out + (size_t)off + 4) = o1;
                    ss += ((o0[0] * o0[0] + o0[1] * o0[1]) + (o0[2] * o0[2] + o0[3] * o0[3])) + ((o1[0] * o1[0] + o1[1] * o1[1]) + (o1[2] * o1[2] + o1[3] * o1[3]));
                    *(u32x4*)(ws + E_XB + (size_t)(off * 2u)) = PG8_PACK8(o0, o1);
                }
                ss += __shfl_xor(ss, 16); ss += __shfl_xor(ss, 32);
                if (fq == 0) ((float*)(ws + E_SSQ))[(size_t)(row * 16u + (unsigned)(u.pn * 4 + wc))] = ss;
                if (m & 1) asm volatile("" ::: "memory");
            }
    }
};
struct EpiUp {
    static constexpr bool PERM = true, AFTER_DRAIN = false;
    unsigned char* ws; PG8_LAS float* tab;
    __device__ __forceinline__ void operator()(const f32x4 (&acc)[2][2][4][2], const Unit& u, int ui, int wr, int wc, int fr, int fq) const {
        const unsigned row0 = (unsigned)(u.pm * BM + wr * 64 + fr), col0 = (unsigned)(u.pn * BM + wc * 32 + 8 * fq);
        const PG8_LAS float* rsp = tab + ui * 256 + wr * 64 + fr;
#pragma unroll
        for (int ai = 0; ai < 2; ++ai)
#pragma unroll
            for (int m = 0; m < 4; ++m) {
                const unsigned row = row0 + ai * HALF + m * 16; const float rs = rsp[ai * HALF + m * 16];
#pragma unroll
                for (int bj = 0; bj < 2; ++bj) {
                    f32x4 y0 = acc[ai][bj][m][0] * rs, y1 = acc[ai][bj][m][1] * rs;
#pragma unroll
                    for (int e = 0; e < 4; ++e) { const float a = fmaxf(y0[e], 0.f), b = fmaxf(y1[e], 0.f); y0[e] = a * a; y1[e] = b * b; }
                    *(u32x4*)(ws + E_H + (size_t)((row * 4096u + col0 + bj * HALF) * 2u)) = PG8_PACK8(y0, y1);
                }
            }
    }
};

template <class Epi, class Sched, bool ALIGN_EPI = false, bool SP2 = false>
__device__ __forceinline__ void gemm_phase(PG8_LAS unsigned char* lds, const Gemm g, const Sched& S, const Epi& E, const int tid) {
    const int wid = __builtin_amdgcn_readfirstlane(tid >> 6), lane = tid & 63, wr = wid >> 2, wc = wid & 3, fr = lane & 15, fq = lane >> 4;
    const int K = g.K, nt = K / BK;
    unsigned voffA[2], voffB[2];
#pragma unroll
    for (int i = 0; i < 2; ++i) { int R, C; stage_rc(tid * 16 + i * 8192, R, C); const int Rb = Epi::PERM ? ((R & ~31) + perm32(R & 31)) : R;
        voffA[i] = (unsigned)(R * K + C) * 2u; voffB[i] = (unsigned)(Rb * K + C) * 2u; }
    const size_t kstep = (size_t)(BK * 2);
    const size_t hstep = (size_t)HALF * K * 2;
    const size_t tstep = 2 * hstep;
    const unsigned ldsw = (unsigned)wid * 1024u;
    const int aoff = lds_byte(wr * 64 + fr, fq * 8), boff = lds_byte(wc * 32 + fr, fq * 8);
#define PG8_SA(b, h) (((b) * 2 + (h)) * HTB)
#define PG8_SB(b, h) ((4 + (b) * 2 + (h)) * HTB)
#define PG8_STAGE(bufoff, gbase, voff) do { _Pragma("unroll") for (int _i = 0; _i < 2; ++_i) \
        __builtin_amdgcn_global_load_lds((const unsigned*)((const char*)(gbase) + (voff)[_i]), (PG8_LAS unsigned*)(lds + (bufoff) + ldsw + _i * 8192), 16, 0, 0); } while (0)
#define PG8_LDA(dst, b, h) do { _Pragma("unroll") for (int m = 0; m < 4; ++m) _Pragma("unroll") for (int k = 0; k < 2; ++k) dst[m][k] = *(const PG8_LAS bf16x8*)(lds + PG8_SA(b, h) + aoff + m * 2048 + k * 1024); } while (0)
#define PG8_LDB(dst, b, h) do { _Pragma("unroll") for (int n = 0; n < 2; ++n) _Pragma("unroll") for (int k = 0; k < 2; ++k) dst[n][k] = *(const PG8_LAS bf16x8*)(lds + PG8_SB(b, h) + boff + n * 2048 + k * 1024); } while (0)
#define PG8_MMA(ai, bj, At, Bt) do { __builtin_amdgcn_s_setprio(1); _Pragma("unroll") for (int m = 0; m < 4; ++m) _Pragma("unroll") for (int n = 0; n < 2; ++n) _Pragma("unroll") for (int k = 0; k < 2; ++k) \
        acc[ai][bj][m][n] = __builtin_amdgcn_mfma_f32_16x16x32_bf16(Bt[n][k], At[m][k], acc[ai][bj][m][n], 0, 0, 0); __builtin_amdgcn_s_setprio(0); } while (0)
#define PG8_WAIT_V(n) asm volatile("s_waitcnt vmcnt(" #n ")" ::: "memory")
#define PG8_WAIT_L(n) asm volatile("s_waitcnt lgkmcnt(" #n ")" ::: "memory")
#define PG8_BAR __builtin_amdgcn_s_barrier()
#define PG8_SCHED __builtin_amdgcn_sched_barrier(0)
    Unit cur, nxt; int ui = 0;
    if (!S.next(0, cur)) return;
    f32x4 acc[2][2][4][2];
#pragma unroll
    for (int a = 0; a < 2; ++a)
#pragma unroll
        for (int b = 0; b < 2; ++b)
#pragma unroll
            for (int m = 0; m < 4; ++m)
#pragma unroll
                for (int n = 0; n < 2; ++n) acc[a][b][m][n] = (f32x4){0.f, 0.f, 0.f, 0.f};
    bf16x8 At[4][2], B0[2][2], B1[2][2];
    const char* cA = (const char*)g.A + (size_t)cur.pm * tstep; const char* cB = (const char*)g.Bt + (size_t)cur.pn * tstep;
    S.a_ready(cur);
    if constexpr (SP2) {
        PG8_STAGE(PG8_SB(0, 0), cB, voffB); PG8_STAGE(PG8_SB(0, 1), cB + hstep, voffB); PG8_STAGE(PG8_SA(0, 0), cA, voffA); PG8_STAGE(PG8_SA(0, 1), cA + hstep, voffA);
        if (wr == 1) PG8_BAR;
        PG8_WAIT_V(2); PG8_BAR;
        PG8_STAGE(PG8_SB(1, 0), cB + kstep, voffB); PG8_STAGE(PG8_SA(1, 0), cA + kstep, voffA); PG8_STAGE(PG8_SB(1, 1), cB + hstep + kstep, voffB);
        PG8_WAIT_V(6); PG8_BAR;
    } else {
        PG8_STAGE(PG8_SB(0, 0), cB, voffB); PG8_STAGE(PG8_SA(0, 0), cA, voffA); PG8_STAGE(PG8_SB(0, 1), cB + hstep, voffB); PG8_STAGE(PG8_SA(0, 1), cA + hstep, voffA);
        if (wr == 1) PG8_BAR;
        PG8_WAIT_V(4); PG8_BAR;
        PG8_STAGE(PG8_SB(1, 0), cB + kstep, voffB); PG8_STAGE(PG8_SA(1, 0), cA + kstep, voffA); PG8_STAGE(PG8_SB(1, 1), cB + hstep + kstep, voffB);
        PG8_WAIT_V(6); PG8_BAR;
    }
    for (;;) {
        const bool has_next = S.next(ui + 1, nxt);
        const char* nA = has_next ? (const char*)g.A + (size_t)nxt.pm * tstep : cA; const char* nB = has_next ? (const char*)g.Bt + (size_t)nxt.pn * tstep : cB;
        for (int t = 0; t < nt; t += 2) {
            const bool last = (t == nt - 2);
            const char* a1 = cA + (size_t)(t + 1) * kstep;
            const char* a2 = last ? nA : cA + (size_t)(t + 2) * kstep; const char* b2 = last ? nB : cB + (size_t)(t + 2) * kstep;
            const char* a3 = a2 + kstep; const char* b3 = b2 + kstep;
            if (last && has_next) S.a_ready(nxt);
            if constexpr (SP2) {
            PG8_LDB(B0, 0, 0); PG8_LDB(B1, 0, 1); PG8_SCHED; PG8_LDA(At, 0, 0); PG8_STAGE(PG8_SA(1, 1), a1 + hstep, voffA);
            PG8_WAIT_V(8); PG8_WAIT_L(0); PG8_BAR; PG8_MMA(0, 0, At, B0); PG8_MMA(0, 1, At, B1); PG8_BAR; PG8_SCHED;
            PG8_LDA(At, 0, 1); PG8_STAGE(PG8_SB(0, 0), b2, voffB); PG8_STAGE(PG8_SB(0, 1), b2 + hstep, voffB); PG8_STAGE(PG8_SA(0, 0), a2, voffA);
            PG8_WAIT_V(8); PG8_WAIT_L(0); PG8_BAR; PG8_MMA(1, 0, At, B0); PG8_MMA(1, 1, At, B1); PG8_BAR; PG8_SCHED;
            PG8_LDB(B0, 1, 0); PG8_LDB(B1, 1, 1); PG8_SCHED; PG8_LDA(At, 1, 0); PG8_STAGE(PG8_SA(0, 1), a2 + hstep, voffA);
            PG8_WAIT_V(8); PG8_WAIT_L(0); PG8_BAR; PG8_MMA(0, 0, At, B0); PG8_MMA(0, 1, At, B1); PG8_BAR; PG8_SCHED;
            PG8_LDA(At, 1, 1); PG8_STAGE(PG8_SB(1, 0), b3, voffB); PG8_STAGE(PG8_SB(1, 1), b3 + hstep, voffB); PG8_STAGE(PG8_SA(1, 0), a3, voffA);
            PG8_WAIT_V(8); PG8_WAIT_L(0); PG8_BAR; PG8_MMA(1, 0, At, B0); PG8_MMA(1, 1, At, B1); PG8_BAR; PG8_SCHED;
            } else {
            PG8_LDB(B0, 0, 0); PG8_SCHED; PG8_LDA(At, 0, 0); PG8_STAGE(PG8_SA(1, 1), a1 + hstep, voffA);
            PG8_WAIT_L(8); PG8_BAR; PG8_WAIT_L(0); PG8_MMA(0, 0, At, B0); PG8_BAR; PG8_SCHED;
            PG8_LDB(B1, 0, 1); PG8_STAGE(PG8_SB(0, 0), b2, voffB);
            PG8_BAR; PG8_WAIT_L(0); PG8_MMA(0, 1, At, B1); PG8_BAR;
            PG8_LDA(At, 0, 1); PG8_STAGE(PG8_SA(0, 0), a2, voffA);
            PG8_BAR; PG8_WAIT_L(0); PG8_MMA(1, 0, At, B0); PG8_BAR; PG8_SCHED;
            PG8_STAGE(PG8_SB(0, 1), b2 + hstep, voffB);
            PG8_WAIT_V(6); PG8_BAR; PG8_MMA(1, 1, At, B1); PG8_BAR;
            PG8_LDB(B0, 1, 0); PG8_SCHED; PG8_LDA(At, 1, 0); PG8_STAGE(PG8_SA(0, 1), a2 + hstep, voffA);
            PG8_WAIT_L(8); PG8_BAR; PG8_WAIT_L(0); PG8_MMA(0, 0, At, B0); PG8_BAR; PG8_SCHED;
            PG8_LDB(B1, 1, 1); PG8_STAGE(PG8_SB(1, 0), b3, voffB);
            PG8_BAR; PG8_WAIT_L(0); PG8_MMA(0, 1, At, B1); PG8_BAR;
            PG8_LDA(At, 1, 1); PG8_STAGE(PG8_SA(1, 0), a3, voffA);
            PG8_BAR; PG8_WAIT_L(0); PG8_MMA(1, 0, At, B0); PG8_BAR; PG8_SCHED;
            PG8_STAGE(PG8_SB(1, 1), b3 + hstep, voffB);
            PG8_WAIT_V(6); PG8_BAR; PG8_MMA(1, 1, At, B1); PG8_BAR;
            }
        }
        if constexpr (ALIGN_EPI) { if (wr == 0) PG8_BAR; }
        if constexpr (!Epi::AFTER_DRAIN) { E(acc, cur, ui, wr, wc, fr, fq); S.done(cur); }
        if (!has_next) break;
#pragma unroll
        for (int a = 0; a < 2; ++a)
#pragma unroll
            for (int b = 0; b < 2; ++b)
#pragma unroll
                for (int m = 0; m < 4; ++m)
#pragma unroll
                    for (int n = 0; n < 2; ++n) acc[a][b][m][n] = (f32x4){0.f, 0.f, 0.f, 0.f};
        cur = nxt; cA = nA; cB = nB; ++ui;
        if constexpr (ALIGN_EPI) { if (wr == 1) PG8_BAR; }
    }
    PG8_WAIT_V(0);
    if constexpr (!ALIGN_EPI) { if (wr == 0) PG8_BAR; }
    PG8_BAR;
    if constexpr (Epi::AFTER_DRAIN) { E.fused(acc, cur, wr, wc, fr, fq, lds, wid, lane); S.done(cur); }
#undef PG8_SA
#undef PG8_SB
#undef PG8_STAGE
#undef PG8_LDA
#undef PG8_LDB
#undef PG8_MMA
#undef PG8_WAIT_V
#undef PG8_WAIT_L
#undef PG8_BAR
#undef PG8_SCHED
}
}

constexpr int NWAVES = 8;
constexpr int BATCH = 8, SEQ = 4096, DM = 1024, NHEAD = 16, FF = 4096, DEPTH = 2;
constexpr int M = BATCH * SEQ;
constexpr int NIN = 3462, NINP = 3584;
constexpr float EPS = 1e-6f, LOG2E = 1.4426950408889634f;
#ifndef MK_ONE_LAUNCH
#define MK_ONE_LAUNCH 1
#endif
constexpr int NPH = 1 + 6 * DEPTH;

constexpr size_t MiB = 1u << 20;
constexpr size_t WS_CTL = 0, CTL_ZERO_BYTES = 1 * MiB;
constexpr size_t WS_W = 2 * MiB, W_LAYER = 25 * MiB, W_IN = 0, W_OUT = 7 * MiB, W_UP = 9 * MiB, W_DOWN = 17 * MiB;
constexpr size_t WS_SSQ = 52 * MiB;
constexpr size_t WS_LS = 54 * MiB;
constexpr size_t WS_KMP = 55 * MiB;
constexpr size_t WS_XB = 64 * MiB;
constexpr size_t WS_Q = 128 * MiB, WS_K = 192 * MiB, WS_V = 256 * MiB, WS_O = 320 * MiB;
constexpr size_t WS_Y = WS_Q;
constexpr size_t WS_H = 128 * MiB;
constexpr size_t WS_GF = 384 * MiB;
constexpr size_t WS_END = 408 * MiB;
constexpr int CW_BAR = 4096;

constexpr int RING_OFF = 0, RING_BYTES = 131072;
constexpr int LDSCTL_OFF = RING_BYTES, MISC_OFF = LDSCTL_OFF + 320;
constexpr int LDS_BYTES = 147456;

#define GAS __attribute__((address_space(1)))
#define LAS __attribute__((address_space(3)))
typedef unsigned short bf16;
typedef unsigned v4u __attribute__((ext_vector_type(4)));
typedef float f32x4 __attribute__((ext_vector_type(4)));
typedef GAS unsigned gu32;
#define RLX_AGENT __ATOMIC_RELAXED, __HIP_MEMORY_SCOPE_AGENT
#define LDS_WAIT() asm volatile("s_waitcnt lgkmcnt(0)" ::: "memory")
#define VM_WAIT() asm volatile("s_waitcnt vmcnt(0)" ::: "memory")
__device__ __forceinline__ unsigned f2bf(float f) { unsigned u = __builtin_bit_cast(unsigned, f); return (u + 0x7fffu + ((u >> 16) & 1u)) >> 16; }
__device__ __forceinline__ unsigned pk2(float lo, float hi) { return f2bf(lo) | (f2bf(hi) << 16); }
__device__ __forceinline__ float bflo(unsigned w) { return __builtin_bit_cast(float, w << 16); }
__device__ __forceinline__ float bfhi(unsigned w) { return __builtin_bit_cast(float, w & 0xffff0000u); }
#define XB_TMO      128
#define XB_XCNT(j)  (256  + 64 * (j))
#define XB_XSUB(j)  (1280 + 64 * (j))
#define XB_XGEN(j)  (2304 + 64 * (j))
#define XB_TOP      3328
#define XB_TOPGEN   3392
#define XCD_BAR_WORDS 3456
#define XB_SPIN_CAP (1u << 18)

__device__ __forceinline__ unsigned xb_ld(unsigned* p)              { return __hip_atomic_load(p, __ATOMIC_RELAXED, __HIP_MEMORY_SCOPE_AGENT); }
__device__ __forceinline__ unsigned xb_add(unsigned* p, unsigned v) { return __hip_atomic_fetch_add(p, v, __ATOMIC_RELAXED, __HIP_MEMORY_SCOPE_AGENT); }
__device__ __forceinline__ unsigned xb_xcc_id() { return (unsigned)__builtin_amdgcn_s_getreg((3 << 11) | 20) & 0xFu; }
#define XB_SPIN(cond, bar) do { unsigned _sp = 0; while (cond) { __builtin_amdgcn_s_sleep(1); \
    if ((++_sp & 255u) == 0u) { if (xb_ld(&(bar)[XB_TMO])) break; if (_sp > XB_SPIN_CAP) { atomicAdd(&(bar)[XB_TMO], 1u); break; } } } } while (0)

struct XcdBarrier {
    unsigned* bar; unsigned x;
    volatile LAS unsigned* st;
};

__device__ __forceinline__ XcdBarrier xcd_barrier_post(unsigned* bar, volatile LAS unsigned* st) {
    XcdBarrier b; b.bar = bar; b.x = xb_xcc_id(); b.st = st;
    if (threadIdx.x == 0) (void)xb_add(&bar[XB_XCNT(b.x)], 1u);
    return b;
}
__device__ __forceinline__ void xcd_barrier_complete(unsigned* bar, unsigned x, unsigned& nloc, unsigned& nx) {
    const unsigned G = gridDim.x * gridDim.y * gridDim.z;
    unsigned sum, cnt, mine, sp = 0u;
    for (;;) {
        sum = 0u; cnt = 0u; mine = 0u;
#pragma unroll
        for (unsigned j = 0; j < 16; ++j) { const unsigned c = xb_ld(&bar[XB_XCNT(j)]); sum += c; cnt += (c > 0u) ? 1u : 0u; mine = (j == x) ? c : mine; }
        if (sum == G) break;
        __builtin_amdgcn_s_sleep(1);
        if ((++sp & 255u) == 0u) { if (xb_ld(&bar[XB_TMO])) break; if (sp > XB_SPIN_CAP) { atomicAdd(&bar[XB_TMO], 1u); break; } }
    }
    nloc = mine > 0u ? mine : 1u; nx = cnt > 0u ? cnt : 1u;
}

__device__ __forceinline__ void xcd_barrier(const XcdBarrier& b, const int tid_x) {
    asm volatile("s_waitcnt vmcnt(0)" ::: "memory");
    __syncthreads();
    if (tid_x == 0) {
        unsigned* bar = b.bar;
        __builtin_amdgcn_s_waitcnt(0);
        unsigned nloc = b.st[0], nx = b.st[1];
        if (nloc == 0u) { xcd_barrier_complete(bar, b.x, nloc, nx); b.st[0] = nloc; b.st[1] = nx; }
        const unsigned old = xb_add(&bar[XB_XSUB(b.x)], 1u);
        const unsigned gen = old / nloc;
        if (old + 1u == (gen + 1u) * nloc) {
            __builtin_amdgcn_fence(__ATOMIC_RELEASE, "agent");
            asm volatile("s_waitcnt vmcnt(0)" ::: "memory");
            const unsigned og = xb_add(&bar[XB_TOP], 1u);
            const unsigned tg = og / nx;
            if (og + 1u == (tg + 1u) * nx) xb_add(&bar[XB_TOPGEN], 1u);
            else XB_SPIN(xb_ld(&bar[XB_TOPGEN]) == tg, bar);
            __builtin_amdgcn_fence(__ATOMIC_ACQUIRE, "agent");
            xb_add(&bar[XB_XGEN(b.x)], 1u);
            asm volatile("s_waitcnt vmcnt(0)" ::: "memory");
        } else {
            XB_SPIN(xb_ld(&bar[XB_XGEN(b.x)]) == gen, bar);
            __builtin_amdgcn_fence(__ATOMIC_ACQUIRE, "agent");
            asm volatile("s_waitcnt vmcnt(0)" ::: "memory");
        }
    }
    __syncthreads();
}

struct Frame {
    LAS unsigned char* lds;
    volatile LAS unsigned* MISC;
    gu32* ctl;
    int tid, lane, wave;
    int vcu, G;
};
struct Ptrs {
    const float *x, *attn_norm, *w_in, *b_forget, *q_gain, *k_gain, *out_gain, *w_out, *mlp_norm, *w_up, *w_down;
    float* out; unsigned char* ws;
};

__device__ __forceinline__ float wave_sum(float v) {
#pragma unroll
    for (int o = 1; o < 64; o <<= 1) v += __shfl_xor(v, o);
    return v;
}

__device__ __forceinline__ int win_src(int cp) {
    const int tile = cp >> 8, within = cp & 255;
    if (tile < 12) { const int bj = within >> 7, wc = (within >> 5) & 3, j = within & 31; return tile * 256 + 64 * wc + 32 * bj + j; }
    if (tile == 12) return 3078 + within;
    if (within < 128) return 3078 + 256 + within;
    if (within < 134) return 3072 + (within - 128);
    return -1;
}
template <int MODE>
__device__ __forceinline__ void transpose_item(const float* W, int K, int N, const float* gain, bf16* WT, LAS float* scr, int item, int nblk, int lane) {
    const int kb = item / nblk, nb = item % nblk, k0 = 64 * kb, n0 = 32 * nb;
    const int sc = (MODE == 0) ? win_src(n0 + (lane & 31)) : (n0 + (lane & 31));
#pragma unroll 8
    for (int i = 0; i < 32; ++i) { const int kk = 2 * i + (lane >> 5); float v = 0.f; if (sc >= 0) { v = W[(size_t)(k0 + kk) * N + sc]; if (gain) v *= gain[k0 + kk]; } scr[kk * 33 + (lane & 31)] = v; }
    LDS_WAIT(); asm volatile("" ::: "memory");
    const int c = lane & 7;
#pragma unroll
    for (int j = 0; j < 4; ++j) { const int n = (lane >> 3) + 8 * j; const LAS float* s = scr + (8 * c) * 33 + n;
        v4u o; o.x = pk2(s[0 * 33], s[1 * 33]); o.y = pk2(s[2 * 33], s[3 * 33]); o.z = pk2(s[4 * 33], s[5 * 33]); o.w = pk2(s[6 * 33], s[7 * 33]);
        *(GAS v4u*)(WT + (size_t)(n0 + n) * K + k0 + 8 * c) = o; }
    LDS_WAIT(); asm volatile("" ::: "memory");
}
__device__ __forceinline__ void p0_prologue(Frame& F, const Ptrs& P) {
    LAS float* scr = (LAS float*)(F.lds + RING_OFF + F.wave * 16384);
    const int gw = F.vcu * NWAVES + F.wave, NGW = F.G * NWAVES;
    constexpr int I_IN = (DM / 64) * (NINP / 32), I_OUT = (DM / 64) * (DM / 32), I_UP = (DM / 64) * (FF / 32), I_DN = (FF / 64) * (DM / 32);
    constexpr int I_LAYER = I_IN + I_OUT + I_UP + I_DN;
    for (int it = gw; it < DEPTH * I_LAYER; it += NGW) {
        const int l = it / I_LAYER; int r = it % I_LAYER;
        unsigned char* wl = P.ws + WS_W + (size_t)l * W_LAYER;
        if (r < I_IN) { transpose_item<0>(P.w_in + (size_t)l * DM * NIN, DM, NIN, P.attn_norm + l * DM, (bf16*)(wl + W_IN), scr, r, NINP / 32, F.lane); continue; } r -= I_IN;
        if (r < I_OUT) { transpose_item<1>(P.w_out + (size_t)l * DM * DM, DM, DM, P.out_gain + l * DM, (bf16*)(wl + W_OUT), scr, r, DM / 32, F.lane); continue; } r -= I_OUT;
        if (r < I_UP) { transpose_item<1>(P.w_up + (size_t)l * DM * FF, DM, FF, P.mlp_norm + l * DM, (bf16*)(wl + W_UP), scr, r, FF / 32, F.lane); continue; } r -= I_UP;
        transpose_item<1>(P.w_down + (size_t)l * FF * DM, FF, DM, nullptr, (bf16*)(wl + W_DOWN), scr, r, DM / 32, F.lane);
    }
    bf16* XB = (bf16*)(P.ws + WS_XB); float* SSQ = (float*)(P.ws + WS_SSQ);
    for (int m = gw; m < M; m += NGW) {
        const GAS f32x4* xr = (const GAS f32x4*)(P.x + (size_t)m * DM) + F.lane;
        f32x4 v[4]; float s = 0.f;
#pragma unroll
        for (int j = 0; j < 4; ++j) { v[j] = xr[64 * j]; s += (v[j].x * v[j].x + v[j].y * v[j].y) + (v[j].z * v[j].z + v[j].w * v[j].w); }
        s = wave_sum(s);
        GAS unsigned long long* o8 = (GAS unsigned long long*)(XB + (size_t)m * DM) + F.lane;
#pragma unroll
        for (int j = 0; j < 4; ++j) o8[64 * j] = (unsigned long long)pk2(v[j].x, v[j].y) | ((unsigned long long)pk2(v[j].z, v[j].w) << 32);
        if (F.lane < 16) SSQ[(size_t)m * 16 + F.lane] = F.lane == 0 ? s : 0.f;
    }
}

struct AttnP { const bf16 *Q, *K, *V; bf16* O; const float *LS, *KMP; };
__device__ __forceinline__ void unpack8(const v4u w, float* f) { f[0] = bflo(w.x); f[1] = bfhi(w.x); f[2] = bflo(w.y); f[3] = bfhi(w.y); f[4] = bflo(w.z); f[5] = bfhi(w.z); f[6] = bflo(w.w); f[7] = bfhi(w.w); }
#define SOFT_UPDATE(lg, VROW_LOAD) do { \
    if ((lg) > mrun) { const float sc_ = __builtin_amdgcn_exp2f(mrun - (lg)); lrun *= sc_; _Pragma("unroll") for (int d_ = 0; d_ < 64; ++d_) o[d_] *= sc_; mrun = (lg); } \
    const float p_ = __builtin_amdgcn_exp2f((lg) - mrun); lrun += p_; \
    _Pragma("unroll") for (int c_ = 0; c_ < 8; ++c_) { float vv_[8]; unpack8(VROW_LOAD(c_), vv_); _Pragma("unroll") for (int e_ = 0; e_ < 8; ++e_) o[8 * c_ + e_] += p_ * vv_[e_]; } } while (0)

template <int KIND>
__device__ __forceinline__ void sattn_unit(Frame& F, const AttnP& P, int b, int h, int chunk) {
    const int tid = F.tid, t = chunk * 512 + tid; const size_t row = (size_t)b * SEQ + t;
    float q[64], o[64];
    { const v4u* qr = (const v4u*)(P.Q + row * DM + h * 64);
#pragma unroll
      for (int c = 0; c < 8; ++c) unpack8(qr[c], q + 8 * c); }
#pragma unroll
    for (int d = 0; d < 64; ++d) o[d] = 0.f;
    unsigned selmask = 0; const int blk = t >> 8; float slope2 = 0.f;
    if (KIND == 0) {
        slope2 = exp2f(-8.0f * (float)(7 + h) / 10.0f) * LOG2E;
        float g0 = -INFINITY, g1 = -INFINITY, g2 = -INFINITY; int i0 = -1, i1 = -1, i2 = -1;
        for (int j = 0; j < blk; ++j) {
            const float* km = P.KMP + ((size_t)((b * 16 + j) * 4 + h) * 2) * 64;
            float dot = 0.f;
#pragma unroll
            for (int d = 0; d < 64; ++d) dot += q[d] * (km[d] + km[64 + d]);
            if (dot > g0) { g2 = g1; i2 = i1; g1 = g0; i1 = i0; g0 = dot; i0 = j; } else if (dot > g1) { g2 = g1; i2 = i1; g1 = dot; i1 = j; } else if (dot > g2) { g2 = dot; i2 = j; }
        }
        if (i0 >= 0) selmask |= 1u << i0; if (i1 >= 0) selmask |= 1u << i1; if (i2 >= 0) selmask |= 1u << i2;
    }
    float mrun = -1e30f, lrun = 0.f, brun = 0.f;
    LAS unsigned char* lds = F.lds;
    const int nkt = 8 * (chunk + 1);
    for (int kt = nkt - 1; kt >= 0; --kt) {
        __syncthreads();
        { const int r = tid >> 3, c = tid & 7; const size_t g = ((size_t)b * SEQ + kt * 64 + r) * DM + h * 64 + c * 8;
          *(LAS v4u*)(lds + r * 128 + c * 16) = *(const v4u*)(P.K + g); *(LAS v4u*)(lds + 8192 + r * 128 + c * 16) = *(const v4u*)(P.V + g);
          if (KIND == 1 && tid < 64) ((LAS float*)(lds + 16384))[tid] = P.LS[((size_t)b * SEQ + kt * 64 + tid) * 8 + (h - 4)] * LOG2E; }
        __syncthreads();
        const int kblk = kt >> 2;
        const bool tile_ok = (KIND == 0) ? ((kblk == blk) || (kblk < blk && ((selmask >> kblk) & 1u))) : true;
        for (int j = 63; j >= 0; --j) {
            const int s = kt * 64 + j;
            const bool ok = tile_ok && ((KIND == 0 && kblk < blk) || s <= t);
            if (ok) {
                float dot = 0.f;
#pragma unroll
                for (int c = 0; c < 8; ++c) { float kk[8]; unpack8(*(const LAS v4u*)(lds + j * 128 + c * 16), kk);
#pragma unroll
                    for (int e = 0; e < 8; ++e) dot += q[8 * c + e] * kk[e]; }
                const float lg = dot + (KIND == 0 ? -slope2 * (float)(t - s) : brun);
#define VROW_LDS(c) (*(const LAS v4u*)(lds + 8192 + j * 128 + (c) * 16))
                SOFT_UPDATE(lg, VROW_LDS);
#undef VROW_LDS
                if (KIND == 1) brun += ((const LAS float*)(lds + 16384))[j];
            }
        }
    }
    const float inv = 1.0f / lrun;
    v4u* orow = (v4u*)(P.O + row * DM + h * 64);
#pragma unroll
    for (int c = 0; c < 8; ++c) { v4u w; w.x = pk2(o[8 * c] * inv, o[8 * c + 1] * inv); w.y = pk2(o[8 * c + 2] * inv, o[8 * c + 3] * inv); w.z = pk2(o[8 * c + 4] * inv, o[8 * c + 5] * inv); w.w = pk2(o[8 * c + 6] * inv, o[8 * c + 7] * inv); orow[c] = w; }
}
__device__ __forceinline__ void sdil_unit(Frame& F, const AttnP& P, int b, int h, int chunk) {
    const int tid = F.tid, t = chunk * 512 + tid; const size_t row = (size_t)b * SEQ + t;
    float q[64], o[64];
    { const v4u* qr = (const v4u*)(P.Q + row * DM + h * 64);
#pragma unroll
      for (int c = 0; c < 8; ++c) unpack8(qr[c], q + 8 * c); }
#pragma unroll
    for (int d = 0; d < 64; ++d) o[d] = 0.f;
    const float slope2 = exp2f(-8.0f * (float)(h - 10 + 1) / 10.0f) * LOG2E;
    float mrun = -1e30f, lrun = 0.f;
    for (int g = 0; g < 3; ++g) {
        const int dil = (g == 0) ? 1 : (g == 1 ? 4 : 16);
        for (int off = 0; off <= 128; ++off) {
            const int s = t - off * dil;
            if (s >= 0) {
                const v4u* kr = (const v4u*)(P.K + ((size_t)b * SEQ + s) * DM + h * 64); const v4u* vr = (const v4u*)(P.V + ((size_t)b * SEQ + s) * DM + h * 64);
                float dot = 0.f;
#pragma unroll
                for (int c = 0; c < 8; ++c) { float kk[8]; unpack8(kr[c], kk);
#pragma unroll
                    for (int e = 0; e < 8; ++e) dot += q[8 * c + e] * kk[e]; }
                const float lg = dot - slope2 * (float)(off * dil);
#define VROW_G(c) (vr[c])
                SOFT_UPDATE(lg, VROW_G);
#undef VROW_G
            }
        }
    }
    const float inv = 1.0f / lrun;
    v4u* orow = (v4u*)(P.O + row * DM + h * 64);
#pragma unroll
    for (int c = 0; c < 8; ++c) { v4u w; w.x = pk2(o[8 * c] * inv, o[8 * c + 1] * inv); w.y = pk2(o[8 * c + 2] * inv, o[8 * c + 3] * inv); w.z = pk2(o[8 * c + 4] * inv, o[8 * c + 5] * inv); w.w = pk2(o[8 * c + 6] * inv, o[8 * c + 7] * inv); orow[c] = w; }
}
__device__ __forceinline__ void simple_attn_phase(Frame& F, const AttnP& P, int bid) {
    for (int id = bid; id < 1024; id += F.G) {
        const int kbh = id >> 3, chunk = ((id & 7) + (kbh >> 5)) & 7;
        if (kbh < 32) sattn_unit<0>(F, P, kbh >> 2, kbh & 3, chunk);
        else if (kbh < 80) { const int r = kbh - 32; sattn_unit<1>(F, P, r / 6, 4 + r % 6, chunk); }
        else { const int r = kbh - 80; sdil_unit(F, P, r / 6, 10 + r % 6, chunk); }
    }
}
__device__ __forceinline__ void norm_phase(Frame& F, const bf16* O, const bf16* GF, bf16* Y) {
    const int gw = F.vcu * NWAVES + F.wave, NGW = F.G * NWAVES, lane = F.lane;
    for (int m = gw; m < M; m += NGW) {
        const v4u wa = *(const v4u*)(O + (size_t)m * DM + 8 * lane), wc = *(const v4u*)(O + (size_t)m * DM + 512 + 8 * lane);
        float fa[8], fc[8]; unpack8(wa, fa); unpack8(wc, fc);
        float sa = 0.f, sc = 0.f;
#pragma unroll
        for (int e = 0; e < 8; ++e) { sa += fa[e] * fa[e]; sc += fc[e] * fc[e]; }
        const float s_moba = wave_sum(lane < 32 ? sa : 0.f), s_fox = wave_sum((lane >= 32 ? sa : 0.f) + (lane < 16 ? sc : 0.f)), s_dil = wave_sum(lane >= 16 ? sc : 0.f);
        const float r_moba = 1.0f / sqrtf(s_moba * (1.0f / 256.0f) + EPS), r_fox = 1.0f / sqrtf(s_fox * (1.0f / 384.0f) + EPS), r_dil = 1.0f / sqrtf(s_dil * (1.0f / 384.0f) + EPS);
        float ga[8], gc[8];
#pragma unroll
        for (int e = 0; e < 8; ++e) { ga[e] = 1.f; gc[e] = 1.f; }
        if (lane >= 32) unpack8(*(const v4u*)(GF + (size_t)m * 384 + 8 * lane - 256), ga);
        if (lane < 16) unpack8(*(const v4u*)(GF + (size_t)m * 384 + 256 + 8 * lane), gc);
        const float ra = lane < 32 ? r_moba : r_fox, rc = lane < 16 ? r_fox : r_dil;
        v4u ya, yc;
        ya.x = pk2(fa[0] * ra * ga[0], fa[1] * ra * ga[1]); ya.y = pk2(fa[2] * ra * ga[2], fa[3] * ra * ga[3]); ya.z = pk2(fa[4] * ra * ga[4], fa[5] * ra * ga[5]); ya.w = pk2(fa[6] * ra * ga[6], fa[7] * ra * ga[7]);
        yc.x = pk2(fc[0] * rc * gc[0], fc[1] * rc * gc[1]); yc.y = pk2(fc[2] * rc * gc[2], fc[3] * rc * gc[3]); yc.z = pk2(fc[4] * rc * gc[4], fc[5] * rc * gc[5]); yc.w = pk2(fc[6] * rc * gc[6], fc[7] * rc * gc[7]);
        *(v4u*)(Y + (size_t)m * DM + 8 * lane) = ya; *(v4u*)(Y + (size_t)m * DM + 512 + 8 * lane) = yc;
    }
}

struct Args { const float* in[11]; float* out; unsigned char* ws; int ph_lo, ph_hi; };
__global__ void __launch_bounds__(NWAVES * 64, 2) mk_fwd(Args args) {
    __shared__ __attribute__((aligned(16))) unsigned char lds[LDS_BYTES];
    for (int u = threadIdx.x; u < (LDS_BYTES - LDSCTL_OFF) / 4; u += NWAVES * 64) ((LAS unsigned*)((LAS unsigned char*)lds + LDSCTL_OFF))[u] = 0u;
    __syncthreads();
    const int lo = args.ph_lo, hi = args.ph_hi;
    XcdBarrier bar; bar.bar = (unsigned*)(args.ws + WS_CTL) + CW_BAR; bar.x = 0; bar.st = nullptr;
    if (hi - lo > 1) bar = xcd_barrier_post((unsigned*)(args.ws + WS_CTL) + CW_BAR, (volatile LAS unsigned*)((LAS unsigned char*)lds + MISC_OFF) + 8);
#pragma unroll 1
    for (int ph = lo; ph < hi; ++ph) {
        unsigned char* ws = args.ws; asm volatile("" : "+s"(ws));
        int tid_ = threadIdx.x; asm volatile("" : "+v"(tid_));
        int bid_ = blockIdx.x, G_ = gridDim.x; asm volatile("" : "+s"(bid_), "+s"(G_));
        Frame F;
        F.lds = (LAS unsigned char*)lds;
        F.MISC = (volatile LAS unsigned*)(F.lds + MISC_OFF);
        F.tid = tid_; F.lane = F.tid & 63; F.wave = __builtin_amdgcn_readfirstlane(F.tid >> 6);
        F.G = G_; F.vcu = (F.G % 8 == 0) ? (bid_ % 8) * (F.G / 8) + bid_ / 8 : bid_;
        F.ctl = (gu32*)(ws + WS_CTL);
        Ptrs P;
        P.x = args.in[0]; P.attn_norm = args.in[1]; P.w_in = args.in[2]; P.b_forget = args.in[3]; P.q_gain = args.in[4]; P.k_gain = args.in[5];
        P.out_gain = args.in[6]; P.w_out = args.in[7]; P.mlp_norm = args.in[8]; P.w_up = args.in[9]; P.w_down = args.in[10]; P.out = args.out; P.ws = ws;
        PG8_LAS float* tab = (PG8_LAS float*)(F.lds + pg8::TAB_OFF);
        if (ph == 0) { p0_prologue(F, P); }
        else {
            const int l = (ph - 1) / 6, k = (ph - 1) % 6;
            unsigned char* wl = ws + WS_W + (size_t)l * W_LAYER;
            bf16* XB = (bf16*)(ws + WS_XB);
            if (k == 0) {
                pg8::Gemm g{XB, (const bf16*)(wl + W_IN), M, NINP, DM}; pg8::StaticOrder S; S.init(M, NINP, F.G, bid_);
                pg8::EpiIn E{ws, P.b_forget + l * 6, tab};
                pg8::prep_tables(S, tab, ws, P.q_gain + l * 1024, P.k_gain + l * 1024, F.tid); __syncthreads();
                pg8::gemm_phase<pg8::EpiIn, pg8::StaticOrder, true, true>(F.lds + RING_OFF, g, S, E, F.tid);
            } else if (k == 1) {
                const AttnP AP{(const bf16*)(ws + WS_Q), (const bf16*)(ws + WS_K), (const bf16*)(ws + WS_V), (bf16*)(ws + WS_O), (const float*)(ws + WS_LS), (const float*)(ws + WS_KMP)};
                simple_attn_phase(F, AP, bid_);
            } else if (k == 2) {
                norm_phase(F, (const bf16*)(ws + WS_O), (const bf16*)(ws + WS_GF), (bf16*)(ws + WS_Y));
            } else if (k == 4) {
                pg8::Gemm g{XB, (const bf16*)(wl + W_UP), M, FF, DM}; pg8::StaticOrder S; S.init(M, FF, F.G, bid_);
                pg8::EpiUp E{ws, tab};
                pg8::prep_tables(S, tab, ws, nullptr, nullptr, F.tid); __syncthreads();
                pg8::gemm_phase<pg8::EpiUp, pg8::StaticOrder, true, true>(F.lds + RING_OFF, g, S, E, F.tid);
            } else {
                const bool dn = (k == 5);
                pg8::Gemm g{dn ? (const bf16*)(ws + WS_H) : (const bf16*)(ws + WS_Y), (const bf16*)(wl + (dn ? W_DOWN : W_OUT)), M, DM, dn ? FF : DM};
                pg8::StaticOrder S; S.init(M, DM, F.G, bid_);
                pg8::EpiRes E{(l == 0 && !dn) ? P.x : P.out, P.out, ws};
                pg8::gemm_phase<pg8::EpiRes, pg8::StaticOrder, true, true>(F.lds + RING_OFF, g, S, E, F.tid);
            }
        }
        if (ph + 1 < hi) { XcdBarrier b2 = bar; asm volatile("" : "+s"(b2.bar)); xcd_barrier(b2, F.tid); }
    }
}

extern "C" void kernel_launch(void* const* d_in, const int* in_sizes, int n_in, void* d_out, int out_size, void* d_ws, size_t ws_size, hipStream_t stream) {
    static int grid = 0;
    if (grid == 0) {
        if (n_in != 11 || in_sizes[0] != M * DM || out_size != M * DM || ws_size < WS_END) { fprintf(stderr, "kernel_launch: unexpected shapes (n_in %d in0 %d out %d ws %zu)\n", n_in, n_in > 0 ? in_sizes[0] : -1, out_size, ws_size); grid = -1; return; }
        int dev = 0, cus = 0, per_cu = 0;
        if (hipGetDevice(&dev) != hipSuccess || hipDeviceGetAttribute(&cus, hipDeviceAttributeMultiprocessorCount, dev) != hipSuccess) { grid = -1; return; }
        if (hipOccupancyMaxActiveBlocksPerMultiprocessor(&per_cu, (const void*)mk_fwd, NWAVES * 64, 0) != hipSuccess || per_cu < 1) { fprintf(stderr, "kernel_launch: occupancy query says %d blocks per CU\n", per_cu); (void)hipGetLastError(); grid = -1; return; }
        grid = cus;
    }
    if (grid < 0) return;
    (void)hipMemsetAsync((char*)d_ws + WS_CTL, 0, CTL_ZERO_BYTES, stream);
    Args a{};
    for (int i = 0; i < 11; ++i) a.in[i] = (const float*)d_in[i];
    a.out = (float*)d_out; a.ws = (unsigned char*)d_ws;
#if MK_ONE_LAUNCH
    a.ph_lo = 0; a.ph_hi = NPH;
    hipLaunchKernelGGL(mk_fwd, dim3(grid), dim3(NWAVES * 64), 0, stream, a);
#else
    for (int p = 0; p < NPH; ++p) { a.ph_lo = p; a.ph_hi = p + 1; hipLaunchKernelGGL(mk_fwd, dim3(grid), dim3(NWAVES * 64), 0, stream, a); }
#endif
}
```

```cpp
#include <hip/hip_runtime.h>
#include <cstdio>
#include <cstdint>
namespace pg8 {
#define PG8_LAS __attribute__((address_space(3)))
typedef unsigned short bf16_t;
typedef short bf16x8 __attribute__((ext_vector_type(8)));
typedef float f32x4 __attribute__((ext_vector_type(4)));
typedef unsigned u32x4 __attribute__((ext_vector_type(4)));
constexpr int BM = 256, BK = 64, HALF = 128, HTB = HALF * BK * 2  , STAGE_BYTES = 8 * HTB, NXCD = 8, WGM = 8;

__host__ __device__ __forceinline__ int lds_byte(int r, int c) { const int st = (r >> 4) * 2 + (c >> 5), rr = r & 15, cc = c & 31, ob = rr * 64 + cc * 2; return st * 1024 + (ob ^ (((ob >> 9) & 1) << 5)); }
__host__ __device__ __forceinline__ void stage_rc(int b, int& R, int& C) { const int st = b / 1024, sb = b % 1024, swz = sb ^ (((sb >> 9) & 1) << 5); R = (st >> 1) * 16 + swz / 64; C = (st & 1) * 32 + (swz % 64) / 2; }
__host__ __device__ __forceinline__ int perm32(int rho) { const int n = rho >> 4, i = rho & 15; return 8 * (i >> 2) + 4 * n + (i & 3); }

struct Unit { int pm, pn; };
struct Gemm { const bf16_t* A; const bf16_t* Bt; int M, N, K; };

struct StaticOrder {
    int nM, nN, nwg, G, c;
    __host__ __device__ void init(int M, int N, int G_, int c_) { nM = M / BM; nN = N / BM; nwg = nM * nN; G = G_; c = c_; }
    __host__ __device__ bool next(int i, Unit& u) const {
        const long L = (long)i * G + c; if (L >= nwg) return false;
        int wgid = (int)L; { const int q = nwg / NXCD, r = nwg % NXCD, xcd = wgid % NXCD, off = wgid / NXCD; wgid = (xcd < r ? xcd * (q + 1) : r * (q + 1) + (xcd - r) * q) + off; }
        const int nig = WGM * nN, gid = wgid / nig, fm = gid * WGM, gsz = (nM - fm) < WGM ? (nM - fm) : WGM;
        u.pm = fm + ((wgid % nig) % gsz); u.pn = (wgid % nig) / gsz; return true;
    }
    __device__ __forceinline__ void a_ready(const Unit&) const {}
    __device__ __forceinline__ void done(const Unit&) const {}
};


__device__ __forceinline__ unsigned cvt_pk_bf16(float lo, float hi) { unsigned r; asm volatile("v_cvt_pk_bf16_f32 %0, %1, %2" : "=v"(r) : "v"(lo), "v"(hi)); return r; }
constexpr float RMS_EPS = 1e-6f;
constexpr float QSCALE = 0.125f * 1.4426950408889634f;
constexpr int TAB_OFF = 131072 + 512, TAB_G = 2048;
constexpr size_t EMiB = 1u << 20;
constexpr size_t E_SSQ = 52 * EMiB, E_LS = 54 * EMiB, E_KMP = 55 * EMiB, E_PRM = 56 * EMiB, E_XB = 64 * EMiB, E_Q = 128 * EMiB, E_K = 192 * EMiB, E_V = 256 * EMiB, E_H = 128 * EMiB, E_GF = 384 * EMiB;
__device__ __forceinline__ float row_rstd(const float* ssq, unsigned row) {
    const float* p = ssq + (size_t)(row * 16u);
    const f32x4 a = *(const f32x4*)(p), b = *(const f32x4*)(p + 4), c = *(const f32x4*)(p + 8), d = *(const f32x4*)(p + 12);
    const float s = ((a[0] + a[1]) + (a[2] + a[3])) + ((b[0] + b[1]) + (b[2] + b[3])) + ((c[0] + c[1]) + (c[2] + c[3])) + ((d[0] + d[1]) + (d[2] + d[3]));
    return 1.0f / sqrtf(s * (1.0f / 1024.0f) + RMS_EPS);
}
template <class Sched>
__device__ __forceinline__ void prep_tables(const Sched& S, PG8_LAS float* tab, const unsigned char* ws, const float* qg, const float* kg  , int tid) {
    Unit u;
#pragma unroll 1
    for (int i = 0; i < 8 && S.next(i, u); ++i) {
        if (tid < 256) tab[i * 256 + tid] = row_rstd((const float*)(ws + E_SSQ), (unsigned)(u.pm * BM + tid));
        else if (qg && u.pn < 8) { const int c = tid - 256; tab[TAB_G + i * 256 + c] = (u.pn < 4 ? qg : kg)[(u.pn & 3) * 256 + c]; }
    }
}
#define PG8_PACK8(y0, y1) (u32x4){cvt_pk_bf16((y0)[0], (y0)[1]), cvt_pk_bf16((y0)[2], (y0)[3]), cvt_pk_bf16((y1)[0], (y1)[1]), cvt_pk_bf16((y1)[2], (y1)[3])}
struct EpiIn {
    static constexpr bool PERM = true, AFTER_DRAIN = false;
    unsigned char* ws; const float* bfg; PG8_LAS float* tab;
    __device__ __forceinline__ void operator()(const f32x4 (&acc)[2][2][4][2], const Unit& u, int ui, int wr, int wc, int fr, int fq) const {
        const int pn = u.pn; const unsigned row0 = (unsigned)(u.pm * BM + wr * 64 + fr);
        const PG8_LAS float* rsp = tab + ui * 256 + wr * 64 + fr;
        if (pn < 8) {
            const PG8_LAS float* gp = tab + TAB_G + ui * 256 + 64 * wc + 8 * fq;
            f32x4 g[2][2];
#pragma unroll
            for (int bj = 0; bj < 2; ++bj)
#pragma unroll
                for (int n = 0; n < 2; ++n) g[bj][n] = *(const PG8_LAS f32x4*)(gp + 32 * bj + 4 * n);
            unsigned char* dst = ws + (pn < 4 ? E_Q : E_K) + (size_t)(unsigned)(((pn & 3) * 256 + wc * 64 + 8 * fq) * 2);
            const float post = pn < 4 ? QSCALE : 1.0f;
            f32x4 ks[2][2];
#pragma unroll
            for (int bj = 0; bj < 2; ++bj)
#pragma unroll
                for (int n = 0; n < 2; ++n) ks[bj][n] = (f32x4){0.f, 0.f, 0.f, 0.f};
#pragma unroll
            for (int ai = 0; ai < 2; ++ai)
#pragma unroll
                for (int m = 0; m < 4; ++m) {
                    const unsigned row = row0 + ai * HALF + m * 16; const float rs = rsp[ai * HALF + m * 16];
                    f32x4 v[2][2]; float ss = 0.f;
#pragma unroll
                    for (int bj = 0; bj < 2; ++bj)
#pragma unroll
                        for (int n = 0; n < 2; ++n) { v[bj][n] = acc[ai][bj][m][n] * rs; const f32x4 x = v[bj][n]; ss += (x[0] * x[0] + x[1] * x[1]) + (x[2] * x[2] + x[3] * x[3]); }
                    ss += __shfl_xor(ss, 16); ss += __shfl_xor(ss, 32);
                    const float r2 = 1.0f / sqrtf(ss * (1.0f / 64.0f) + RMS_EPS);
#pragma unroll
                    for (int bj = 0; bj < 2; ++bj) {
                        const f32x4 y0 = v[bj][0] * r2 * g[bj][0], y1 = v[bj][1] * r2 * g[bj][1];
                        ks[bj][0] += y0; ks[bj][1] += y1;
                        const f32x4 z0 = y0 * post, z1 = y1 * post;
                        *(u32x4*)(dst + (size_t)(row * 2048u + 64u * bj)) = PG8_PACK8(z0, z1);
                    }
                }
            if (pn == 4) {
#pragma unroll
                for (int bj = 0; bj < 2; ++bj)
#pragma unroll
                    for (int n = 0; n < 2; ++n)
#pragma unroll
                        for (int e = 0; e < 4; ++e) { float s = ks[bj][n][e]; s += __shfl_xor(s, 1); s += __shfl_xor(s, 2); s += __shfl_xor(s, 4); s += __shfl_xor(s, 8); ks[bj][n][e] = s; }
                if (fr == 0) { float* kp = (float*)(ws + E_KMP) + (size_t)(unsigned)((((u.pm * 4 + wc) * 2 + wr) * 64 + 8 * fq));
#pragma unroll
                    for (int bj = 0; bj < 2; ++bj)
#pragma unroll
                        for (int n = 0; n < 2; ++n) *(f32x4*)(kp + 32 * bj + 4 * n) = ks[bj][n]; }
            }
        } else if (pn < 12) {
            unsigned char* dst = ws + E_V + (size_t)(unsigned)(((pn & 3) * 256 + wc * 64 + 8 * fq) * 2);
#pragma unroll
            for (int ai = 0; ai < 2; ++ai)
#pragma unroll
                for (int m = 0; m < 4; ++m) {
                    const unsigned row = row0 + ai * HALF + m * 16; const float rs = rsp[ai * HALF + m * 16];
#pragma unroll
                    for (int bj = 0; bj < 2; ++bj) { const f32x4 y0 = acc[ai][bj][m][0] * rs, y1 = acc[ai][bj][m][1] * rs;
                        *(u32x4*)(dst + (size_t)(row * 2048u + 64u * bj)) = PG8_PACK8(y0, y1); }
                }
        } else {
#pragma unroll
            for (int ai = 0; ai < 2; ++ai)
#pragma unroll
                for (int m = 0; m < 4; ++m) {
                    const unsigned row = row0 + ai * HALF + m * 16; const float rs = rsp[ai * HALF + m * 16];
#pragma unroll
                    for (int bj = 0; bj < 2; ++bj) {
                        const f32x4 y0 = acc[ai][bj][m][0] * rs, y1 = acc[ai][bj][m][1] * rs;
                        if (pn == 12 || bj == 0) {
                            const unsigned gcol = (unsigned)((pn == 12 ? 0 : 256) + 128 * bj + 32 * wc + 8 * fq);
                            f32x4 s0, s1;
#pragma unroll
                            for (int e = 0; e < 4; ++e) { s0[e] = 1.0f / (1.0f + __expf(-y0[e])); s1[e] = 1.0f / (1.0f + __expf(-y1[e])); }
                            *(u32x4*)(ws + E_GF + (size_t)((row * 384u + gcol) * 2u)) = PG8_PACK8(s0, s1);
                        } else if (wc == 0 && fq == 0) {
                            float z[6] = {y0[0], y0[1], y0[2], y0[3], y1[0], y1[1]};
#pragma unroll
                            for (int e = 0; e < 6; ++e) { const float zz = z[e] + bfg[e]; z[e] = fminf(zz, 0.f) - log1pf(__expf(-fabsf(zz))); }
                            float* lp = (float*)(ws + E_LS) + (size_t)row;
#pragma unroll
                            for (int e = 0; e < 6; ++e) lp[(size_t)(e * 32768u)] = z[e];
                        }
                    }
                }
        }
    }
};
struct EpiRes {
    static constexpr bool PERM = true, AFTER_DRAIN = false;
    const float* res; float* out; unsigned char* ws;
    __device__ __forceinline__ void operator()(const f32x4 (&acc)[2][2][4][2], const Unit& u, int ui, int wr, int wc, int fr, int fq) const {
        const unsigned row0 = (unsigned)(u.pm * BM + wr * 64 + fr), col0 = (unsigned)(u.pn * BM + wc * 32 + 8 * fq);
#pragma unroll
        for (int ai = 0; ai < 2; ++ai)
#pragma unroll
            for (int m = 0; m < 4; ++m) {
                const unsigned row = row0 + ai * HALF + m * 16; float ss = 0.f;
#pragma unroll
                for (int bj = 0; bj < 2; ++bj) {
                    const unsigned off = row * 1024u + col0 + bj * HALF;
                    const f32x4 o0 = *(const f32x4*)(res + (size_t)off) + acc[ai][bj][m][0], o1 = *(const f32x4*)(res + (size_t)off + 4) + acc[ai][bj][m][1];
                    *(f32x4*)(out + (size_t)off) = o0; *(f32x4*)(out + (size_t)off + 4) = o1;
                    ss += ((o0[0] * o0[0] + o0[1] * o0[1]) + (o0[2] * o0[2] + o0[3] * o0[3])) + ((o1[0] * o1[0] + o1[1] * o1[1]) + (o1[2] * o1[2] + o1[3] * o1[3]));
                    *(u32x4*)(ws + E_XB + (size_t)(off * 2u)) = PG8_PACK8(o0, o1);
                }
                ss += __shfl_xor(ss, 16); ss += __shfl_xor(ss, 32);
                if (fq == 0) ((float*)(ws + E_SSQ))[(size_t)(row * 16u + (unsigned)(u.pn * 4 + wc))] = ss;
                if (m & 1) asm volatile("" ::: "memory");
            }
    }
};
struct EpiUp {
    static constexpr bool PERM = true, AFTER_DRAIN = false;
    unsigned char* ws; PG8_LAS float* tab;
    __device__ __forceinline__ void operator()(const f32x4 (&acc)[2][2][4][2], const Unit& u, int ui, int wr, int wc, int fr, int fq) const {
        const unsigned row0 = (unsigned)(u.pm * BM + wr * 64 + fr), col0 = (unsigned)(u.pn * BM + wc * 32 + 8 * fq);
        const PG8_LAS float* rsp = tab + ui * 256 + wr * 64 + fr;
#pragma unroll
        for (int ai = 0; ai < 2; ++ai)
#pragma unroll
            for (int m = 0; m < 4; ++m) {
                const unsigned row = row0 + ai * HALF + m * 16; const float rs = rsp[ai * HALF + m * 16];
#pragma unroll
                for (int bj = 0; bj < 2; ++bj) {
                    f32x4 y0 = acc[ai][bj][m][0] * rs, y1 = acc[ai][bj][m][1] * rs;
#pragma unroll
                    for (int e = 0; e < 4; ++e) { const float a = fmaxf(y0[e], 0.f), b = fmaxf(y1[e], 0.f); y0[e] = a * a; y1[e] = b * b; }
                    *(u32x4*)(ws + E_H + (size_t)((row * 4096u + col0 + bj * HALF) * 2u)) = PG8_PACK8(y0, y1);
                }
            }
    }
};

template <class Epi, class Sched, bool ALIGN_EPI = false, bool SP2 = false>
__device__ __forceinline__ void gemm_phase(PG8_LAS unsigned char* lds, const Gemm g, const Sched& S, const Epi& E, const int tid) {
    const int wid = __builtin_amdgcn_readfirstlane(tid >> 6), lane = tid & 63, wr = wid >> 2, wc = wid & 3, fr = lane & 15, fq = lane >> 4;
    const int K = g.K, nt = K / BK;
    unsigned voffA[2], voffB[2];
#pragma unroll
    for (int i = 0; i < 2; ++i) { int R, C; stage_rc(tid * 16 + i * 8192, R, C); const int Rb = Epi::PERM ? ((R & ~31) + perm32(R & 31)) : R;
        voffA[i] = (unsigned)(R * K + C) * 2u; voffB[i] = (unsigned)(Rb * K + C) * 2u; }
    const size_t kstep = (size_t)(BK * 2);
    const size_t hstep = (size_t)HALF * K * 2;
    const size_t tstep = 2 * hstep;
    const unsigned ldsw = (unsigned)wid * 1024u;
    const int aoff = lds_byte(wr * 64 + fr, fq * 8), boff = lds_byte(wc * 32 + fr, fq * 8);
#define PG8_SA(b, h) (((b) * 2 + (h)) * HTB)
#define PG8_SB(b, h) ((4 + (b) * 2 + (h)) * HTB)
#define PG8_STAGE(bufoff, gbase, voff) do { _Pragma("unroll") for (int _i = 0; _i < 2; ++_i) \
        __builtin_amdgcn_global_load_lds((const unsigned*)((const char*)(gbase) + (voff)[_i]), (PG8_LAS unsigned*)(lds + (bufoff) + ldsw + _i * 8192), 16, 0, 0); } while (0)
#define PG8_LDA(dst, b, h) do { _Pragma("unroll") for (int m = 0; m < 4; ++m) _Pragma("unroll") for (int k = 0; k < 2; ++k) dst[m][k] = *(const PG8_LAS bf16x8*)(lds + PG8_SA(b, h) + aoff + m * 2048 + k * 1024); } while (0)
#define PG8_LDB(dst, b, h) do { _Pragma("unroll") for (int n = 0; n < 2; ++n) _Pragma("unroll") for (int k = 0; k < 2; ++k) dst[n][k] = *(const PG8_LAS bf16x8*)(lds + PG8_SB(b, h) + boff + n * 2048 + k * 1024); } while (0)
#define PG8_MMA(ai, bj, At, Bt) do { __builtin_amdgcn_s_setprio(1); _Pragma("unroll") for (int m = 0; m < 4; ++m) _Pragma("unroll") for (int n = 0; n < 2; ++n) _Pragma("unroll") for (int k = 0; k < 2; ++k) \
        acc[ai][bj][m][n] = __builtin_amdgcn_mfma_f32_16x16x32_bf16(Bt[n][k], At[m][k], acc[ai][bj][m][n], 0, 0, 0); __builtin_amdgcn_s_setprio(0); } while (0)
#define PG8_WAIT_V(n) asm volatile("s_waitcnt vmcnt(" #n ")" ::: "memory")
#define PG8_WAIT_L(n) asm volatile("s_waitcnt lgkmcnt(" #n ")" ::: "memory")
#define PG8_BAR __builtin_amdgcn_s_barrier()
#define PG8_SCHED __builtin_amdgcn_sched_barrier(0)
    Unit cur, nxt; int ui = 0;
    if (!S.next(0, cur)) return;
    f32x4 acc[2][2][4][2];
#pragma unroll
    for (int a = 0; a < 2; ++a)
#pragma unroll
        for (int b = 0; b < 2; ++b)
#pragma unroll
            for (int m = 0; m < 4; ++m)
#pragma unroll
                for (int n = 0; n < 2; ++n) acc[a][b][m][n] = (f32x4){0.f, 0.f, 0.f, 0.f};
    bf16x8 At[4][2], B0[2][2], B1[2][2];
    const char* cA = (const char*)g.A + (size_t)cur.pm * tstep; const char* cB = (const char*)g.Bt + (size_t)cur.pn * tstep;
    S.a_ready(cur);
    if constexpr (SP2) {
        PG8_STAGE(PG8_SB(0, 0), cB, voffB); PG8_STAGE(PG8_SB(0, 1), cB + hstep, voffB); PG8_STAGE(PG8_SA(0, 0), cA, voffA); PG8_STAGE(PG8_SA(0, 1), cA + hstep, voffA);
        if (wr == 1) PG8_BAR;
        PG8_WAIT_V(2); PG8_BAR;
        PG8_STAGE(PG8_SB(1, 0), cB + kstep, voffB); PG8_STAGE(PG8_SA(1, 0), cA + kstep, voffA); PG8_STAGE(PG8_SB(1, 1), cB + hstep + kstep, voffB);
        PG8_WAIT_V(6); PG8_BAR;
    } else {
        PG8_STAGE(PG8_SB(0, 0), cB, voffB); PG8_STAGE(PG8_SA(0, 0), cA, voffA); PG8_STAGE(PG8_SB(0, 1), cB + hstep, voffB); PG8_STAGE(PG8_SA(0, 1), cA + hstep, voffA);
        if (wr == 1) PG8_BAR;
        PG8_WAIT_V(4); PG8_BAR;
        PG8_STAGE(PG8_SB(1, 0), cB + kstep, voffB); PG8_STAGE(PG8_SA(1, 0), cA + kstep, voffA); PG8_STAGE(PG8_SB(1, 1), cB + hstep + kstep, voffB);
        PG8_WAIT_V(6); PG8_BAR;
    }
    for (;;) {
        const bool has_next = S.next(ui + 1, nxt);
        const char* nA = has_next ? (const char*)g.A + (size_t)nxt.pm * tstep : cA; const char* nB = has_next ? (const char*)g.Bt + (size_t)nxt.pn * tstep : cB;
        for (int t = 0; t < nt; t += 2) {
            const bool last = (t == nt - 2);
            const char* a1 = cA + (size_t)(t + 1) * kstep;
            const char* a2 = last ? nA : cA + (size_t)(t + 2) * kstep; const char* b2 = last ? nB : cB + (size_t)(t + 2) * kstep;
            const char* a3 = a2 + kstep; const char* b3 = b2 + kstep;
            if (last && has_next) S.a_ready(nxt);
            if constexpr (SP2) {
            PG8_LDB(B0, 0, 0); PG8_LDB(B1, 0, 1); PG8_SCHED; PG8_LDA(At, 0, 0); PG8_STAGE(PG8_SA(1, 1), a1 + hstep, voffA);
            PG8_WAIT_V(8); PG8_WAIT_L(0); PG8_BAR; PG8_MMA(0, 0, At, B0); PG8_MMA(0, 1, At, B1); PG8_BAR; PG8_SCHED;
            PG8_LDA(At, 0, 1); PG8_STAGE(PG8_SB(0, 0), b2, voffB); PG8_STAGE(PG8_SB(0, 1), b2 + hstep, voffB); PG8_STAGE(PG8_SA(0, 0), a2, voffA);
            PG8_WAIT_V(8); PG8_WAIT_L(0); PG8_BAR; PG8_MMA(1, 0, At, B0); PG8_MMA(1, 1, At, B1); PG8_BAR; PG8_SCHED;
            PG8_LDB(B0, 1, 0); PG8_LDB(B1, 1, 1); PG8_SCHED; PG8_LDA(At, 1, 0); PG8_STAGE(PG8_SA(0, 1), a2 + hstep, voffA);
            PG8_WAIT_V(8); PG8_WAIT_L(0); PG8_BAR; PG8_MMA(0, 0, At, B0); PG8_MMA(0, 1, At, B1); PG8_BAR; PG8_SCHED;
            PG8_LDA(At, 1, 1); PG8_STAGE(PG8_SB(1, 0), b3, voffB); PG8_STAGE(PG8_SB(1, 1), b3 + hstep, voffB); PG8_STAGE(PG8_SA(1, 0), a3, voffA);
            PG8_WAIT_V(8); PG8_WAIT_L(0); PG8_BAR; PG8_MMA(1, 0, At, B0); PG8_MMA(1, 1, At, B1); PG8_BAR; PG8_SCHED;
            } else {
            PG8_LDB(B0, 0, 0); PG8_SCHED; PG8_LDA(At, 0, 0); PG8_STAGE(PG8_SA(1, 1), a1 + hstep, voffA);
            PG8_WAIT_L(8); PG8_BAR; PG8_WAIT_L(0); PG8_MMA(0, 0, At, B0); PG8_BAR; PG8_SCHED;
            PG8_LDB(B1, 0, 1); PG8_STAGE(PG8_SB(0, 0), b2, voffB);
            PG8_BAR; PG8_WAIT_L(0); PG8_MMA(0, 1, At, B1); PG8_BAR;
            PG8_LDA(At, 0, 1); PG8_STAGE(PG8_SA(0, 0), a2, voffA);
            PG8_BAR; PG8_WAIT_L(0); PG8_MMA(1, 0, At, B0); PG8_BAR; PG8_SCHED;
            PG8_STAGE(PG8_SB(0, 1), b2 + hstep, voffB);
            PG8_WAIT_V(6); PG8_BAR; PG8_MMA(1, 1, At, B1); PG8_BAR;
            PG8_LDB(B0, 1, 0); PG8_SCHED; PG8_LDA(At, 1, 0); PG8_STAGE(PG8_SA(0, 1), a2 + hstep, voffA);
            PG8_WAIT_L(8); PG8_BAR; PG8_WAIT_L(0); PG8_MMA(0, 0, At, B0); PG8_BAR; PG8_SCHED;
            PG8_LDB(B1, 1, 1); PG8_STAGE(PG8_SB(1, 0), b3, voffB);
            PG8_BAR; PG8_WAIT_L(0); PG8_MMA(0, 1, At, B1); PG8_BAR;
            PG8_LDA(At, 1, 1); PG8_STAGE(PG8_SA(1, 0), a3, voffA);
            PG8_BAR; PG8_WAIT_L(0); PG8_MMA(1, 0, At, B0); PG8_BAR; PG8_SCHED;
            PG8_STAGE(PG8_SB(1, 1), b3 + hstep, voffB);
            PG8_WAIT_V(6); PG8_BAR; PG8_MMA(1, 1, At, B1); PG8_BAR;
            }
        }
        if constexpr (ALIGN_EPI) { if (wr == 0) PG8_BAR; }
        if constexpr (!Epi::AFTER_DRAIN) { E(acc, cur, ui, wr, wc, fr, fq); S.done(cur); }
        if (!has_next) break;
#pragma unroll
        for (int a = 0; a < 2; ++a)
#pragma unroll
            for (int b = 0; b < 2; ++b)
#pragma unroll
                for (int m = 0; m < 4; ++m)
#pragma unroll
                    for (int n = 0; n < 2; ++n) acc[a][b][m][n] = (f32x4){0.f, 0.f, 0.f, 0.f};
        cur = nxt; cA = nA; cB = nB; ++ui;
        if constexpr (ALIGN_EPI) { if (wr == 1) PG8_BAR; }
    }
    PG8_WAIT_V(0);
    if constexpr (!ALIGN_EPI) { if (wr == 0) PG8_BAR; }
    PG8_BAR;
    if constexpr (Epi::AFTER_DRAIN) { E.fused(acc, cur, wr, wc, fr, fq, lds, wid, lane); S.done(cur); }
#undef PG8_SA
#undef PG8_SB
#undef PG8_STAGE
#undef PG8_LDA
#undef PG8_LDB
#undef PG8_MMA
#undef PG8_WAIT_V
#undef PG8_WAIT_L
#undef PG8_BAR
#undef PG8_SCHED
}
}

constexpr int NWAVES = 8;
constexpr int BATCH = 8, SEQ = 4096, DM = 1024, NHEAD = 16, FF = 4096, DEPTH = 2;
constexpr int M = BATCH * SEQ;
constexpr int NIN = 3462, NINP = 3584;
constexpr float EPS = 1e-6f, LOG2E = 1.4426950408889634f;
#ifndef MK_ONE_LAUNCH
#define MK_ONE_LAUNCH 1
#endif
constexpr int NPH = 1 + 6 * DEPTH;

constexpr size_t MiB = 1u << 20;
constexpr size_t WS_CTL = 0, CTL_ZERO_BYTES = 1 * MiB;
constexpr size_t WS_W = 2 * MiB, W_LAYER = 25 * MiB, W_IN = 0, W_OUT = 7 * MiB, W_UP = 9 * MiB, W_DOWN = 17 * MiB;
constexpr size_t WS_SSQ = 52 * MiB;
constexpr size_t WS_LS = 54 * MiB;
constexpr size_t WS_KMP = 55 * MiB;
constexpr size_t WS_XB = 64 * MiB;
constexpr size_t WS_Q = 128 * MiB, WS_K = 192 * MiB, WS_V = 256 * MiB, WS_O = 320 * MiB;
constexpr size_t WS_Y = WS_Q;
constexpr size_t WS_H = 128 * MiB;
constexpr size_t WS_GF = 384 * MiB;
constexpr size_t WS_LD = 56 * MiB;
constexpr size_t WS_OD = 408 * MiB;
constexpr size_t WS_END = 480 * MiB;
constexpr int CW_BAR = 4096;

constexpr int RING_OFF = 0, RING_BYTES = 131072;
constexpr int LDSCTL_OFF = RING_BYTES, MISC_OFF = LDSCTL_OFF + 320;
constexpr int LDS_BYTES = 147456;

#define GAS __attribute__((address_space(1)))
#define LAS __attribute__((address_space(3)))
typedef unsigned short bf16;
typedef unsigned v4u __attribute__((ext_vector_type(4)));
typedef float f32x4 __attribute__((ext_vector_type(4)));
typedef GAS unsigned gu32;
#define RLX_AGENT __ATOMIC_RELAXED, __HIP_MEMORY_SCOPE_AGENT
#define LDS_WAIT() asm volatile("s_waitcnt lgkmcnt(0)" ::: "memory")
#define VM_WAIT() asm volatile("s_waitcnt vmcnt(0)" ::: "memory")
__device__ __forceinline__ unsigned f2bf(float f) { unsigned u = __builtin_bit_cast(unsigned, f); return (u + 0x7fffu + ((u >> 16) & 1u)) >> 16; }
__device__ __forceinline__ unsigned pk2(float lo, float hi) { return f2bf(lo) | (f2bf(hi) << 16); }
__device__ __forceinline__ float bflo(unsigned w) { return __builtin_bit_cast(float, w << 16); }
__device__ __forceinline__ float bfhi(unsigned w) { return __builtin_bit_cast(float, w & 0xffff0000u); }
#define XB_TMO      128
#define XB_XCNT(j)  (256  + 64 * (j))
#define XB_XSUB(j)  (1280 + 64 * (j))
#define XB_XGEN(j)  (2304 + 64 * (j))
#define XB_TOP      3328
#define XB_TOPGEN   3392
#define XCD_BAR_WORDS 3456
#define XB_SPIN_CAP (1u << 18)

__device__ __forceinline__ unsigned xb_ld(unsigned* p)              { return __hip_atomic_load(p, __ATOMIC_RELAXED, __HIP_MEMORY_SCOPE_AGENT); }
__device__ __forceinline__ unsigned xb_add(unsigned* p, unsigned v) { return __hip_atomic_fetch_add(p, v, __ATOMIC_RELAXED, __HIP_MEMORY_SCOPE_AGENT); }
__device__ __forceinline__ unsigned xb_xcc_id() { return (unsigned)__builtin_amdgcn_s_getreg((3 << 11) | 20) & 0xFu; }
#define XB_SPIN(cond, bar) do { unsigned _sp = 0; while (cond) { __builtin_amdgcn_s_sleep(1); \
    if ((++_sp & 255u) == 0u) { if (xb_ld(&(bar)[XB_TMO])) break; if (_sp > XB_SPIN_CAP) { atomicAdd(&(bar)[XB_TMO], 1u); break; } } } } while (0)

struct XcdBarrier {
    unsigned* bar; unsigned x;
    volatile LAS unsigned* st;
};

__device__ __forceinline__ XcdBarrier xcd_barrier_post(unsigned* bar, volatile LAS unsigned* st) {
    XcdBarrier b; b.bar = bar; b.x = xb_xcc_id(); b.st = st;
    if (threadIdx.x == 0) (void)xb_add(&bar[XB_XCNT(b.x)], 1u);
    return b;
}
__device__ __forceinline__ void xcd_barrier_complete(unsigned* bar, unsigned x, unsigned& nloc, unsigned& nx) {
    const unsigned G = gridDim.x * gridDim.y * gridDim.z;
    unsigned sum, cnt, mine, sp = 0u;
    for (;;) {
        sum = 0u; cnt = 0u; mine = 0u;
#pragma unroll
        for (unsigned j = 0; j < 16; ++j) { const unsigned c = xb_ld(&bar[XB_XCNT(j)]); sum += c; cnt += (c > 0u) ? 1u : 0u; mine = (j == x) ? c : mine; }
        if (sum == G) break;
        __builtin_amdgcn_s_sleep(1);
        if ((++sp & 255u) == 0u) { if (xb_ld(&bar[XB_TMO])) break; if (sp > XB_SPIN_CAP) { atomicAdd(&bar[XB_TMO], 1u); break; } }
    }
    nloc = mine > 0u ? mine : 1u; nx = cnt > 0u ? cnt : 1u;
}

__device__ __forceinline__ void xcd_barrier(const XcdBarrier& b, const int tid_x) {
    asm volatile("s_waitcnt vmcnt(0)" ::: "memory");
    __syncthreads();
    if (tid_x == 0) {
        unsigned* bar = b.bar;
        __builtin_amdgcn_s_waitcnt(0);
        unsigned nloc = b.st[0], nx = b.st[1];
        if (nloc == 0u) { xcd_barrier_complete(bar, b.x, nloc, nx); b.st[0] = nloc; b.st[1] = nx; }
        const unsigned old = xb_add(&bar[XB_XSUB(b.x)], 1u);
        const unsigned gen = old / nloc;
        if (old + 1u == (gen + 1u) * nloc) {
            __builtin_amdgcn_fence(__ATOMIC_RELEASE, "agent");
            asm volatile("s_waitcnt vmcnt(0)" ::: "memory");
            const unsigned og = xb_add(&bar[XB_TOP], 1u);
            const unsigned tg = og / nx;
            if (og + 1u == (tg + 1u) * nx) xb_add(&bar[XB_TOPGEN], 1u);
            else XB_SPIN(xb_ld(&bar[XB_TOPGEN]) == tg, bar);
            __builtin_amdgcn_fence(__ATOMIC_ACQUIRE, "agent");
            xb_add(&bar[XB_XGEN(b.x)], 1u);
            asm volatile("s_waitcnt vmcnt(0)" ::: "memory");
        } else {
            XB_SPIN(xb_ld(&bar[XB_XGEN(b.x)]) == gen, bar);
            __builtin_amdgcn_fence(__ATOMIC_ACQUIRE, "agent");
            asm volatile("s_waitcnt vmcnt(0)" ::: "memory");
        }
    }
    __syncthreads();
}

namespace att {
typedef unsigned short bf16;
using bf16x8 = __attribute__((ext_vector_type(8))) short;
using s16x4 = __attribute__((ext_vector_type(4))) short;
using f32x16 = __attribute__((ext_vector_type(16))) float;
using f32x4 = __attribute__((ext_vector_type(4))) float;
using u32x4 = __attribute__((ext_vector_type(4))) unsigned;
typedef __attribute__((address_space(3))) const char* lds_cptr;
typedef __attribute__((address_space(3))) float* lds_fptr;
typedef short v4i16_t __attribute__((ext_vector_type(4)));
constexpr int SLOTB = 8192, LDS_K = 0, LDS_V = 3 * SLOTB, LDS_WS = 6 * SLOTB, LDS_OST = LDS_WS + 8 * 256, LDS_X = LDS_OST + 8 * 4096, LDS_X2 = LDS_X + 16384, LDS_END = LDS_X2 + 1024;
constexpr int DMP = 1024;
#define ATT_WAIT_BAR(N) asm volatile("s_waitcnt vmcnt(" #N ") lgkmcnt(0)\n\ts_barrier" ::: "memory")
__device__ __forceinline__ void glds16(const void* gsrc, unsigned lds_dst) { unsigned keep;
    asm volatile("s_mov_b32 %0, m0\n\ts_mov_b32 m0, %2\n\ts_nop 0\n\tglobal_load_lds_dwordx4 %1, off\n\ts_mov_b32 m0, %0" : "=&s"(keep) : "v"(gsrc), "s"(lds_dst) : "memory"); }
typedef float f32x2_t __attribute__((ext_vector_type(2))); typedef __bf16 bf16x2_t __attribute__((ext_vector_type(2)));
__device__ __forceinline__ unsigned cvtpk(float lo, float hi) { f32x2_t v = {lo, hi}; bf16x2_t b = __builtin_convertvector(v, bf16x2_t); return __builtin_bit_cast(unsigned, b); }
__device__ __forceinline__ s16x4 vtr(lds_cptr p) { return __builtin_bit_cast(s16x4, __builtin_amdgcn_ds_read_tr16_b64_v4i16((__attribute__((address_space(3))) v4i16_t*)p)); }
__device__ __forceinline__ int crow(int r, int hi) { return (r & 3) + 8 * (r >> 2) + 4 * hi; }
#define ATT_NEG (-INFINITY)

struct UnitIO {
    const bf16* Q; long qstride;
    const bf16* K0; const bf16* V0; long kstride;
    bf16* O; long ostride;
    float* L; long lstride;
    bool norm;
};
struct BiasMoba {
    float slope2, tqf; int qrel, hi, w, nb0; unsigned selmask;
    __device__ __forceinline__ bool active(int t) const { return t < nb0 || (t - nb0) <= (w >> 1); }
    __device__ __forceinline__ void init(f32x16& c0, f32x16& c1, int t) const {
        float base = slope2 * ((float)(64 * t + 4 * hi) - tqf);
        if (t < nb0) { if (!((selmask >> (t >> 2)) & 1u)) base = ATT_NEG;
#pragma unroll
            for (int r = 0; r < 16; ++r) { const float v = base + slope2 * (float)((r & 3) + 8 * (r >> 2)); c0[r] = v; c1[r] = v + 32.0f * slope2; }
        } else { const int kb = 64 * (t - nb0) + 4 * hi;
#pragma unroll
            for (int r = 0; r < 16; ++r) { const int kv = kb + (r & 3) + 8 * (r >> 2); const float v = base + slope2 * (float)((r & 3) + 8 * (r >> 2)); c0[r] = kv > qrel ? ATT_NEG : v; c1[r] = kv + 32 > qrel ? ATT_NEG : v + 32.0f * slope2; }
        }
    }
};
struct BiasFox {
    lds_fptr cs2; float base; int qrel, hi, w, nb0;
    __device__ __forceinline__ bool active(int t) const { return t < nb0 || (t - nb0) <= (w >> 1); }
    __device__ __forceinline__ void init(f32x16& c0, f32x16& c1, int t) const {
        const lds_fptr p = cs2 + 64 * t + 4 * hi;
#pragma unroll
        for (int g = 0; g < 4; ++g) { const f32x4 a = *(const __attribute__((address_space(3))) f32x4*)(p + 8 * g), b = *(const __attribute__((address_space(3))) f32x4*)(p + 32 + 8 * g);
#pragma unroll
            for (int e = 0; e < 4; ++e) { c0[4 * g + e] = base - a[e]; c1[4 * g + e] = base - b[e]; } }
        if (t >= nb0) { const int kb = 64 * (t - nb0) + 4 * hi;
#pragma unroll
            for (int r = 0; r < 16; ++r) { const int kv = kb + (r & 3) + 8 * (r >> 2); if (kv > qrel) c0[r] = ATT_NEG; if (kv + 32 > qrel) c1[r] = ATT_NEG; } }
    }
};
struct BiasDil {
    float sd; int qrel, hi, w;
    __device__ __forceinline__ bool active(int t) const { return t >= (w >> 1) && t <= (w >> 1) + 2; }
    __device__ __forceinline__ void init(f32x16& c0, f32x16& c1, int t) const {
        const int kb = 64 * t + 4 * hi;
#pragma unroll
        for (int r = 0; r < 16; ++r) { const int off = qrel - (kb + (r & 3) + 8 * (r >> 2)); const float v = -sd * (float)off;
            c0[r] = ((unsigned)off <= 128u) ? v : ATT_NEG; c1[r] = ((unsigned)(off - 32) <= 128u) ? v + 32.0f * sd : ATT_NEG; }
    }
};

template <class BIAS>
__device__ __forceinline__ void attn_tiles(char* shm, const UnitIO& io, int t_begin, int t_end, const BIAS& B, int tid) {
    const int lane = tid & 63, r32 = lane & 31, hi = lane >> 5; const int wid = __builtin_amdgcn_readfirstlane(tid >> 6);
    const unsigned lds0 = (unsigned)(uintptr_t)shm;
    const bf16* ksrc = io.K0 + (long)lane * io.kstride + wid * 8;
    const bf16* vsrc = io.V0 + (long)(16 * (wid & 3) + (lane >> 2)) * io.kstride + (wid >> 2) * 32 + (lane & 3) * 8;
    const unsigned kdst = lds0 + LDS_K + wid * 1024, vdst = lds0 + LDS_V + wid * 1024;
    const long tstep = 64 * io.kstride;
#define ATT_DMA(t, slot) do { glds16(ksrc + (long)(t) * tstep, (unsigned)__builtin_amdgcn_readfirstlane(kdst + (slot))); glds16(vsrc + (long)(t) * tstep, (unsigned)__builtin_amdgcn_readfirstlane(vdst + (slot))); } while (0)
    const lds_cptr shm3 = (lds_cptr)shm;
    const lds_cptr kp0 = shm3 + LDS_K + hi * 1024 + r32 * 16;
    const lds_cptr vp0 = shm3 + LDS_V + ((lane >> 4) & 1) * 32 + (lane & 3) * 8 + (4 * hi + ((lane & 15) >> 2)) * 64;
    float* wsf = (float*)(shm + LDS_WS) + wid * 64;
    if (t_begin < t_end) { ATT_DMA(t_begin, 0); if (t_begin + 1 < t_end) ATT_DMA(t_begin + 1, SLOTB); }
    bf16x8 qr[4];
    { const bf16* qp = io.Q + (long)r32 * io.qstride + hi * 8;
#pragma unroll
      for (int d0 = 0; d0 < 4; ++d0) qr[d0] = *reinterpret_cast<const bf16x8*>(qp + d0 * 16); }
    f32x16 o[2]; o[0] = f32x16{}; o[1] = f32x16{}; float l_reg = 0.f;
    ATT_WAIT_BAR(0);
    int sl_c = 0, sl_n = SLOTB, sl_nn = 2 * SLOTB;
#pragma unroll 1
    for (int t = t_begin; t < t_end; ++t) {
        const bool more = (t + 2 < t_end);
        if (more) ATT_DMA(t + 2, sl_nn);
        if (B.active(t)) {
            f32x16 c0, c1; B.init(c0, c1, t);
            bf16x8 kf[8]; const lds_cptr kp = kp0 + sl_c;
#pragma unroll
            for (int j = 0; j < 4; ++j) { kf[2 * j] = *(const __attribute__((address_space(3))) bf16x8*)(kp + j * 2048); kf[2 * j + 1] = *(const __attribute__((address_space(3))) bf16x8*)(kp + j * 2048 + 512); }
#pragma unroll
            for (int d0 = 0; d0 < 4; ++d0) { c0 = __builtin_amdgcn_mfma_f32_32x32x16_bf16(kf[2 * d0], qr[d0], c0, 0, 0, 0); c1 = __builtin_amdgcn_mfma_f32_32x32x16_bf16(kf[2 * d0 + 1], qr[d0], c1, 0, 0, 0); }
            float s0 = 0.f, s1 = 0.f;
#pragma unroll
            for (int r = 0; r < 16; ++r) { c0[r] = __builtin_amdgcn_exp2f(c0[r]); c1[r] = __builtin_amdgcn_exp2f(c1[r]); s0 += c0[r]; s1 += c1[r]; }
            l_reg += s0 + s1;
            u32x4 pw[4];
#pragma unroll
            for (int i = 0; i < 4; ++i) { pw[0][i] = cvtpk(c0[2 * i], c0[2 * i + 1]); pw[1][i] = cvtpk(c0[8 + 2 * i], c0[9 + 2 * i]); pw[2][i] = cvtpk(c1[2 * i], c1[2 * i + 1]); pw[3][i] = cvtpk(c1[8 + 2 * i], c1[9 + 2 * i]); }
            const lds_cptr vp = vp0 + sl_c;
#pragma unroll
            for (int dh = 0; dh < 2; ++dh)
#pragma unroll
                for (int ks = 0; ks < 4; ++ks) { const s16x4 lo = vtr(vp + dh * 4096 + ks * 1024), hh = vtr(vp + dh * 4096 + ks * 1024 + 512);
                    const bf16x8 vf = (bf16x8){lo[0], lo[1], lo[2], lo[3], hh[0], hh[1], hh[2], hh[3]};
                    o[dh] = __builtin_amdgcn_mfma_f32_32x32x16_bf16(__builtin_bit_cast(bf16x8, pw[ks]), vf, o[dh], 0, 0, 0); }
        }
        if (more) ATT_WAIT_BAR(2); else ATT_WAIT_BAR(0);
        const int tmp = sl_c; sl_c = sl_n; sl_n = sl_nn; sl_nn = tmp;
    }
#undef ATT_DMA
    { auto rr = __builtin_amdgcn_permlane32_swap(__float_as_uint(l_reg), __float_as_uint(l_reg), false, false); l_reg = __uint_as_float(rr[0]) + __uint_as_float(rr[1]); }
    if (hi == 0) wsf[32 + r32] = l_reg;
    asm volatile("s_waitcnt lgkmcnt(0)" ::: "memory");
    float rli[16];
#pragma unroll
    for (int r = 0; r < 16; ++r) rli[r] = io.norm ? __builtin_amdgcn_rcpf(wsf[32 + crow(r, hi)]) : 1.0f;
    if (!io.norm && hi == 0) io.L[(long)r32 * io.lstride] = l_reg;
    { bf16* stg = (bf16*)(shm + LDS_OST) + wid * 2048;
#pragma unroll
      for (int r = 0; r < 16; ++r) { const int orow = crow(r, hi);
#pragma unroll
          for (int d0 = 0; d0 < 2; ++d0) stg[orow * 64 + d0 * 32 + r32] = (bf16)(cvtpk(o[d0][r] * rli[r], 0.f) & 0xffffu); }
      asm volatile("s_waitcnt lgkmcnt(0)" ::: "memory");
#pragma unroll
      for (int i = 0; i < 4; ++i) { const int row = i * 8 + (lane >> 3), ch = lane & 7; const u32x4 v = *(const u32x4*)(stg + row * 64 + ch * 8); *(u32x4*)(io.O + (long)row * io.ostride + ch * 8) = v; } }
    asm volatile("s_waitcnt lgkmcnt(0)" ::: "memory");
}
}

struct Frame {
    LAS unsigned char* lds;
    volatile LAS unsigned* MISC;
    gu32* ctl;
    int tid, lane, wave;
    int vcu, G;
};
struct Ptrs {
    const float *x, *attn_norm, *w_in, *b_forget, *q_gain, *k_gain, *out_gain, *w_out, *mlp_norm, *w_up, *w_down;
    float* out; unsigned char* ws;
};

__device__ __forceinline__ float wave_sum(float v) {
#pragma unroll
    for (int o = 1; o < 64; o <<= 1) v += __shfl_xor(v, o);
    return v;
}

__device__ __forceinline__ int win_src(int cp) {
    const int tile = cp >> 8, within = cp & 255;
    if (tile < 12) { const int bj = within >> 7, wc = (within >> 5) & 3, j = within & 31; return tile * 256 + 64 * wc + 32 * bj + j; }
    if (tile == 12) return 3078 + within;
    if (within < 128) return 3078 + 256 + within;
    if (within < 134) return 3072 + (within - 128);
    return -1;
}
template <int MODE>
__device__ __forceinline__ void transpose_item(const float* W, int K, int N, const float* gain, bf16* WT, LAS float* scr, int item, int nblk, int lane) {
    const int kb = item / nblk, nb = item % nblk, k0 = 64 * kb, n0 = 32 * nb;
    const int sc = (MODE == 0) ? win_src(n0 + (lane & 31)) : (n0 + (lane & 31));
#pragma unroll 8
    for (int i = 0; i < 32; ++i) { const int kk = 2 * i + (lane >> 5); float v = 0.f; if (sc >= 0) { v = W[(size_t)(k0 + kk) * N + sc]; if (gain) v *= gain[k0 + kk]; } scr[kk * 33 + (lane & 31)] = v; }
    LDS_WAIT(); asm volatile("" ::: "memory");
    const int c = lane & 7;
#pragma unroll
    for (int j = 0; j < 4; ++j) { const int n = (lane >> 3) + 8 * j; const LAS float* s = scr + (8 * c) * 33 + n;
        v4u o; o.x = pk2(s[0 * 33], s[1 * 33]); o.y = pk2(s[2 * 33], s[3 * 33]); o.z = pk2(s[4 * 33], s[5 * 33]); o.w = pk2(s[6 * 33], s[7 * 33]);
        *(GAS v4u*)(WT + (size_t)(n0 + n) * K + k0 + 8 * c) = o; }
    LDS_WAIT(); asm volatile("" ::: "memory");
}
__device__ __forceinline__ void p0_prologue(Frame& F, const Ptrs& P) {
    LAS float* scr = (LAS float*)(F.lds + RING_OFF + F.wave * 16384);
    const int gw = F.vcu * NWAVES + F.wave, NGW = F.G * NWAVES;
    constexpr int I_IN = (DM / 64) * (NINP / 32), I_OUT = (DM / 64) * (DM / 32), I_UP = (DM / 64) * (FF / 32), I_DN = (FF / 64) * (DM / 32);
    constexpr int I_LAYER = I_IN + I_OUT + I_UP + I_DN;
    for (int it = gw; it < DEPTH * I_LAYER; it += NGW) {
        const int l = it / I_LAYER; int r = it % I_LAYER;
        unsigned char* wl = P.ws + WS_W + (size_t)l * W_LAYER;
        if (r < I_IN) { transpose_item<0>(P.w_in + (size_t)l * DM * NIN, DM, NIN, P.attn_norm + l * DM, (bf16*)(wl + W_IN), scr, r, NINP / 32, F.lane); continue; } r -= I_IN;
        if (r < I_OUT) { transpose_item<1>(P.w_out + (size_t)l * DM * DM, DM, DM, P.out_gain + l * DM, (bf16*)(wl + W_OUT), scr, r, DM / 32, F.lane); continue; } r -= I_OUT;
        if (r < I_UP) { transpose_item<1>(P.w_up + (size_t)l * DM * FF, DM, FF, P.mlp_norm + l * DM, (bf16*)(wl + W_UP), scr, r, FF / 32, F.lane); continue; } r -= I_UP;
        transpose_item<1>(P.w_down + (size_t)l * FF * DM, FF, DM, nullptr, (bf16*)(wl + W_DOWN), scr, r, DM / 32, F.lane);
    }
    bf16* XB = (bf16*)(P.ws + WS_XB); float* SSQ = (float*)(P.ws + WS_SSQ);
    for (int m = gw; m < M; m += NGW) {
        const GAS f32x4* xr = (const GAS f32x4*)(P.x + (size_t)m * DM) + F.lane;
        f32x4 v[4]; float s = 0.f;
#pragma unroll
        for (int j = 0; j < 4; ++j) { v[j] = xr[64 * j]; s += (v[j].x * v[j].x + v[j].y * v[j].y) + (v[j].z * v[j].z + v[j].w * v[j].w); }
        s = wave_sum(s);
        GAS unsigned long long* o8 = (GAS unsigned long long*)(XB + (size_t)m * DM) + F.lane;
#pragma unroll
        for (int j = 0; j < 4; ++j) o8[64 * j] = (unsigned long long)pk2(v[j].x, v[j].y) | ((unsigned long long)pk2(v[j].z, v[j].w) << 32);
        if (F.lane < 16) SSQ[(size_t)m * 16 + F.lane] = F.lane == 0 ? s : 0.f;
    }
}

__device__ __forceinline__ void unpack8(const v4u w, float* f) { f[0] = bflo(w.x); f[1] = bfhi(w.x); f[2] = bflo(w.y); f[3] = bfhi(w.y); f[4] = bflo(w.z); f[5] = bfhi(w.z); f[6] = bflo(w.w); f[7] = bfhi(w.w); }

struct AttnBufs { const bf16 *Q, *K, *V; bf16* O; bf16* OD; float* LD; const float* LS; const float* KMP; };
constexpr size_t OD_BRANCH = (size_t)M * 384, LD_BRANCH = (size_t)M * 8;

__device__ __forceinline__ void moba_unit(Frame& F, const AttnBufs& A, int b, int h, int qb) {
    char* shm = (char*)F.lds; const int tid = F.tid, lane = tid & 63, r32 = lane & 31, hi = lane >> 5, w = F.wave;
    LAS float* KM = (LAS float*)(F.lds + att::LDS_X);
    for (int i = tid; i < 1024; i += 512) { const int j = i >> 6, d = i & 63; float v = 0.f;
        if (j < qb) { const float* p = A.KMP + ((size_t)((b * 16 + j) * 4 + h) * 2) * 64 + d; v = p[0] + p[64]; } KM[i] = v; }
    const size_t row0 = (size_t)b * SEQ + qb * 256 + w * 32;
    const bf16* Qw = A.Q + row0 * DM + h * 64;
    float qf[32];
    { const bf16* qp = Qw + (size_t)r32 * DM + hi * 8;
#pragma unroll
      for (int d0 = 0; d0 < 4; ++d0) { const v4u wv = *(const v4u*)(qp + d0 * 16); unpack8(wv, qf + 8 * d0); } }
    __syncthreads();
    float g0 = -INFINITY, g1 = -INFINITY, g2 = -INFINITY; int i0 = -1, i1 = -1, i2 = -1;
#pragma unroll 1
    for (int j = 0; j < qb; ++j) {
        float dot = 0.f;
#pragma unroll
        for (int d0 = 0; d0 < 4; ++d0) { const f32x4 ka = *(const LAS f32x4*)(KM + j * 64 + d0 * 16 + hi * 8), kb = *(const LAS f32x4*)(KM + j * 64 + d0 * 16 + hi * 8 + 4);
#pragma unroll
            for (int e = 0; e < 4; ++e) { dot += qf[8 * d0 + e] * ka[e]; dot += qf[8 * d0 + 4 + e] * kb[e]; } }
        { auto rr = __builtin_amdgcn_permlane32_swap(__float_as_uint(dot), __float_as_uint(dot), false, false); dot = __uint_as_float(rr[0]) + __uint_as_float(rr[1]); }
        if (dot > g0) { g2 = g1; i2 = i1; g1 = g0; i1 = i0; g0 = dot; i0 = j; } else if (dot > g1) { g2 = g1; i2 = i1; g1 = dot; i1 = j; } else if (dot > g2) { g2 = dot; i2 = j; }
    }
    unsigned selmask = 0u; if (i0 >= 0) selmask |= 1u << i0; if (i1 >= 0) selmask |= 1u << i1; if (i2 >= 0) selmask |= 1u << i2;
    att::BiasMoba B; B.slope2 = exp2f(-8.0f * (float)(7 + h) / 10.0f) * LOG2E; B.qrel = w * 32 + r32; B.tqf = (float)(qb * 256 + B.qrel); B.hi = hi; B.w = w; B.nb0 = 4 * qb; B.selmask = selmask;
    att::UnitIO io; io.Q = Qw; io.qstride = DM; io.K0 = A.K + (size_t)b * SEQ * DM + h * 64; io.V0 = A.V + (size_t)b * SEQ * DM + h * 64; io.kstride = DM;
    io.O = A.O + row0 * DM + h * 64; io.ostride = DM; io.L = nullptr; io.lstride = 0; io.norm = true;
    att::attn_tiles(shm, io, 0, 4 * qb + 4, B, tid);
}
__device__ __forceinline__ void fox_unit(Frame& F, const AttnBufs& A, int b, int h, int qb) {
    char* shm = (char*)F.lds; const int tid = F.tid, lane = tid & 63, r32 = lane & 31, hi = lane >> 5, w = F.wave;
    LAS float* CS = (LAS float*)(F.lds + att::LDS_X); LAS float* WT = (LAS float*)(F.lds + att::LDS_X2);
    const int n = 256 * (qb + 1);
    const float* ls = A.LS + (size_t)(h - 4) * M + (size_t)b * SEQ;
    float v[8]; float run = 0.f;
    if (8 * tid < n) { const f32x4 a = *(const f32x4*)(ls + 8 * tid), c = *(const f32x4*)(ls + 8 * tid + 4);
        v[0] = a[0]; v[1] = a[1]; v[2] = a[2]; v[3] = a[3]; v[4] = c[0]; v[5] = c[1]; v[6] = c[2]; v[7] = c[3];
#pragma unroll
        for (int e = 0; e < 8; ++e) { run += v[e] * LOG2E; v[e] = run; } }
    else {
#pragma unroll
        for (int e = 0; e < 8; ++e) v[e] = 0.f; }
    float inc = run;
#pragma unroll
    for (int o = 1; o < 64; o <<= 1) { const float up = __shfl_up(inc, o); if (lane >= o) inc += up; }
    if (lane == 63) WT[w] = inc;
    __syncthreads();
    float woff = 0.f;
#pragma unroll
    for (int k = 0; k < 8; ++k) { const float tk = WT[k]; if (k < w) woff += tk; }
    const float excl = woff + inc - run;
    if (8 * tid < n) {
        *(LAS f32x4*)(CS + 8 * tid) = (f32x4){v[0] + excl, v[1] + excl, v[2] + excl, v[3] + excl}; *(LAS f32x4*)(CS + 8 * tid + 4) = (f32x4){v[4] + excl, v[5] + excl, v[6] + excl, v[7] + excl}; }
    __syncthreads();
    const int nb0 = 4 * qb; const float c_first = CS[qb * 256];
    int t_begin = 0;
    { bool skip = false; if (lane < nb0) skip = (c_first - CS[64 * lane + 63]) < -100.0f;
      const unsigned long long bm = __ballot(skip); t_begin = (int)__builtin_ctzll(~bm); if (t_begin > nb0) t_begin = nb0; }
    t_begin = __builtin_amdgcn_readfirstlane(t_begin);
    att::BiasFox B; B.cs2 = CS; B.qrel = w * 32 + r32; B.base = CS[qb * 256 + B.qrel]; B.hi = hi; B.w = w; B.nb0 = nb0;
    const size_t row0 = (size_t)b * SEQ + qb * 256 + w * 32;
    att::UnitIO io; io.Q = A.Q + row0 * DM + h * 64; io.qstride = DM; io.K0 = A.K + (size_t)b * SEQ * DM + h * 64; io.V0 = A.V + (size_t)b * SEQ * DM + h * 64; io.kstride = DM;
    io.O = A.O + row0 * DM + h * 64; io.ostride = DM; io.L = nullptr; io.lstride = 0; io.norm = true;
    att::attn_tiles(shm, io, t_begin, nb0 + 4, B, tid);
}
__device__ __forceinline__ void dil_unit(Frame& F, const AttnBufs& A, int b, int h, int g, int r, int c) {
    char* shm = (char*)F.lds; const int tid = F.tid, lane = tid & 63, r32 = lane & 31, hi = lane >> 5, w = F.wave;
    const int dil = (g == 0) ? 1 : (g == 1 ? 4 : 16);
    const int i0 = 256 * c;
    att::BiasDil B; B.sd = exp2f(-8.0f * (float)(h - 10 + 1) / 10.0f) * LOG2E * (float)dil; B.qrel = 128 + w * 32 + r32; B.hi = hi; B.w = w;
    const long tok_q0 = (long)b * SEQ + r + (long)dil * (i0 + w * 32);
    const long tok_k0 = (long)b * SEQ + r + (long)dil * (i0 - 128);
    att::UnitIO io; io.Q = A.Q + tok_q0 * DM + h * 64; io.qstride = (long)DM * dil; io.K0 = A.K + tok_k0 * DM + h * 64; io.V0 = A.V + tok_k0 * DM + h * 64; io.kstride = (long)DM * dil;
    io.O = A.OD + (size_t)g * OD_BRANCH + tok_q0 * 384 + (h - 10) * 64; io.ostride = (long)384 * dil; io.L = A.LD + (size_t)g * LD_BRANCH + tok_q0 * 8 + (h - 10); io.lstride = (long)8 * dil; io.norm = false;
    att::attn_tiles(shm, io, c == 0 ? 2 : 0, 6, B, tid);
}
__device__ __forceinline__ void attn_phase(Frame& F, const AttnBufs& A) {
    const int v = F.vcu, G = F.G;
    for (int i = v; i < 512; i += G) { const int k = i >> 8, j = i & 255, bh = j >> 3, s = j & 7; moba_unit(F, A, bh >> 2, bh & 3, k == 0 ? s : 15 - s); }
    for (int f = v; f < 768; f += G) { const int k = f >> 8, bhf = f >> 4, qb = ((f & 15) + 5 * k) & 15; fox_unit(F, A, bhf / 6, 4 + bhf % 6, qb); }
    for (int u = v; u < 2304; u += G) { const int bh6 = u / 48, rest = u % 48, g = rest >> 4, idx = rest & 15;
        const int r = (g == 0) ? 0 : (g == 1 ? (idx >> 2) : idx), c = (g == 0) ? idx : (g == 1 ? (idx & 3) : 0);
        dil_unit(F, A, bh6 / 6, 10 + bh6 % 6, g, r, c); }
}
__device__ __forceinline__ void norm_phase(Frame& F, const bf16* O, const bf16* GF, const bf16* OD, const float* LD, bf16* Y) {
    const int gw = F.vcu * NWAVES + F.wave, NGW = F.G * NWAVES, lane = F.lane;
    for (int m = gw; m < M; m += NGW) {
        float fa[8], fc[8];
        unpack8(*(const v4u*)(O + (size_t)m * DM + 8 * lane), fa);
        if (lane < 16) unpack8(*(const v4u*)(O + (size_t)m * DM + 512 + 8 * lane), fc);
        else {
            const int dc = 8 * lane - 128, hd = dc >> 6;
            float f0[8], f1[8], f2[8];
            unpack8(*(const v4u*)(OD + (size_t)m * 384 + dc), f0); unpack8(*(const v4u*)(OD + OD_BRANCH + (size_t)m * 384 + dc), f1); unpack8(*(const v4u*)(OD + 2 * OD_BRANCH + (size_t)m * 384 + dc), f2);
            const float lt = LD[(size_t)m * 8 + hd] + LD[LD_BRANCH + (size_t)m * 8 + hd] + LD[2 * LD_BRANCH + (size_t)m * 8 + hd];
            const float inv = 1.0f / lt;
#pragma unroll
            for (int e = 0; e < 8; ++e) fc[e] = (f0[e] + f1[e] + f2[e]) * inv;
        }
        float sa = 0.f, sc = 0.f;
#pragma unroll
        for (int e = 0; e < 8; ++e) { sa += fa[e] * fa[e]; sc += fc[e] * fc[e]; }
        const float s_moba = wave_sum(lane < 32 ? sa : 0.f), s_fox = wave_sum((lane >= 32 ? sa : 0.f) + (lane < 16 ? sc : 0.f)), s_dil = wave_sum(lane >= 16 ? sc : 0.f);
        const float r_moba = 1.0f / sqrtf(s_moba * (1.0f / 256.0f) + EPS), r_fox = 1.0f / sqrtf(s_fox * (1.0f / 384.0f) + EPS), r_dil = 1.0f / sqrtf(s_dil * (1.0f / 384.0f) + EPS);
        float ga[8], gc[8];
#pragma unroll
        for (int e = 0; e < 8; ++e) { ga[e] = 1.f; gc[e] = 1.f; }
        if (lane >= 32) unpack8(*(const v4u*)(GF + (size_t)m * 384 + 8 * lane - 256), ga);
        if (lane < 16) unpack8(*(const v4u*)(GF + (size_t)m * 384 + 256 + 8 * lane), gc);
        const float ra = lane < 32 ? r_moba : r_fox, rc = lane < 16 ? r_fox : r_dil;
        v4u ya, yc;
        ya.x = pk2(fa[0] * ra * ga[0], fa[1] * ra * ga[1]); ya.y = pk2(fa[2] * ra * ga[2], fa[3] * ra * ga[3]); ya.z = pk2(fa[4] * ra * ga[4], fa[5] * ra * ga[5]); ya.w = pk2(fa[6] * ra * ga[6], fa[7] * ra * ga[7]);
        yc.x = pk2(fc[0] * rc * gc[0], fc[1] * rc * gc[1]); yc.y = pk2(fc[2] * rc * gc[2], fc[3] * rc * gc[3]); yc.z = pk2(fc[4] * rc * gc[4], fc[5] * rc * gc[5]); yc.w = pk2(fc[6] * rc * gc[6], fc[7] * rc * gc[7]);
        *(v4u*)(Y + (size_t)m * DM + 8 * lane) = ya; *(v4u*)(Y + (size_t)m * DM + 512 + 8 * lane) = yc;
    }
}

struct Args { const float* in[11]; float* out; unsigned char* ws; int ph_lo, ph_hi; };
__global__ void __launch_bounds__(NWAVES * 64, 2) mk_fwd(Args args) {
    __shared__ __attribute__((aligned(16))) unsigned char lds[LDS_BYTES];
    for (int u = threadIdx.x; u < (LDS_BYTES - LDSCTL_OFF) / 4; u += NWAVES * 64) ((LAS unsigned*)((LAS unsigned char*)lds + LDSCTL_OFF))[u] = 0u;
    __syncthreads();
    const int lo = args.ph_lo, hi = args.ph_hi;
    XcdBarrier bar; bar.bar = (unsigned*)(args.ws + WS_CTL) + CW_BAR; bar.x = 0; bar.st = nullptr;
    if (hi - lo > 1) bar = xcd_barrier_post((unsigned*)(args.ws + WS_CTL) + CW_BAR, (volatile LAS unsigned*)((LAS unsigned char*)lds + MISC_OFF) + 8);
#pragma unroll 1
    for (int ph = lo; ph < hi; ++ph) {
        unsigned char* ws = args.ws; asm volatile("" : "+s"(ws));
        int tid_ = threadIdx.x; asm volatile("" : "+v"(tid_));
        int bid_ = blockIdx.x, G_ = gridDim.x; asm volatile("" : "+s"(bid_), "+s"(G_));
        Frame F;
        F.lds = (LAS unsigned char*)lds;
        F.MISC = (volatile LAS unsigned*)(F.lds + MISC_OFF);
        F.tid = tid_; F.lane = F.tid & 63; F.wave = __builtin_amdgcn_readfirstlane(F.tid >> 6);
        F.G = G_; F.vcu = (F.G % 8 == 0) ? (bid_ % 8) * (F.G / 8) + bid_ / 8 : bid_;
        F.ctl = (gu32*)(ws + WS_CTL);
        Ptrs P;
        P.x = args.in[0]; P.attn_norm = args.in[1]; P.w_in = args.in[2]; P.b_forget = args.in[3]; P.q_gain = args.in[4]; P.k_gain = args.in[5];
        P.out_gain = args.in[6]; P.w_out = args.in[7]; P.mlp_norm = args.in[8]; P.w_up = args.in[9]; P.w_down = args.in[10]; P.out = args.out; P.ws = ws;
        PG8_LAS float* tab = (PG8_LAS float*)(F.lds + pg8::TAB_OFF);
        if (ph == 0) { p0_prologue(F, P); }
        else {
            const int l = (ph - 1) / 6, k = (ph - 1) % 6;
            unsigned char* wl = ws + WS_W + (size_t)l * W_LAYER;
            bf16* XB = (bf16*)(ws + WS_XB);
            if (k == 0) {
                pg8::Gemm g{XB, (const bf16*)(wl + W_IN), M, NINP, DM}; pg8::StaticOrder S; S.init(M, NINP, F.G, bid_);
                pg8::EpiIn E{ws, P.b_forget + l * 6, tab};
                pg8::prep_tables(S, tab, ws, P.q_gain + l * 1024, P.k_gain + l * 1024, F.tid); __syncthreads();
                pg8::gemm_phase<pg8::EpiIn, pg8::StaticOrder, true, true>(F.lds + RING_OFF, g, S, E, F.tid);
            } else if (k == 1) {
                const AttnBufs AB{(const bf16*)(ws + WS_Q), (const bf16*)(ws + WS_K), (const bf16*)(ws + WS_V), (bf16*)(ws + WS_O), (bf16*)(ws + WS_OD), (float*)(ws + WS_LD), (const float*)(ws + WS_LS), (const float*)(ws + WS_KMP)};
                attn_phase(F, AB);
            } else if (k == 2) {
                norm_phase(F, (const bf16*)(ws + WS_O), (const bf16*)(ws + WS_GF), (const bf16*)(ws + WS_OD), (const float*)(ws + WS_LD), (bf16*)(ws + WS_Y));
            } else if (k == 4) {
                pg8::Gemm g{XB, (const bf16*)(wl + W_UP), M, FF, DM}; pg8::StaticOrder S; S.init(M, FF, F.G, bid_);
                pg8::EpiUp E{ws, tab};
                pg8::prep_tables(S, tab, ws, nullptr, nullptr, F.tid); __syncthreads();
                pg8::gemm_phase<pg8::EpiUp, pg8::StaticOrder, true, true>(F.lds + RING_OFF, g, S, E, F.tid);
            } else {
                const bool dn = (k == 5);
                pg8::Gemm g{dn ? (const bf16*)(ws + WS_H) : (const bf16*)(ws + WS_Y), (const bf16*)(wl + (dn ? W_DOWN : W_OUT)), M, DM, dn ? FF : DM};
                pg8::StaticOrder S; S.init(M, DM, F.G, bid_);
                pg8::EpiRes E{(l == 0 && !dn) ? P.x : P.out, P.out, ws};
                pg8::gemm_phase<pg8::EpiRes, pg8::StaticOrder, true, true>(F.lds + RING_OFF, g, S, E, F.tid);
            }
        }
        if (ph + 1 < hi) { XcdBarrier b2 = bar; asm volatile("" : "+s"(b2.bar)); xcd_barrier(b2, F.tid); }
    }
}

extern "C" void kernel_launch(void* const* d_in, const int* in_sizes, int n_in, void* d_out, int out_size, void* d_ws, size_t ws_size, hipStream_t stream) {
    static int grid = 0;
    if (grid == 0) {
        if (n_in != 11 || in_sizes[0] != M * DM || out_size != M * DM || ws_size < WS_END) { fprintf(stderr, "kernel_launch: unexpected shapes (n_in %d in0 %d out %d ws %zu)\n", n_in, n_in > 0 ? in_sizes[0] : -1, out_size, ws_size); grid = -1; return; }
        int dev = 0, cus = 0, per_cu = 0;
        if (hipGetDevice(&dev) != hipSuccess || hipDeviceGetAttribute(&cus, hipDeviceAttributeMultiprocessorCount, dev) != hipSuccess) { grid = -1; return; }
        if (hipOccupancyMaxActiveBlocksPerMultiprocessor(&per_cu, (const void*)mk_fwd, NWAVES * 64, 0) != hipSuccess || per_cu < 1) { fprintf(stderr, "kernel_launch: occupancy query says %d blocks per CU\n", per_cu); (void)hipGetLastError(); grid = -1; return; }
        grid = cus;
    }
    if (grid < 0) return;
    (void)hipMemsetAsync((char*)d_ws + WS_CTL, 0, CTL_ZERO_BYTES, stream);
    Args a{};
    for (int i = 0; i < 11; ++i) a.in[i] = (const float*)d_in[i];
    a.out = (float*)d_out; a.ws = (unsigned char*)d_ws;
#if MK_ONE_LAUNCH
    a.ph_lo = 0; a.ph_hi = NPH;
    hipLaunchKernelGGL(mk_fwd, dim3(grid), dim3(NWAVES * 64), 0, stream, a);
#else
    for (int p = 0; p < NPH; ++p) { a.ph_lo = p; a.ph_hi = p + 1; hipLaunchKernelGGL(mk_fwd, dim3(grid), dim3(NWAVES * 64), 0, stream, a); }
#endif
}
```

```cpp
#include <hip/hip_runtime.h>
#include <cstdio>
#include <cstdint>
namespace pg8 {
#define PG8_LAS __attribute__((address_space(3)))
typedef unsigned short bf16_t;
typedef short bf16x8 __attribute__((ext_vector_type(8)));
typedef float f32x4 __attribute__((ext_vector_type(4)));
typedef unsigned u32x4 __attribute__((ext_vector_type(4)));
constexpr int BM = 256, BK = 64, HALF = 128, HTB = HALF * BK * 2  , STAGE_BYTES = 8 * HTB, NXCD = 8, WGM = 8;

__host__ __device__ __forceinline__ int lds_byte(int r, int c) { const int st = (r >> 4) * 2 + (c >> 5), rr = r & 15, cc = c & 31, ob = rr * 64 + cc * 2; return st * 1024 + (ob ^ (((ob >> 9) & 1) << 5)); }
__host__ __device__ __forceinline__ void stage_rc(int b, int& R, int& C) { const int st = b / 1024, sb = b % 1024, swz = sb ^ (((sb >> 9) & 1) << 5); R = (st >> 1) * 16 + swz / 64; C = (st & 1) * 32 + (swz % 64) / 2; }
__host__ __device__ __forceinline__ int perm32(int rho) { const int n = rho >> 4, i = rho & 15; return 8 * (i >> 2) + 4 * n + (i & 3); }

struct Unit { int pm, pn; };
struct Gemm { const bf16_t* A; const bf16_t* Bt; int M, N, K; };

struct StaticOrder {
    int nM, nN, nwg, G, c;
    __host__ __device__ void init(int M, int N, int G_, int c_) { nM = M / BM; nN = N / BM; nwg = nM * nN; G = G_; c = c_; }
    __host__ __device__ bool next(int i, Unit& u) const {
        const long L = (long)i * G + c; if (L >= nwg) return false;
        int wgid = (int)L; { const int q = nwg / NXCD, r = nwg % NXCD, xcd = wgid % NXCD, off = wgid / NXCD; wgid = (xcd < r ? xcd * (q + 1) : r * (q + 1) + (xcd - r) * q) + off; }
        const int nig = WGM * nN, gid = wgid / nig, fm = gid * WGM, gsz = (nM - fm) < WGM ? (nM - fm) : WGM;
        u.pm = fm + ((wgid % nig) % gsz); u.pn = (wgid % nig) / gsz; return true;
    }
    __device__ __forceinline__ void a_ready(const Unit&) const {}
    __device__ __forceinline__ void done(const Unit&) const {}
};


__device__ __forceinline__ unsigned cvt_pk_bf16(float lo, float hi) { unsigned r; asm volatile("v_cvt_pk_bf16_f32 %0, %1, %2" : "=v"(r) : "v"(lo), "v"(hi)); return r; }
constexpr float RMS_EPS = 1e-6f;
constexpr float QSCALE = 0.125f * 1.4426950408889634f;
constexpr int TAB_OFF = 131072 + 512, TAB_G = 2048;
constexpr size_t EMiB = 1u << 20;
constexpr size_t E_SSQ = 52 * EMiB, E_LS = 54 * EMiB, E_KMP = 55 * EMiB, E_PRM = 56 * EMiB, E_XB = 64 * EMiB, E_Q = 128 * EMiB, E_K = 192 * EMiB, E_V = 256 * EMiB, E_H = 128 * EMiB, E_GF = 384 * EMiB;
__device__ __forceinline__ float row_rstd(const float* ssq, unsigned row) {
    const float* p = ssq + (size_t)(row * 16u);
    const f32x4 a = *(const f32x4*)(p), b = *(const f32x4*)(p + 4), c = *(const f32x4*)(p + 8), d = *(const f32x4*)(p + 12);
    const float s = ((a[0] + a[1]) + (a[2] + a[3])) + ((b[0] + b[1]) + (b[2] + b[3])) + ((c[0] + c[1]) + (c[2] + c[3])) + ((d[0] + d[1]) + (d[2] + d[3]));
    return 1.0f / sqrtf(s * (1.0f / 1024.0f) + RMS_EPS);
}
template <class Sched>
__device__ __forceinline__ void prep_tables(const Sched& S, PG8_LAS float* tab, const unsigned char* ws, const float* qg, const float* kg  , int tid) {
    Unit u;
#pragma unroll 1
    for (int i = 0; i < 8 && S.next(i, u); ++i) {
        if (tid < 256) tab[i * 256 + tid] = row_rstd((const float*)(ws + E_SSQ), (unsigned)(u.pm * BM + tid));
        else if (qg && u.pn < 8) { const int c = tid - 256; tab[TAB_G + i * 256 + c] = (u.pn < 4 ? qg : kg)[(u.pn & 3) * 256 + c]; }
    }
}
#define PG8_PACK8(y0, y1) (u32x4){cvt_pk_bf16((y0)[0], (y0)[1]), cvt_pk_bf16((y0)[2], (y0)[3]), cvt_pk_bf16((y1)[0], (y1)[1]), cvt_pk_bf16((y1)[2], (y1)[3])}
struct EpiIn {
    static constexpr bool PERM = true, AFTER_DRAIN = false;
    unsigned char* ws; const float* bfg; PG8_LAS float* tab;
    __device__ __forceinline__ void operator()(const f32x4 (&acc)[2][2][4][2], const Unit& u, int ui, int wr, int wc, int fr, int fq) const {
        const int pn = u.pn; const unsigned row0 = (unsigned)(u.pm * BM + wr * 64 + fr);
        const PG8_LAS float* rsp = tab + ui * 256 + wr * 64 + fr;
        if (pn < 8) {
            const PG8_LAS float* gp = tab + TAB_G + ui * 256 + 64 * wc + 8 * fq;
            f32x4 g[2][2];
#pragma unroll
            for (int bj = 0; bj < 2; ++bj)
#pragma unroll
                for (int n = 0; n < 2; ++n) g[bj][n] = *(const PG8_LAS f32x4*)(gp + 32 * bj + 4 * n);
            unsigned char* dst = ws + (pn < 4 ? E_Q : E_K) + (size_t)(unsigned)(((pn & 3) * 256 + wc * 64 + 8 * fq) * 2);
            const float post = pn < 4 ? QSCALE : 1.0f;
            f32x4 ks[2][2];
#pragma unroll
            for (int bj = 0; bj < 2; ++bj)
#pragma unroll
                for (int n = 0; n < 2; ++n) ks[bj][n] = (f32x4){0.f, 0.f, 0.f, 0.f};
#pragma unroll
            for (int ai = 0; ai < 2; ++ai)
#pragma unroll
                for (int m = 0; m < 4; ++m) {
                    const unsigned row = row0 + ai * HALF + m * 16; const float rs = rsp[ai * HALF + m * 16];
                    f32x4 v[2][2]; float ss = 0.f;
#pragma unroll
                    for (int bj = 0; bj < 2; ++bj)
#pragma unroll
                        for (int n = 0; n < 2; ++n) { v[bj][n] = acc[ai][bj][m][n] * rs; const f32x4 x = v[bj][n]; ss += (x[0] * x[0] + x[1] * x[1]) + (x[2] * x[2] + x[3] * x[3]); }
                    ss += __shfl_xor(ss, 16); ss += __shfl_xor(ss, 32);
                    const float r2 = 1.0f / sqrtf(ss * (1.0f / 64.0f) + RMS_EPS);
#pragma unroll
                    for (int bj = 0; bj < 2; ++bj) {
                        const f32x4 y0 = v[bj][0] * r2 * g[bj][0], y1 = v[bj][1] * r2 * g[bj][1];
                        ks[bj][0] += y0; ks[bj][1] += y1;
                        const f32x4 z0 = y0 * post, z1 = y1 * post;
                        *(u32x4*)(dst + (size_t)(row * 2048u + 64u * bj)) = PG8_PACK8(z0, z1);
                    }
                }
            if (pn == 4) {
#pragma unroll
                for (int bj = 0; bj < 2; ++bj)
#pragma unroll
                    for (int n = 0; n < 2; ++n)
#pragma unroll
                        for (int e = 0; e < 4; ++e) { float s = ks[bj][n][e]; s += __shfl_xor(s, 1); s += __shfl_xor(s, 2); s += __shfl_xor(s, 4); s += __shfl_xor(s, 8); ks[bj][n][e] = s; }
                if (fr == 0) { float* kp = (float*)(ws + E_KMP) + (size_t)(unsigned)((((u.pm * 4 + wc) * 2 + wr) * 64 + 8 * fq));
#pragma unroll
                    for (int bj = 0; bj < 2; ++bj)
#pragma unroll
                        for (int n = 0; n < 2; ++n) *(f32x4*)(kp + 32 * bj + 4 * n) = ks[bj][n]; }
            }
        } else if (pn < 12) {
            unsigned char* dst = ws + E_V + (size_t)(unsigned)(((pn & 3) * 256 + wc * 64 + 8 * fq) * 2);
#pragma unroll
            for (int ai = 0; ai < 2; ++ai)
#pragma unroll
                for (int m = 0; m < 4; ++m) {
                    const unsigned row = row0 + ai * HALF + m * 16; const float rs = rsp[ai * HALF + m * 16];
#pragma unroll
                    for (int bj = 0; bj < 2; ++bj) { const f32x4 y0 = acc[ai][bj][m][0] * rs, y1 = acc[ai][bj][m][1] * rs;
                        *(u32x4*)(dst + (size_t)(row * 2048u + 64u * bj)) = PG8_PACK8(y0, y1); }
                }
        } else {
#pragma unroll
            for (int ai = 0; ai < 2; ++ai)
#pragma unroll
                for (int m = 0; m < 4; ++m) {
                    const unsigned row = row0 + ai * HALF + m * 16; const float rs = rsp[ai * HALF + m * 16];
#pragma unroll
                    for (int bj = 0; bj < 2; ++bj) {
                        const f32x4 y0 = acc[ai][bj][m][0] * rs, y1 = acc[ai][bj][m][1] * rs;
                        if (pn == 12 || bj == 0) {
                            const unsigned gcol = (unsigned)((pn == 12 ? 0 : 256) + 128 * bj + 32 * wc + 8 * fq);
                            f32x4 s0, s1;
#pragma unroll
                            for (int e = 0; e < 4; ++e) { s0[e] = 1.0f / (1.0f + __expf(-y0[e])); s1[e] = 1.0f / (1.0f + __expf(-y1[e])); }
                            *(u32x4*)(ws + E_GF + (size_t)((row * 384u + gcol) * 2u)) = PG8_PACK8(s0, s1);
                        } else if (wc == 0 && fq == 0) {
                            float z[6] = {y0[0], y0[1], y0[2], y0[3], y1[0], y1[1]};
#pragma unroll
                            for (int e = 0; e < 6; ++e) { const float zz = z[e] + bfg[e]; z[e] = fminf(zz, 0.f) - log1pf(__expf(-fabsf(zz))); }
                            float* lp = (float*)(ws + E_LS) + (size_t)row;
#pragma unroll
                            for (int e = 0; e < 6; ++e) lp[(size_t)(e * 32768u)] = z[e];
                        }
                    }
                }
        }
    }
};
struct EpiRes {
    static constexpr bool PERM = true, AFTER_DRAIN = false;
    float* out; unsigned char* ws; bool last;
    __device__ __forceinline__ void operator()(const f32x4 (&acc)[2][2][4][2], const Unit& u, int ui, int wr, int wc, int fr, int fq) const {
        const unsigned row0 = (unsigned)(u.pm * BM + wr * 64 + fr), col0 = (unsigned)(u.pn * BM + wc * 32 + 8 * fq);
#pragma unroll
        for (int ai = 0; ai < 2; ++ai) {
#pragma unroll
            for (int m = 0; m < 4; ++m) {
                const unsigned row = row0 + ai * HALF + m * 16; float ss = 0.f;
#pragma unroll
                for (int bj = 0; bj < 2; ++bj) {
                    const unsigned off = row * 1024u + col0 + bj * HALF;
                    const u32x4 xw = *(const u32x4*)(ws + E_XB + (size_t)(off * 2u));
                    f32x4 o0, o1;
                    o0[0] = __builtin_bit_cast(float, xw[0] << 16) + acc[ai][bj][m][0][0]; o0[1] = __builtin_bit_cast(float, xw[0] & 0xffff0000u) + acc[ai][bj][m][0][1];
                    o0[2] = __builtin_bit_cast(float, xw[1] << 16) + acc[ai][bj][m][0][2]; o0[3] = __builtin_bit_cast(float, xw[1] & 0xffff0000u) + acc[ai][bj][m][0][3];
                    o1[0] = __builtin_bit_cast(float, xw[2] << 16) + acc[ai][bj][m][1][0]; o1[1] = __builtin_bit_cast(float, xw[2] & 0xffff0000u) + acc[ai][bj][m][1][1];
                    o1[2] = __builtin_bit_cast(float, xw[3] << 16) + acc[ai][bj][m][1][2]; o1[3] = __builtin_bit_cast(float, xw[3] & 0xffff0000u) + acc[ai][bj][m][1][3];
                    if (last) { *(f32x4*)(out + (size_t)off) = o0; *(f32x4*)(out + (size_t)off + 4) = o1; }
                    else {
                        ss += ((o0[0] * o0[0] + o0[1] * o0[1]) + (o0[2] * o0[2] + o0[3] * o0[3])) + ((o1[0] * o1[0] + o1[1] * o1[1]) + (o1[2] * o1[2] + o1[3] * o1[3]));
                        *(u32x4*)(ws + E_XB + (size_t)(off * 2u)) = PG8_PACK8(o0, o1);
                    }
                }
                if (!last) { ss += __shfl_xor(ss, 16); ss += __shfl_xor(ss, 32);
                    if (fq == 0) ((float*)(ws + E_SSQ))[(size_t)(row * 16u + (unsigned)(u.pn * 4 + wc))] = ss; }
            }
            asm volatile("" ::: "memory");
        }
    }
};
struct EpiUp {
    static constexpr bool PERM = true, AFTER_DRAIN = false;
    unsigned char* ws; PG8_LAS float* tab;
    __device__ __forceinline__ void operator()(const f32x4 (&acc)[2][2][4][2], const Unit& u, int ui, int wr, int wc, int fr, int fq) const {
        const unsigned row0 = (unsigned)(u.pm * BM + wr * 64 + fr), col0 = (unsigned)(u.pn * BM + wc * 32 + 8 * fq);
        const PG8_LAS float* rsp = tab + ui * 256 + wr * 64 + fr;
#pragma unroll
        for (int ai = 0; ai < 2; ++ai)
#pragma unroll
            for (int m = 0; m < 4; ++m) {
                const unsigned row = row0 + ai * HALF + m * 16; const float rs = rsp[ai * HALF + m * 16];
#pragma unroll
                for (int bj = 0; bj < 2; ++bj) {
                    f32x4 y0 = acc[ai][bj][m][0] * rs, y1 = acc[ai][bj][m][1] * rs;
#pragma unroll
                    for (int e = 0; e < 4; ++e) { const float a = fmaxf(y0[e], 0.f), b = fmaxf(y1[e], 0.f); y0[e] = a * a; y1[e] = b * b; }
                    *(u32x4*)(ws + E_H + (size_t)((row * 4096u + col0 + bj * HALF) * 2u)) = PG8_PACK8(y0, y1);
                }
            }
    }
};

template <class Epi, class Sched, bool ALIGN_EPI = false, bool SP2 = false>
__device__ __forceinline__ void gemm_phase(PG8_LAS unsigned char* lds, const Gemm g, const Sched& S, const Epi& E, const int tid) {
    const int wid = __builtin_amdgcn_readfirstlane(tid >> 6), lane = tid & 63, wr = wid >> 2, wc = wid & 3, fr = lane & 15, fq = lane >> 4;
    const int K = g.K, nt = K / BK;
    unsigned voffA[2], voffB[2];
#pragma unroll
    for (int i = 0; i < 2; ++i) { int R, C; stage_rc(tid * 16 + i * 8192, R, C); const int Rb = Epi::PERM ? ((R & ~31) + perm32(R & 31)) : R;
        voffA[i] = (unsigned)(R * K + C) * 2u; voffB[i] = (unsigned)(Rb * K + C) * 2u; }
    const size_t kstep = (size_t)(BK * 2);
    const size_t hstep = (size_t)HALF * K * 2;
    const size_t tstep = 2 * hstep;
    const unsigned ldsw = (unsigned)wid * 1024u;
    const int aoff = lds_byte(wr * 64 + fr, fq * 8), boff = lds_byte(wc * 32 + fr, fq * 8);
#define PG8_SA(b, h) (((b) * 2 + (h)) * HTB)
#define PG8_SB(b, h) ((4 + (b) * 2 + (h)) * HTB)
#define PG8_STAGE(bufoff, gbase, voff) do { _Pragma("unroll") for (int _i = 0; _i < 2; ++_i) \
        __builtin_amdgcn_global_load_lds((const unsigned*)((const char*)(gbase) + (voff)[_i]), (PG8_LAS unsigned*)(lds + (bufoff) + ldsw + _i * 8192), 16, 0, 0); } while (0)
#define PG8_LDA(dst, b, h) do { _Pragma("unroll") for (int m = 0; m < 4; ++m) _Pragma("unroll") for (int k = 0; k < 2; ++k) dst[m][k] = *(const PG8_LAS bf16x8*)(lds + PG8_SA(b, h) + aoff + m * 2048 + k * 1024); } while (0)
#define PG8_LDB(dst, b, h) do { _Pragma("unroll") for (int n = 0; n < 2; ++n) _Pragma("unroll") for (int k = 0; k < 2; ++k) dst[n][k] = *(const PG8_LAS bf16x8*)(lds + PG8_SB(b, h) + boff + n * 2048 + k * 1024); } while (0)
#define PG8_MMA(ai, bj, At, Bt) do { __builtin_amdgcn_s_setprio(1); _Pragma("unroll") for (int m = 0; m < 4; ++m) _Pragma("unroll") for (int n = 0; n < 2; ++n) _Pragma("unroll") for (int k = 0; k < 2; ++k) \
        acc[ai][bj][m][n] = __builtin_amdgcn_mfma_f32_16x16x32_bf16(Bt[n][k], At[m][k], acc[ai][bj][m][n], 0, 0, 0); __builtin_amdgcn_s_setprio(0); } while (0)
#define PG8_WAIT_V(n) asm volatile("s_waitcnt vmcnt(" #n ")" ::: "memory")
#define PG8_WAIT_L(n) asm volatile("s_waitcnt lgkmcnt(" #n ")" ::: "memory")
#define PG8_BAR __builtin_amdgcn_s_barrier()
#define PG8_SCHED __builtin_amdgcn_sched_barrier(0)
    Unit cur, nxt; int ui = 0;
    if (!S.next(0, cur)) return;
    f32x4 acc[2][2][4][2];
#pragma unroll
    for (int a = 0; a < 2; ++a)
#pragma unroll
        for (int b = 0; b < 2; ++b)
#pragma unroll
            for (int m = 0; m < 4; ++m)
#pragma unroll
                for (int n = 0; n < 2; ++n) acc[a][b][m][n] = (f32x4){0.f, 0.f, 0.f, 0.f};
    bf16x8 At[4][2], B0[2][2], B1[2][2];
    const char* cA = (const char*)g.A + (size_t)cur.pm * tstep; const char* cB = (const char*)g.Bt + (size_t)cur.pn * tstep;
    S.a_ready(cur);
    if constexpr (SP2) {
        PG8_STAGE(PG8_SB(0, 0), cB, voffB); PG8_STAGE(PG8_SB(0, 1), cB + hstep, voffB); PG8_STAGE(PG8_SA(0, 0), cA, voffA); PG8_STAGE(PG8_SA(0, 1), cA + hstep, voffA);
        if (wr == 1) PG8_BAR;
        PG8_WAIT_V(2); PG8_BAR;
        PG8_STAGE(PG8_SB(1, 0), cB + kstep, voffB); PG8_STAGE(PG8_SA(1, 0), cA + kstep, voffA); PG8_STAGE(PG8_SB(1, 1), cB + hstep + kstep, voffB);
        PG8_WAIT_V(6); PG8_BAR;
    } else {
        PG8_STAGE(PG8_SB(0, 0), cB, voffB); PG8_STAGE(PG8_SA(0, 0), cA, voffA); PG8_STAGE(PG8_SB(0, 1), cB + hstep, voffB); PG8_STAGE(PG8_SA(0, 1), cA + hstep, voffA);
        if (wr == 1) PG8_BAR;
        PG8_WAIT_V(4); PG8_BAR;
        PG8_STAGE(PG8_SB(1, 0), cB + kstep, voffB); PG8_STAGE(PG8_SA(1, 0), cA + kstep, voffA); PG8_STAGE(PG8_SB(1, 1), cB + hstep + kstep, voffB);
        PG8_WAIT_V(6); PG8_BAR;
    }
    for (;;) {
        const bool has_next = S.next(ui + 1, nxt);
        const char* nA = has_next ? (const char*)g.A + (size_t)nxt.pm * tstep : cA; const char* nB = has_next ? (const char*)g.Bt + (size_t)nxt.pn * tstep : cB;
        for (int t = 0; t < nt; t += 2) {
            const bool last = (t == nt - 2);
            const char* a1 = cA + (size_t)(t + 1) * kstep;
            const char* a2 = last ? nA : cA + (size_t)(t + 2) * kstep; const char* b2 = last ? nB : cB + (size_t)(t + 2) * kstep;
            const char* a3 = a2 + kstep; const char* b3 = b2 + kstep;
            if (last && has_next) S.a_ready(nxt);
            if constexpr (SP2) {
            PG8_LDB(B0, 0, 0); PG8_LDB(B1, 0, 1); PG8_SCHED; PG8_LDA(At, 0, 0); PG8_STAGE(PG8_SA(1, 1), a1 + hstep, voffA);
            PG8_WAIT_V(8); PG8_WAIT_L(0); PG8_BAR; PG8_MMA(0, 0, At, B0); PG8_MMA(0, 1, At, B1); PG8_BAR; PG8_SCHED;
            PG8_LDA(At, 0, 1); PG8_STAGE(PG8_SB(0, 0), b2, voffB); PG8_STAGE(PG8_SB(0, 1), b2 + hstep, voffB); PG8_STAGE(PG8_SA(0, 0), a2, voffA);
            PG8_WAIT_V(8); PG8_WAIT_L(0); PG8_BAR; PG8_MMA(1, 0, At, B0); PG8_MMA(1, 1, At, B1); PG8_BAR; PG8_SCHED;
            PG8_LDB(B0, 1, 0); PG8_LDB(B1, 1, 1); PG8_SCHED; PG8_LDA(At, 1, 0); PG8_STAGE(PG8_SA(0, 1), a2 + hstep, voffA);
            PG8_WAIT_V(8); PG8_WAIT_L(0); PG8_BAR; PG8_MMA(0, 0, At, B0); PG8_MMA(0, 1, At, B1); PG8_BAR; PG8_SCHED;
            PG8_LDA(At, 1, 1); PG8_STAGE(PG8_SB(1, 0), b3, voffB); PG8_STAGE(PG8_SB(1, 1), b3 + hstep, voffB); PG8_STAGE(PG8_SA(1, 0), a3, voffA);
            PG8_WAIT_V(8); PG8_WAIT_L(0); PG8_BAR; PG8_MMA(1, 0, At, B0); PG8_MMA(1, 1, At, B1); PG8_BAR; PG8_SCHED;
            } else {
            PG8_LDB(B0, 0, 0); PG8_SCHED; PG8_LDA(At, 0, 0); PG8_STAGE(PG8_SA(1, 1), a1 + hstep, voffA);
            PG8_WAIT_L(8); PG8_BAR; PG8_WAIT_L(0); PG8_MMA(0, 0, At, B0); PG8_BAR; PG8_SCHED;
            PG8_LDB(B1, 0, 1); PG8_STAGE(PG8_SB(0, 0), b2, voffB);
            PG8_BAR; PG8_WAIT_L(0); PG8_MMA(0, 1, At, B1); PG8_BAR;
            PG8_LDA(At, 0, 1); PG8_STAGE(PG8_SA(0, 0), a2, voffA);
            PG8_BAR; PG8_WAIT_L(0); PG8_MMA(1, 0, At, B0); PG8_BAR; PG8_SCHED;
            PG8_STAGE(PG8_SB(0, 1), b2 + hstep, voffB);
            PG8_WAIT_V(6); PG8_BAR; PG8_MMA(1, 1, At, B1); PG8_BAR;
            PG8_LDB(B0, 1, 0); PG8_SCHED; PG8_LDA(At, 1, 0); PG8_STAGE(PG8_SA(0, 1), a2 + hstep, voffA);
            PG8_WAIT_L(8); PG8_BAR; PG8_WAIT_L(0); PG8_MMA(0, 0, At, B0); PG8_BAR; PG8_SCHED;
            PG8_LDB(B1, 1, 1); PG8_STAGE(PG8_SB(1, 0), b3, voffB);
            PG8_BAR; PG8_WAIT_L(0); PG8_MMA(0, 1, At, B1); PG8_BAR;
            PG8_LDA(At, 1, 1); PG8_STAGE(PG8_SA(1, 0), a3, voffA);
            PG8_BAR; PG8_WAIT_L(0); PG8_MMA(1, 0, At, B0); PG8_BAR; PG8_SCHED;
            PG8_STAGE(PG8_SB(1, 1), b3 + hstep, voffB);
            PG8_WAIT_V(6); PG8_BAR; PG8_MMA(1, 1, At, B1); PG8_BAR;
            }
        }
        if constexpr (ALIGN_EPI) { if (wr == 0) PG8_BAR; }
        if constexpr (!Epi::AFTER_DRAIN) { E(acc, cur, ui, wr, wc, fr, fq); S.done(cur); }
        if (!has_next) break;
#pragma unroll
        for (int a = 0; a < 2; ++a)
#pragma unroll
            for (int b = 0; b < 2; ++b)
#pragma unroll
                for (int m = 0; m < 4; ++m)
#pragma unroll
                    for (int n = 0; n < 2; ++n) acc[a][b][m][n] = (f32x4){0.f, 0.f, 0.f, 0.f};
        cur = nxt; cA = nA; cB = nB; ++ui;
        if constexpr (ALIGN_EPI) { if (wr == 1) PG8_BAR; }
    }
    PG8_WAIT_V(0);
    if constexpr (!ALIGN_EPI) { if (wr == 0) PG8_BAR; }
    PG8_BAR;
    if constexpr (Epi::AFTER_DRAIN) { E.fused(acc, cur, wr, wc, fr, fq, lds, wid, lane); S.done(cur); }
#undef PG8_SA
#undef PG8_SB
#undef PG8_STAGE
#undef PG8_LDA
#undef PG8_LDB
#undef PG8_MMA
#undef PG8_WAIT_V
#undef PG8_WAIT_L
#undef PG8_BAR
#undef PG8_SCHED
}
}

constexpr int NWAVES = 8;
constexpr int BATCH = 8, SEQ = 4096, DM = 1024, NHEAD = 16, FF = 4096, DEPTH = 2;
constexpr int M = BATCH * SEQ;
constexpr int NIN = 3462, NINP = 3584;
constexpr float EPS = 1e-6f, LOG2E = 1.4426950408889634f;
#ifndef MK_ONE_LAUNCH
#define MK_ONE_LAUNCH 1
#endif
constexpr int NPH = 1 + 6 * DEPTH;

constexpr size_t MiB = 1u << 20;
constexpr size_t WS_CTL = 0, CTL_ZERO_BYTES = 1 * MiB;
constexpr size_t WS_W = 2 * MiB, W_LAYER = 25 * MiB, W_IN = 0, W_OUT = 7 * MiB, W_UP = 9 * MiB, W_DOWN = 17 * MiB;
constexpr size_t WS_SSQ = 52 * MiB;
constexpr size_t WS_LS = 54 * MiB;
constexpr size_t WS_KMP = 55 * MiB;
constexpr size_t WS_XB = 64 * MiB;
constexpr size_t WS_Q = 128 * MiB, WS_K = 192 * MiB, WS_V = 256 * MiB, WS_O = 320 * MiB;
constexpr size_t WS_Y = WS_Q;
constexpr size_t WS_H = 128 * MiB;
constexpr size_t WS_GF = 384 * MiB;
constexpr size_t WS_LD = 56 * MiB;
constexpr size_t WS_OD = 408 * MiB;
constexpr size_t WS_END = 480 * MiB;
constexpr int CW_BAR = 4096;

constexpr int RING_OFF = 0, RING_BYTES = 131072;
constexpr int LDSCTL_OFF = RING_BYTES, MISC_OFF = LDSCTL_OFF + 320;
constexpr int LDS_BYTES = 147456;

#define GAS __attribute__((address_space(1)))
#define LAS __attribute__((address_space(3)))
typedef unsigned short bf16;
typedef unsigned v4u __attribute__((ext_vector_type(4)));
typedef float f32x4 __attribute__((ext_vector_type(4)));
typedef GAS unsigned gu32;
#define RLX_AGENT __ATOMIC_RELAXED, __HIP_MEMORY_SCOPE_AGENT
#define LDS_WAIT() asm volatile("s_waitcnt lgkmcnt(0)" ::: "memory")
#define VM_WAIT() asm volatile("s_waitcnt vmcnt(0)" ::: "memory")
__device__ __forceinline__ unsigned f2bf(float f) { unsigned u = __builtin_bit_cast(unsigned, f); return (u + 0x7fffu + ((u >> 16) & 1u)) >> 16; }
__device__ __forceinline__ unsigned pk2(float lo, float hi) { return f2bf(lo) | (f2bf(hi) << 16); }
__device__ __forceinline__ float bflo(unsigned w) { return __builtin_bit_cast(float, w << 16); }
__device__ __forceinline__ float bfhi(unsigned w) { return __builtin_bit_cast(float, w & 0xffff0000u); }
#define XB_TMO      128
#define XB_XCNT(j)  (256  + 64 * (j))
#define XB_XSUB(j)  (1280 + 64 * (j))
#define XB_XGEN(j)  (2304 + 64 * (j))
#define XB_TOP      3328
#define XB_TOPGEN   3392
#define XCD_BAR_WORDS 3456
#define XB_SPIN_CAP (1u << 18)

__device__ __forceinline__ unsigned xb_ld(unsigned* p)              { return __hip_atomic_load(p, __ATOMIC_RELAXED, __HIP_MEMORY_SCOPE_AGENT); }
__device__ __forceinline__ unsigned xb_add(unsigned* p, unsigned v) { return __hip_atomic_fetch_add(p, v, __ATOMIC_RELAXED, __HIP_MEMORY_SCOPE_AGENT); }
__device__ __forceinline__ unsigned xb_xcc_id() { return (unsigned)__builtin_amdgcn_s_getreg((3 << 11) | 20) & 0xFu; }
#define XB_SPIN(cond, bar) do { unsigned _sp = 0; while (cond) { __builtin_amdgcn_s_sleep(1); \
    if ((++_sp & 255u) == 0u) { if (xb_ld(&(bar)[XB_TMO])) break; if (_sp > XB_SPIN_CAP) { atomicAdd(&(bar)[XB_TMO], 1u); break; } } } } while (0)

struct XcdBarrier {
    unsigned* bar; unsigned x;
    volatile LAS unsigned* st;
};

__device__ __forceinline__ XcdBarrier xcd_barrier_post(unsigned* bar, volatile LAS unsigned* st) {
    XcdBarrier b; b.bar = bar; b.x = xb_xcc_id(); b.st = st;
    if (threadIdx.x == 0) (void)xb_add(&bar[XB_XCNT(b.x)], 1u);
    return b;
}
__device__ __forceinline__ void xcd_barrier_complete(unsigned* bar, unsigned x, unsigned& nloc, unsigned& nx) {
    const unsigned G = gridDim.x * gridDim.y * gridDim.z;
    unsigned sum, cnt, mine, sp = 0u;
    for (;;) {
        sum = 0u; cnt = 0u; mine = 0u;
#pragma unroll
        for (unsigned j = 0; j < 16; ++j) { const unsigned c = xb_ld(&bar[XB_XCNT(j)]); sum += c; cnt += (c > 0u) ? 1u : 0u; mine = (j == x) ? c : mine; }
        if (sum == G) break;
        __builtin_amdgcn_s_sleep(1);
        if ((++sp & 255u) == 0u) { if (xb_ld(&bar[XB_TMO])) break; if (sp > XB_SPIN_CAP) { atomicAdd(&bar[XB_TMO], 1u); break; } }
    }
    nloc = mine > 0u ? mine : 1u; nx = cnt > 0u ? cnt : 1u;
}

__device__ __forceinline__ void xcd_barrier(const XcdBarrier& b, const int tid_x) {
    asm volatile("s_waitcnt vmcnt(0)" ::: "memory");
    __syncthreads();
    if (tid_x == 0) {
        unsigned* bar = b.bar;
        __builtin_amdgcn_s_waitcnt(0);
        unsigned nloc = b.st[0], nx = b.st[1];
        if (nloc == 0u) { xcd_barrier_complete(bar, b.x, nloc, nx); b.st[0] = nloc; b.st[1] = nx; }
        const unsigned old = xb_add(&bar[XB_XSUB(b.x)], 1u);
        const unsigned gen = old / nloc;
        if (old + 1u == (gen + 1u) * nloc) {
            __builtin_amdgcn_fence(__ATOMIC_RELEASE, "agent");
            asm volatile("s_waitcnt vmcnt(0)" ::: "memory");
            const unsigned og = xb_add(&bar[XB_TOP], 1u);
            const unsigned tg = og / nx;
            if (og + 1u == (tg + 1u) * nx) xb_add(&bar[XB_TOPGEN], 1u);
            else XB_SPIN(xb_ld(&bar[XB_TOPGEN]) == tg, bar);
            __builtin_amdgcn_fence(__ATOMIC_ACQUIRE, "agent");
            xb_add(&bar[XB_XGEN(b.x)], 1u);
            asm volatile("s_waitcnt vmcnt(0)" ::: "memory");
        } else {
            XB_SPIN(xb_ld(&bar[XB_XGEN(b.x)]) == gen, bar);
            __builtin_amdgcn_fence(__ATOMIC_ACQUIRE, "agent");
            asm volatile("s_waitcnt vmcnt(0)" ::: "memory");
        }
    }
    __syncthreads();
}

namespace att {
typedef unsigned short bf16;
using bf16x8 = __attribute__((ext_vector_type(8))) short;
using s16x4 = __attribute__((ext_vector_type(4))) short;
using f32x16 = __attribute__((ext_vector_type(16))) float;
using f32x4 = __attribute__((ext_vector_type(4))) float;
using u32x4 = __attribute__((ext_vector_type(4))) unsigned;
typedef __attribute__((address_space(3))) const char* lds_cptr;
typedef __attribute__((address_space(3))) float* lds_fptr;
typedef short v4i16_t __attribute__((ext_vector_type(4)));
constexpr int SLOTB = 8192, LDS_K = 0, LDS_V = 3 * SLOTB, LDS_WS = 6 * SLOTB, LDS_OST = LDS_WS + 8 * 256, LDS_X = LDS_OST + 8 * 4096, LDS_X2 = LDS_X + 16384, LDS_END = LDS_X2 + 1024;
constexpr int DMP = 1024;
#define ATT_WAIT_BAR(N) asm volatile("s_waitcnt vmcnt(" #N ") lgkmcnt(0)\n\ts_barrier" ::: "memory")
__device__ __forceinline__ void glds16(const void* gsrc, unsigned lds_dst) { unsigned keep;
    asm volatile("s_mov_b32 %0, m0\n\ts_mov_b32 m0, %2\n\ts_nop 0\n\tglobal_load_lds_dwordx4 %1, off\n\ts_mov_b32 m0, %0" : "=&s"(keep) : "v"(gsrc), "s"(lds_dst) : "memory"); }
typedef float f32x2_t __attribute__((ext_vector_type(2))); typedef __bf16 bf16x2_t __attribute__((ext_vector_type(2)));
__device__ __forceinline__ unsigned cvtpk(float lo, float hi) { f32x2_t v = {lo, hi}; bf16x2_t b = __builtin_convertvector(v, bf16x2_t); return __builtin_bit_cast(unsigned, b); }
__device__ __forceinline__ s16x4 vtr(lds_cptr p) { return __builtin_bit_cast(s16x4, __builtin_amdgcn_ds_read_tr16_b64_v4i16((__attribute__((address_space(3))) v4i16_t*)p)); }
__device__ __forceinline__ int crow(int r, int hi) { return (r & 3) + 8 * (r >> 2) + 4 * hi; }
#define ATT_NEG (-INFINITY)

struct UnitIO {
    const bf16* Q; long qstride;
    const bf16* K0; const bf16* V0; long kstride;
    bf16* O; long ostride;
    float* L; long lstride;
    bool norm;
};
struct BiasMoba {
    float slope2, tqf; int qrel, hi, w, nb0; unsigned selmask;
    __device__ __forceinline__ bool active(int t) const { return t < nb0 || (t - nb0) <= (w >> 1); }
    __device__ __forceinline__ void init(f32x16& c0, f32x16& c1, int t) const {
        float base = slope2 * ((float)(64 * t + 4 * hi) - tqf);
        if (t < nb0) { if (!((selmask >> (t >> 2)) & 1u)) base = ATT_NEG;
#pragma unroll
            for (int r = 0; r < 16; ++r) { const float v = base + slope2 * (float)((r & 3) + 8 * (r >> 2)); c0[r] = v; c1[r] = v + 32.0f * slope2; }
        } else { const int kb = 64 * (t - nb0) + 4 * hi;
#pragma unroll
            for (int r = 0; r < 16; ++r) { const int kv = kb + (r & 3) + 8 * (r >> 2); const float v = base + slope2 * (float)((r & 3) + 8 * (r >> 2)); c0[r] = kv > qrel ? ATT_NEG : v; c1[r] = kv + 32 > qrel ? ATT_NEG : v + 32.0f * slope2; }
        }
    }
};
struct BiasFox {
    lds_fptr cs2; float base; int qrel, hi, w, nb0;
    __device__ __forceinline__ bool active(int t) const { return t < nb0 || (t - nb0) <= (w >> 1); }
    __device__ __forceinline__ void init(f32x16& c0, f32x16& c1, int t) const {
        const lds_fptr p = cs2 + 64 * t + 4 * hi;
#pragma unroll
        for (int g = 0; g < 4; ++g) { const f32x4 a = *(const __attribute__((address_space(3))) f32x4*)(p + 8 * g), b = *(const __attribute__((address_space(3))) f32x4*)(p + 32 + 8 * g);
#pragma unroll
            for (int e = 0; e < 4; ++e) { c0[4 * g + e] = base - a[e]; c1[4 * g + e] = base - b[e]; } }
        if (t >= nb0) { const int kb = 64 * (t - nb0) + 4 * hi;
#pragma unroll
            for (int r = 0; r < 16; ++r) { const int kv = kb + (r & 3) + 8 * (r >> 2); if (kv > qrel) c0[r] = ATT_NEG; if (kv + 32 > qrel) c1[r] = ATT_NEG; } }
    }
};
struct BiasDil {
    float sd; int qrel, hi, w;
    __device__ __forceinline__ bool active(int t) const { return t >= (w >> 1) && t <= (w >> 1) + 2; }
    __device__ __forceinline__ void init(f32x16& c0, f32x16& c1, int t) const {
        const int kb = 64 * t + 4 * hi;
#pragma unroll
        for (int r = 0; r < 16; ++r) { const int off = qrel - (kb + (r & 3) + 8 * (r >> 2)); const float v = -sd * (float)off;
            c0[r] = ((unsigned)off <= 128u) ? v : ATT_NEG; c1[r] = ((unsigned)(off - 32) <= 128u) ? v + 32.0f * sd : ATT_NEG; }
    }
};

template <class BIAS>
__device__ __forceinline__ void attn_tiles(char* shm, const UnitIO& io, int t_begin, int t_end, const BIAS& B, int tid) {
    const int lane = tid & 63, r32 = lane & 31, hi = lane >> 5; const int wid = __builtin_amdgcn_readfirstlane(tid >> 6);
    const unsigned lds0 = (unsigned)(uintptr_t)shm;
    const bf16* ksrc = io.K0 + (long)lane * io.kstride + wid * 8;
    const bf16* vsrc = io.V0 + (long)(16 * (wid & 3) + (lane >> 2)) * io.kstride + (wid >> 2) * 32 + (lane & 3) * 8;
    const unsigned kdst = lds0 + LDS_K + wid * 1024, vdst = lds0 + LDS_V + wid * 1024;
    const long tstep = 64 * io.kstride;
#define ATT_DMA(t, slot) do { glds16(ksrc + (long)(t) * tstep, (unsigned)__builtin_amdgcn_readfirstlane(kdst + (slot))); glds16(vsrc + (long)(t) * tstep, (unsigned)__builtin_amdgcn_readfirstlane(vdst + (slot))); } while (0)
    const lds_cptr shm3 = (lds_cptr)shm;
    const lds_cptr kp0 = shm3 + LDS_K + hi * 1024 + r32 * 16;
    const lds_cptr vp0 = shm3 + LDS_V + ((lane >> 4) & 1) * 32 + (lane & 3) * 8 + (4 * hi + ((lane & 15) >> 2)) * 64;
    float* wsf = (float*)(shm + LDS_WS) + wid * 64;
    if (t_begin < t_end) { ATT_DMA(t_begin, 0); if (t_begin + 1 < t_end) ATT_DMA(t_begin + 1, SLOTB); }
    bf16x8 qr[4];
    { const bf16* qp = io.Q + (long)r32 * io.qstride + hi * 8;
#pragma unroll
      for (int d0 = 0; d0 < 4; ++d0) qr[d0] = *reinterpret_cast<const bf16x8*>(qp + d0 * 16); }
    f32x16 o[2]; o[0] = f32x16{}; o[1] = f32x16{}; float l_reg = 0.f;
    ATT_WAIT_BAR(0);
    int sl_c = 0, sl_n = SLOTB, sl_nn = 2 * SLOTB;
#pragma unroll 1
    for (int t = t_begin; t < t_end; ++t) {
        const bool more = (t + 2 < t_end);
        if (more) ATT_DMA(t + 2, sl_nn);
        if (B.active(t)) {
            f32x16 c0, c1; B.init(c0, c1, t);
            bf16x8 kf[8]; const lds_cptr kp = kp0 + sl_c;
#pragma unroll
            for (int j = 0; j < 4; ++j) { kf[2 * j] = *(const __attribute__((address_space(3))) bf16x8*)(kp + j * 2048); kf[2 * j + 1] = *(const __attribute__((address_space(3))) bf16x8*)(kp + j * 2048 + 512); }
#pragma unroll
            for (int d0 = 0; d0 < 4; ++d0) { c0 = __builtin_amdgcn_mfma_f32_32x32x16_bf16(kf[2 * d0], qr[d0], c0, 0, 0, 0); c1 = __builtin_amdgcn_mfma_f32_32x32x16_bf16(kf[2 * d0 + 1], qr[d0], c1, 0, 0, 0); }
            float s0 = 0.f, s1 = 0.f;
#pragma unroll
            for (int r = 0; r < 16; ++r) { c0[r] = __builtin_amdgcn_exp2f(c0[r]); c1[r] = __builtin_amdgcn_exp2f(c1[r]); s0 += c0[r]; s1 += c1[r]; }
            l_reg += s0 + s1;
            u32x4 pw[4];
#pragma unroll
            for (int i = 0; i < 4; ++i) { pw[0][i] = cvtpk(c0[2 * i], c0[2 * i + 1]); pw[1][i] = cvtpk(c0[8 + 2 * i], c0[9 + 2 * i]); pw[2][i] = cvtpk(c1[2 * i], c1[2 * i + 1]); pw[3][i] = cvtpk(c1[8 + 2 * i], c1[9 + 2 * i]); }
            const lds_cptr vp = vp0 + sl_c;
#pragma unroll
            for (int dh = 0; dh < 2; ++dh)
#pragma unroll
                for (int ks = 0; ks < 4; ++ks) { const s16x4 lo = vtr(vp + dh * 4096 + ks * 1024), hh = vtr(vp + dh * 4096 + ks * 1024 + 512);
                    const bf16x8 vf = (bf16x8){lo[0], lo[1], lo[2], lo[3], hh[0], hh[1], hh[2], hh[3]};
                    o[dh] = __builtin_amdgcn_mfma_f32_32x32x16_bf16(__builtin_bit_cast(bf16x8, pw[ks]), vf, o[dh], 0, 0, 0); }
        }
        if (more) ATT_WAIT_BAR(2); else ATT_WAIT_BAR(0);
        const int tmp = sl_c; sl_c = sl_n; sl_n = sl_nn; sl_nn = tmp;
    }
#undef ATT_DMA
    { auto rr = __builtin_amdgcn_permlane32_swap(__float_as_uint(l_reg), __float_as_uint(l_reg), false, false); l_reg = __uint_as_float(rr[0]) + __uint_as_float(rr[1]); }
    if (hi == 0) wsf[32 + r32] = l_reg;
    asm volatile("s_waitcnt lgkmcnt(0)" ::: "memory");
    float rli[16];
#pragma unroll
    for (int r = 0; r < 16; ++r) rli[r] = io.norm ? __builtin_amdgcn_rcpf(wsf[32 + crow(r, hi)]) : 1.0f;
    if (!io.norm && hi == 0) io.L[(long)r32 * io.lstride] = l_reg;
    { bf16* stg = (bf16*)(shm + LDS_OST) + wid * 2048;
#pragma unroll
      for (int r = 0; r < 16; ++r) { const int orow = crow(r, hi);
#pragma unroll
          for (int d0 = 0; d0 < 2; ++d0) stg[orow * 64 + d0 * 32 + r32] = (bf16)(cvtpk(o[d0][r] * rli[r], 0.f) & 0xffffu); }
      asm volatile("s_waitcnt lgkmcnt(0)" ::: "memory");
#pragma unroll
      for (int i = 0; i < 4; ++i) { const int row = i * 8 + (lane >> 3), ch = lane & 7; const u32x4 v = *(const u32x4*)(stg + row * 64 + ch * 8); *(u32x4*)(io.O + (long)row * io.ostride + ch * 8) = v; } }
    asm volatile("s_waitcnt lgkmcnt(0)" ::: "memory");
}
}

struct Frame {
    LAS unsigned char* lds;
    volatile LAS unsigned* MISC;
    gu32* ctl;
    int tid, lane, wave;
    int vcu, G;
};
struct Ptrs {
    const float *x, *attn_norm, *w_in, *b_forget, *q_gain, *k_gain, *out_gain, *w_out, *mlp_norm, *w_up, *w_down;
    float* out; unsigned char* ws;
};

__device__ __forceinline__ float wave_sum(float v) {
#pragma unroll
    for (int o = 1; o < 64; o <<= 1) v += __shfl_xor(v, o);
    return v;
}

__device__ __forceinline__ int win_src(int cp) {
    const int tile = cp >> 8, within = cp & 255;
    if (tile < 12) { const int bj = within >> 7, wc = (within >> 5) & 3, j = within & 31; return tile * 256 + 64 * wc + 32 * bj + j; }
    if (tile == 12) return 3078 + within;
    if (within < 128) return 3078 + 256 + within;
    if (within < 134) return 3072 + (within - 128);
    return -1;
}
template <int MODE>
__device__ __forceinline__ void transpose_item(const float* W, int K, int N, const float* gain, bf16* WT, LAS float* scr, int item, int nblk, int lane) {
    const int kb = item / nblk, nb = item % nblk, k0 = 64 * kb, n0 = 32 * nb;
    const int sc = (MODE == 0) ? win_src(n0 + (lane & 31)) : (n0 + (lane & 31));
    const GAS float* src = (const GAS float*)W + (size_t)(k0 + (lane >> 5)) * N + (sc >= 0 ? sc : 0);
    const float keep = sc >= 0 ? 1.f : 0.f;
    float v[32];
#pragma unroll
    for (int i = 0; i < 32; ++i) v[i] = src[(size_t)(2 * i) * N];
    const int c = lane & 7;
    f32x4 g0 = (f32x4){1.f, 1.f, 1.f, 1.f}, g1 = g0;
    if (gain) { g0 = *(const GAS f32x4*)(gain + k0 + 8 * c); g1 = *(const GAS f32x4*)(gain + k0 + 8 * c + 4); }
#pragma unroll
    for (int i = 0; i < 32; ++i) scr[(2 * i + (lane >> 5)) * 33 + (lane & 31)] = v[i] * keep;
    LDS_WAIT(); asm volatile("" ::: "memory");
#pragma unroll
    for (int j = 0; j < 4; ++j) { const int n = (lane >> 3) + 8 * j; const LAS float* s = scr + (8 * c) * 33 + n;
        v4u o; o.x = pk2(s[0 * 33] * g0[0], s[1 * 33] * g0[1]); o.y = pk2(s[2 * 33] * g0[2], s[3 * 33] * g0[3]); o.z = pk2(s[4 * 33] * g1[0], s[5 * 33] * g1[1]); o.w = pk2(s[6 * 33] * g1[2], s[7 * 33] * g1[3]);
        *(GAS v4u*)(WT + (size_t)(n0 + n) * K + k0 + 8 * c) = o; }
    LDS_WAIT(); asm volatile("" ::: "memory");
}
__device__ __forceinline__ void p0_prologue(Frame& F, const Ptrs& P) {
    LAS float* scr = (LAS float*)(F.lds + RING_OFF + F.wave * 16384);
    const int gw = F.vcu * NWAVES + F.wave, NGW = F.G * NWAVES;
    constexpr int I_IN = (DM / 64) * (NINP / 32), I_OUT = (DM / 64) * (DM / 32), I_UP = (DM / 64) * (FF / 32), I_DN = (FF / 64) * (DM / 32);
    constexpr int I_LAYER = I_IN + I_OUT + I_UP + I_DN;
    for (int it = gw; it < DEPTH * I_LAYER; it += NGW) {
        const int l = it / I_LAYER; int r = it % I_LAYER;
        unsigned char* wl = P.ws + WS_W + (size_t)l * W_LAYER;
        if (r < I_IN) { transpose_item<0>(P.w_in + (size_t)l * DM * NIN, DM, NIN, P.attn_norm + l * DM, (bf16*)(wl + W_IN), scr, r, NINP / 32, F.lane); continue; } r -= I_IN;
        if (r < I_OUT) { transpose_item<1>(P.w_out + (size_t)l * DM * DM, DM, DM, P.out_gain + l * DM, (bf16*)(wl + W_OUT), scr, r, DM / 32, F.lane); continue; } r -= I_OUT;
        if (r < I_UP) { transpose_item<1>(P.w_up + (size_t)l * DM * FF, DM, FF, P.mlp_norm + l * DM, (bf16*)(wl + W_UP), scr, r, FF / 32, F.lane); continue; } r -= I_UP;
        transpose_item<1>(P.w_down + (size_t)l * FF * DM, FF, DM, nullptr, (bf16*)(wl + W_DOWN), scr, r, DM / 32, F.lane);
    }
    bf16* XB = (bf16*)(P.ws + WS_XB); float* SSQ = (float*)(P.ws + WS_SSQ);
    for (int m = gw; m < M; m += 2 * NGW) {
        const int m2 = m + NGW; const bool has2 = m2 < M;
        const GAS f32x4* xr = (const GAS f32x4*)(P.x + (size_t)m * DM) + F.lane; const GAS f32x4* xr2 = (const GAS f32x4*)(P.x + (size_t)(has2 ? m2 : m) * DM) + F.lane;
        f32x4 v[4], w[4]; float s = 0.f, s2 = 0.f;
#pragma unroll
        for (int j = 0; j < 4; ++j) { v[j] = xr[64 * j]; w[j] = xr2[64 * j]; }
#pragma unroll
        for (int j = 0; j < 4; ++j) { s += (v[j].x * v[j].x + v[j].y * v[j].y) + (v[j].z * v[j].z + v[j].w * v[j].w); s2 += (w[j].x * w[j].x + w[j].y * w[j].y) + (w[j].z * w[j].z + w[j].w * w[j].w); }
        s = wave_sum(s); s2 = wave_sum(s2);
        GAS unsigned long long* o8 = (GAS unsigned long long*)(XB + (size_t)m * DM) + F.lane;
#pragma unroll
        for (int j = 0; j < 4; ++j) o8[64 * j] = (unsigned long long)pk2(v[j].x, v[j].y) | ((unsigned long long)pk2(v[j].z, v[j].w) << 32);
        if (F.lane < 16) SSQ[(size_t)m * 16 + F.lane] = F.lane == 0 ? s : 0.f;
        if (has2) { GAS unsigned long long* p8 = (GAS unsigned long long*)(XB + (size_t)m2 * DM) + F.lane;
#pragma unroll
            for (int j = 0; j < 4; ++j) p8[64 * j] = (unsigned long long)pk2(w[j].x, w[j].y) | ((unsigned long long)pk2(w[j].z, w[j].w) << 32);
            if (F.lane < 16) SSQ[(size_t)m2 * 16 + F.lane] = F.lane == 0 ? s2 : 0.f; }
    }
}

__device__ __forceinline__ void unpack8(const v4u w, float* f) { f[0] = bflo(w.x); f[1] = bfhi(w.x); f[2] = bflo(w.y); f[3] = bfhi(w.y); f[4] = bflo(w.z); f[5] = bfhi(w.z); f[6] = bflo(w.w); f[7] = bfhi(w.w); }

struct AttnBufs { const bf16 *Q, *K, *V; bf16* O; bf16* OD; float* LD; const float* LS; const float* KMP; };
constexpr size_t OD_BRANCH = (size_t)M * 384, LD_BRANCH = (size_t)M * 8;

__device__ __forceinline__ void moba_unit(Frame& F, const AttnBufs& A, int b, int h, int qb) {
    char* shm = (char*)F.lds; const int tid = F.tid, lane = tid & 63, r32 = lane & 31, hi = lane >> 5, w = F.wave;
    LAS float* KM = (LAS float*)(F.lds + att::LDS_X);
    for (int i = tid; i < 1024; i += 512) { const int j = i >> 6, d = i & 63; float v = 0.f;
        if (j < qb) { const float* p = A.KMP + ((size_t)((b * 16 + j) * 4 + h) * 2) * 64 + d; v = p[0] + p[64]; } KM[i] = v; }
    const size_t row0 = (size_t)b * SEQ + qb * 256 + w * 32;
    const bf16* Qw = A.Q + row0 * DM + h * 64;
    float qf[32];
    { const bf16* qp = Qw + (size_t)r32 * DM + hi * 8;
#pragma unroll
      for (int d0 = 0; d0 < 4; ++d0) { const v4u wv = *(const v4u*)(qp + d0 * 16); unpack8(wv, qf + 8 * d0); } }
    __syncthreads();
    float g0 = -INFINITY, g1 = -INFINITY, g2 = -INFINITY; int i0 = -1, i1 = -1, i2 = -1;
#pragma unroll 1
    for (int j = 0; j < qb; ++j) {
        float dot = 0.f;
#pragma unroll
        for (int d0 = 0; d0 < 4; ++d0) { const f32x4 ka = *(const LAS f32x4*)(KM + j * 64 + d0 * 16 + hi * 8), kb = *(const LAS f32x4*)(KM + j * 64 + d0 * 16 + hi * 8 + 4);
#pragma unroll
            for (int e = 0; e < 4; ++e) { dot += qf[8 * d0 + e] * ka[e]; dot += qf[8 * d0 + 4 + e] * kb[e]; } }
        { auto rr = __builtin_amdgcn_permlane32_swap(__float_as_uint(dot), __float_as_uint(dot), false, false); dot = __uint_as_float(rr[0]) + __uint_as_float(rr[1]); }
        if (dot > g0) { g2 = g1; i2 = i1; g1 = g0; i1 = i0; g0 = dot; i0 = j; } else if (dot > g1) { g2 = g1; i2 = i1; g1 = dot; i1 = j; } else if (dot > g2) { g2 = dot; i2 = j; }
    }
    unsigned selmask = 0u; if (i0 >= 0) selmask |= 1u << i0; if (i1 >= 0) selmask |= 1u << i1; if (i2 >= 0) selmask |= 1u << i2;
    att::BiasMoba B; B.slope2 = exp2f(-8.0f * (float)(7 + h) / 10.0f) * LOG2E; B.qrel = w * 32 + r32; B.tqf = (float)(qb * 256 + B.qrel); B.hi = hi; B.w = w; B.nb0 = 4 * qb; B.selmask = selmask;
    att::UnitIO io; io.Q = Qw; io.qstride = DM; io.K0 = A.K + (size_t)b * SEQ * DM + h * 64; io.V0 = A.V + (size_t)b * SEQ * DM + h * 64; io.kstride = DM;
    io.O = A.O + row0 * DM + h * 64; io.ostride = DM; io.L = nullptr; io.lstride = 0; io.norm = true;
    att::attn_tiles(shm, io, 0, 4 * qb + 4, B, tid);
}
__device__ __forceinline__ void fox_unit(Frame& F, const AttnBufs& A, int b, int h, int qb) {
    char* shm = (char*)F.lds; const int tid = F.tid, lane = tid & 63, r32 = lane & 31, hi = lane >> 5, w = F.wave;
    LAS float* CS = (LAS float*)(F.lds + att::LDS_X); LAS float* WT = (LAS float*)(F.lds + att::LDS_X2);
    const int n = 256 * (qb + 1);
    const float* ls = A.LS + (size_t)(h - 4) * M + (size_t)b * SEQ;
    float v[8]; float run = 0.f;
    if (8 * tid < n) { const f32x4 a = *(const f32x4*)(ls + 8 * tid), c = *(const f32x4*)(ls + 8 * tid + 4);
        v[0] = a[0]; v[1] = a[1]; v[2] = a[2]; v[3] = a[3]; v[4] = c[0]; v[5] = c[1]; v[6] = c[2]; v[7] = c[3];
#pragma unroll
        for (int e = 0; e < 8; ++e) { run += v[e] * LOG2E; v[e] = run; } }
    else {
#pragma unroll
        for (int e = 0; e < 8; ++e) v[e] = 0.f; }
    float inc = run;
#pragma unroll
    for (int o = 1; o < 64; o <<= 1) { const float up = __shfl_up(inc, o); if (lane >= o) inc += up; }
    if (lane == 63) WT[w] = inc;
    __syncthreads();
    float woff = 0.f;
#pragma unroll
    for (int k = 0; k < 8; ++k) { const float tk = WT[k]; if (k < w) woff += tk; }
    const float excl = woff + inc - run;
    if (8 * tid < n) {
        *(LAS f32x4*)(CS + 8 * tid) = (f32x4){v[0] + excl, v[1] + excl, v[2] + excl, v[3] + excl}; *(LAS f32x4*)(CS + 8 * tid + 4) = (f32x4){v[4] + excl, v[5] + excl, v[6] + excl, v[7] + excl}; }
    __syncthreads();
    const int nb0 = 4 * qb; const float c_first = CS[qb * 256];
    int t_begin = 0;
    { bool skip = false; if (lane < nb0) skip = (c_first - CS[64 * lane + 63]) < -100.0f;
      const unsigned long long bm = __ballot(skip); t_begin = (int)__builtin_ctzll(~bm); if (t_begin > nb0) t_begin = nb0; }
    t_begin = __builtin_amdgcn_readfirstlane(t_begin);
    att::BiasFox B; B.cs2 = CS; B.qrel = w * 32 + r32; B.base = CS[qb * 256 + B.qrel]; B.hi = hi; B.w = w; B.nb0 = nb0;
    const size_t row0 = (size_t)b * SEQ + qb * 256 + w * 32;
    att::UnitIO io; io.Q = A.Q + row0 * DM + h * 64; io.qstride = DM; io.K0 = A.K + (size_t)b * SEQ * DM + h * 64; io.V0 = A.V + (size_t)b * SEQ * DM + h * 64; io.kstride = DM;
    io.O = A.O + row0 * DM + h * 64; io.ostride = DM; io.L = nullptr; io.lstride = 0; io.norm = true;
    att::attn_tiles(shm, io, t_begin, nb0 + 4, B, tid);
}
__device__ __forceinline__ void dil_unit(Frame& F, const AttnBufs& A, int b, int h, int g, int r, int c) {
    char* shm = (char*)F.lds; const int tid = F.tid, lane = tid & 63, r32 = lane & 31, hi = lane >> 5, w = F.wave;
    const int dil = (g == 0) ? 1 : (g == 1 ? 4 : 16);
    const int i0 = 256 * c;
    att::BiasDil B; B.sd = exp2f(-8.0f * (float)(h - 10 + 1) / 10.0f) * LOG2E * (float)dil; B.qrel = 128 + w * 32 + r32; B.hi = hi; B.w = w;
    const long tok_q0 = (long)b * SEQ + r + (long)dil * (i0 + w * 32);
    const long tok_k0 = (long)b * SEQ + r + (long)dil * (i0 - 128);
    att::UnitIO io; io.Q = A.Q + tok_q0 * DM + h * 64; io.qstride = (long)DM * dil; io.K0 = A.K + tok_k0 * DM + h * 64; io.V0 = A.V + tok_k0 * DM + h * 64; io.kstride = (long)DM * dil;
    io.O = A.OD + (size_t)g * OD_BRANCH + tok_q0 * 384 + (h - 10) * 64; io.ostride = (long)384 * dil; io.L = A.LD + (size_t)g * LD_BRANCH + tok_q0 * 8 + (h - 10); io.lstride = (long)8 * dil; io.norm = false;
    att::attn_tiles(shm, io, c == 0 ? 2 : 0, 6, B, tid);
}
__device__ __forceinline__ void attn_phase(Frame& F, const AttnBufs& A) {
#ifndef PROBE_DUP_ATT
#define PROBE_DUP_ATT 0
#endif
    const int v = F.vcu, G = F.G;
    for (int rep = 0; rep < ((PROBE_DUP_ATT & 1) ? 2 : 1); ++rep)
    for (int i = v; i < 512; i += G) { const int k = i >> 8, j = i & 255, bh = j >> 3, s = j & 7; moba_unit(F, A, bh >> 2, bh & 3, k == 0 ? s : 15 - s); }
    for (int rep = 0; rep < ((PROBE_DUP_ATT & 2) ? 2 : 1); ++rep)
    for (int f = v; f < 768; f += G) { const int k = f >> 8, bhf = f >> 4, qb = ((f & 15) + 5 * k) & 15; fox_unit(F, A, bhf / 6, 4 + bhf % 6, qb); }
    for (int rep = 0; rep < ((PROBE_DUP_ATT & 4) ? 2 : 1); ++rep)
    for (int u = v; u < 2304; u += G) { const int bh6 = u / 48, rest = u % 48, g = rest >> 4, idx = rest & 15;
        const int r = (g == 0) ? 0 : (g == 1 ? (idx >> 2) : idx), c = (g == 0) ? idx : (g == 1 ? (idx & 3) : 0);
        dil_unit(F, A, bh6 / 6, 10 + bh6 % 6, g, r, c); }
}
__device__ __forceinline__ void norm_phase(Frame& F, const bf16* O, const bf16* GF, const bf16* OD, const float* LD, bf16* Y) {
    const int gw = F.vcu * NWAVES + F.wave, NGW = F.G * NWAVES, lane = F.lane;
    for (int m = gw; m < M; m += NGW) {
        float fa[8], fc[8];
        unpack8(*(const v4u*)(O + (size_t)m * DM + 8 * lane), fa);
        if (lane < 16) unpack8(*(const v4u*)(O + (size_t)m * DM + 512 + 8 * lane), fc);
        else {
            const int dc = 8 * lane - 128, hd = dc >> 6;
            float f0[8], f1[8], f2[8];
            unpack8(*(const v4u*)(OD + (size_t)m * 384 + dc), f0); unpack8(*(const v4u*)(OD + OD_BRANCH + (size_t)m * 384 + dc), f1); unpack8(*(const v4u*)(OD + 2 * OD_BRANCH + (size_t)m * 384 + dc), f2);
            const float lt = LD[(size_t)m * 8 + hd] + LD[LD_BRANCH + (size_t)m * 8 + hd] + LD[2 * LD_BRANCH + (size_t)m * 8 + hd];
            const float inv = 1.0f / lt;
#pragma unroll
            for (int e = 0; e < 8; ++e) fc[e] = (f0[e] + f1[e] + f2[e]) * inv;
        }
        float sa = 0.f, sc = 0.f;
#pragma unroll
        for (int e = 0; e < 8; ++e) { sa += fa[e] * fa[e]; sc += fc[e] * fc[e]; }
        const float s_moba = wave_sum(lane < 32 ? sa : 0.f), s_fox = wave_sum((lane >= 32 ? sa : 0.f) + (lane < 16 ? sc : 0.f)), s_dil = wave_sum(lane >= 16 ? sc : 0.f);
        const float r_moba = 1.0f / sqrtf(s_moba * (1.0f / 256.0f) + EPS), r_fox = 1.0f / sqrtf(s_fox * (1.0f / 384.0f) + EPS), r_dil = 1.0f / sqrtf(s_dil * (1.0f / 384.0f) + EPS);
        float ga[8], gc[8];
#pragma unroll
        for (int e = 0; e < 8; ++e) { ga[e] = 1.f; gc[e] = 1.f; }
        if (lane >= 32) unpack8(*(const v4u*)(GF + (size_t)m * 384 + 8 * lane - 256), ga);
        if (lane < 16) unpack8(*(const v4u*)(GF + (size_t)m * 384 + 256 + 8 * lane), gc);
        const float ra = lane < 32 ? r_moba : r_fox, rc = lane < 16 ? r_fox : r_dil;
        v4u ya, yc;
        ya.x = pk2(fa[0] * ra * ga[0], fa[1] * ra * ga[1]); ya.y = pk2(fa[2] * ra * ga[2], fa[3] * ra * ga[3]); ya.z = pk2(fa[4] * ra * ga[4], fa[5] * ra * ga[5]); ya.w = pk2(fa[6] * ra * ga[6], fa[7] * ra * ga[7]);
        yc.x = pk2(fc[0] * rc * gc[0], fc[1] * rc * gc[1]); yc.y = pk2(fc[2] * rc * gc[2], fc[3] * rc * gc[3]); yc.z = pk2(fc[4] * rc * gc[4], fc[5] * rc * gc[5]); yc.w = pk2(fc[6] * rc * gc[6], fc[7] * rc * gc[7]);
        *(v4u*)(Y + (size_t)m * DM + 8 * lane) = ya; *(v4u*)(Y + (size_t)m * DM + 512 + 8 * lane) = yc;
    }
}

struct Args { const float* in[11]; float* out; unsigned char* ws; int ph_lo, ph_hi; };
__global__ void __launch_bounds__(NWAVES * 64, 2) mk_fwd(Args args) {
    __shared__ __attribute__((aligned(16))) unsigned char lds[LDS_BYTES];
    for (int u = threadIdx.x; u < (LDS_BYTES - LDSCTL_OFF) / 4; u += NWAVES * 64) ((LAS unsigned*)((LAS unsigned char*)lds + LDSCTL_OFF))[u] = 0u;
    __syncthreads();
    const int lo = args.ph_lo, hi = args.ph_hi;
    XcdBarrier bar; bar.bar = (unsigned*)(args.ws + WS_CTL) + CW_BAR; bar.x = 0; bar.st = nullptr;
    if (hi - lo > 1) bar = xcd_barrier_post((unsigned*)(args.ws + WS_CTL) + CW_BAR, (volatile LAS unsigned*)((LAS unsigned char*)lds + MISC_OFF) + 8);
#ifndef PROBE_DUP_PHASE
#define PROBE_DUP_PHASE -1
#endif
    int dup_left = 1;
#pragma unroll 1
    for (int ph = lo; ph < hi; ++ph) {
        unsigned char* ws = args.ws; asm volatile("" : "+s"(ws));
        int tid_ = threadIdx.x; asm volatile("" : "+v"(tid_));
        int bid_ = blockIdx.x, G_ = gridDim.x; asm volatile("" : "+s"(bid_), "+s"(G_));
        Frame F;
        F.lds = (LAS unsigned char*)lds;
        F.MISC = (volatile LAS unsigned*)(F.lds + MISC_OFF);
        F.tid = tid_; F.lane = F.tid & 63; F.wave = __builtin_amdgcn_readfirstlane(F.tid >> 6);
        F.G = G_; F.vcu = (F.G % 8 == 0) ? (bid_ % 8) * (F.G / 8) + bid_ / 8 : bid_;
        F.ctl = (gu32*)(ws + WS_CTL);
        Ptrs P;
        P.x = args.in[0]; P.attn_norm = args.in[1]; P.w_in = args.in[2]; P.b_forget = args.in[3]; P.q_gain = args.in[4]; P.k_gain = args.in[5];
        P.out_gain = args.in[6]; P.w_out = args.in[7]; P.mlp_norm = args.in[8]; P.w_up = args.in[9]; P.w_down = args.in[10]; P.out = args.out; P.ws = ws;
        PG8_LAS float* tab = (PG8_LAS float*)(F.lds + pg8::TAB_OFF);
        if (ph == 0) { p0_prologue(F, P); }
        else {
            const int l = (ph - 1) / 6, k = (ph - 1) % 6;
            unsigned char* wl = ws + WS_W + (size_t)l * W_LAYER;
            bf16* XB = (bf16*)(ws + WS_XB);
            if (k == 0) {
                pg8::Gemm g{XB, (const bf16*)(wl + W_IN), M, NINP, DM}; pg8::StaticOrder S; S.init(M, NINP, F.G, bid_);
                pg8::EpiIn E{ws, P.b_forget + l * 6, tab};
                pg8::prep_tables(S, tab, ws, P.q_gain + l * 1024, P.k_gain + l * 1024, F.tid); __syncthreads();
                pg8::gemm_phase<pg8::EpiIn, pg8::StaticOrder, true, true>(F.lds + RING_OFF, g, S, E, F.tid);
            } else if (k == 1) {
                const AttnBufs AB{(const bf16*)(ws + WS_Q), (const bf16*)(ws + WS_K), (const bf16*)(ws + WS_V), (bf16*)(ws + WS_O), (bf16*)(ws + WS_OD), (float*)(ws + WS_LD), (const float*)(ws + WS_LS), (const float*)(ws + WS_KMP)};
                attn_phase(F, AB);
            } else if (k == 2) {
                norm_phase(F, (const bf16*)(ws + WS_O), (const bf16*)(ws + WS_GF), (const bf16*)(ws + WS_OD), (const float*)(ws + WS_LD), (bf16*)(ws + WS_Y));
            } else if (k == 4) {
                pg8::Gemm g{XB, (const bf16*)(wl + W_UP), M, FF, DM}; pg8::StaticOrder S; S.init(M, FF, F.G, bid_);
                pg8::EpiUp E{ws, tab};
                pg8::prep_tables(S, tab, ws, nullptr, nullptr, F.tid); __syncthreads();
                pg8::gemm_phase<pg8::EpiUp, pg8::StaticOrder, true, true>(F.lds + RING_OFF, g, S, E, F.tid);
            } else {
                const bool dn = (k == 5);
                pg8::Gemm g{dn ? (const bf16*)(ws + WS_H) : (const bf16*)(ws + WS_Y), (const bf16*)(wl + (dn ? W_DOWN : W_OUT)), M, DM, dn ? FF : DM};
                pg8::StaticOrder S; S.init(M, DM, F.G, bid_);
                pg8::EpiRes E{P.out, ws, ph == NPH - 1};
                pg8::gemm_phase<pg8::EpiRes, pg8::StaticOrder, true, true>(F.lds + RING_OFF, g, S, E, F.tid);
            }
        }
        if (ph == PROBE_DUP_PHASE && dup_left > 0) { --dup_left; --ph; }
        if (ph + 1 < hi) { XcdBarrier b2 = bar; asm volatile("" : "+s"(b2.bar)); xcd_barrier(b2, F.tid); }
    }
}

extern "C" void kernel_launch(void* const* d_in, const int* in_sizes, int n_in, void* d_out, int out_size, void* d_ws, size_t ws_size, hipStream_t stream) {
    static int grid = 0;
    if (grid == 0) {
        if (n_in != 11 || in_sizes[0] != M * DM || out_size != M * DM || ws_size < WS_END) { fprintf(stderr, "kernel_launch: unexpected shapes (n_in %d in0 %d out %d ws %zu)\n", n_in, n_in > 0 ? in_sizes[0] : -1, out_size, ws_size); grid = -1; return; }
        int dev = 0, cus = 0, per_cu = 0;
        if (hipGetDevice(&dev) != hipSuccess || hipDeviceGetAttribute(&cus, hipDeviceAttributeMultiprocessorCount, dev) != hipSuccess) { grid = -1; return; }
        if (hipOccupancyMaxActiveBlocksPerMultiprocessor(&per_cu, (const void*)mk_fwd, NWAVES * 64, 0) != hipSuccess || per_cu < 1) { fprintf(stderr, "kernel_launch: occupancy query says %d blocks per CU\n", per_cu); (void)hipGetLastError(); grid = -1; return; }
        grid = cus;
    }
    if (grid < 0) return;
    (void)hipMemsetAsync((char*)d_ws + WS_CTL, 0, CTL_ZERO_BYTES, stream);
    Args a{};
    for (int i = 0; i < 11; ++i) a.in[i] = (const float*)d_in[i];
    a.out = (float*)d_out; a.ws = (unsigned char*)d_ws;
#if MK_ONE_LAUNCH
    a.ph_lo = 0; a.ph_hi = NPH;
    hipLaunchKernelGGL(mk_fwd, dim3(grid), dim3(NWAVES * 64), 0, stream, a);
#else
    for (int p = 0; p < NPH; ++p) { a.ph_lo = p; a.ph_hi = p + 1; hipLaunchKernelGGL(mk_fwd, dim3(grid), dim3(NWAVES * 64), 0, stream, a); }
#endif
}
```

```cpp
#include <hip/hip_runtime.h>
#include <cstdio>
#include <cstdint>
namespace pg8 {
#define PG8_LAS __attribute__((address_space(3)))
typedef unsigned short bf16_t;
typedef short bf16x8 __attribute__((ext_vector_type(8)));
typedef float f32x4 __attribute__((ext_vector_type(4)));
typedef unsigned u32x4 __attribute__((ext_vector_type(4)));
constexpr int BM = 256, BK = 64, HALF = 128, HTB = HALF * BK * 2  , STAGE_BYTES = 8 * HTB, NXCD = 8, WGM = 8;

__host__ __device__ __forceinline__ int lds_byte(int r, int c) { const int st = (r >> 4) * 2 + (c >> 5), rr = r & 15, cc = c & 31, ob = rr * 64 + cc * 2; return st * 1024 + (ob ^ (((ob >> 9) & 1) << 5)); }
__host__ __device__ __forceinline__ void stage_rc(int b, int& R, int& C) { const int st = b / 1024, sb = b % 1024, swz = sb ^ (((sb >> 9) & 1) << 5); R = (st >> 1) * 16 + swz / 64; C = (st & 1) * 32 + (swz % 64) / 2; }
__host__ __device__ __forceinline__ int perm32(int rho) { const int n = rho >> 4, i = rho & 15; return 8 * (i >> 2) + 4 * n + (i & 3); }

struct Unit { int pm, pn; };
struct Gemm { const bf16_t* A; const bf16_t* Bt; int M, N, K; };

struct StaticOrder {
    int nM, nN, nwg, G, c;
    __host__ __device__ void init(int M, int N, int G_, int c_) { nM = M / BM; nN = N / BM; nwg = nM * nN; G = G_; c = c_; }
    __host__ __device__ bool next(int i, Unit& u) const {
        const long L = (long)i * G + c; if (L >= nwg) return false;
        int wgid = (int)L; { const int q = nwg / NXCD, r = nwg % NXCD, xcd = wgid % NXCD, off = wgid / NXCD; wgid = (xcd < r ? xcd * (q + 1) : r * (q + 1) + (xcd - r) * q) + off; }
        const int nig = WGM * nN, gid = wgid / nig, fm = gid * WGM, gsz = (nM - fm) < WGM ? (nM - fm) : WGM;
        u.pm = fm + ((wgid % nig) % gsz); u.pn = (wgid % nig) / gsz; return true;
    }
    __device__ __forceinline__ void a_ready(const Unit&) const {}
    __device__ __forceinline__ void done(const Unit&) const {}
};


__device__ __forceinline__ unsigned cvt_pk_bf16(float lo, float hi) { unsigned r; asm volatile("v_cvt_pk_bf16_f32 %0, %1, %2" : "=v"(r) : "v"(lo), "v"(hi)); return r; }
constexpr float RMS_EPS = 1e-6f;
constexpr float QSCALE = 0.125f * 1.4426950408889634f;
constexpr int TAB_OFF = 131072 + 512, TAB_G = 2048;
constexpr size_t EMiB = 1u << 20;
constexpr size_t E_SSQ = 52 * EMiB, E_LS = 54 * EMiB, E_KMP = 55 * EMiB, E_PRM = 56 * EMiB, E_XB = 64 * EMiB, E_Q = 128 * EMiB, E_K = 192 * EMiB, E_V = 256 * EMiB, E_H = 128 * EMiB, E_GF = 384 * EMiB;
__device__ __forceinline__ float row_rstd(const float* ssq, unsigned row) {
    const float* p = ssq + (size_t)(row * 16u);
    const f32x4 a = *(const f32x4*)(p), b = *(const f32x4*)(p + 4), c = *(const f32x4*)(p + 8), d = *(const f32x4*)(p + 12);
    const float s = ((a[0] + a[1]) + (a[2] + a[3])) + ((b[0] + b[1]) + (b[2] + b[3])) + ((c[0] + c[1]) + (c[2] + c[3])) + ((d[0] + d[1]) + (d[2] + d[3]));
    return 1.0f / sqrtf(s * (1.0f / 1024.0f) + RMS_EPS);
}
template <class Sched>
__device__ __forceinline__ void prep_tables(const Sched& S, PG8_LAS float* tab, const unsigned char* ws, const float* qg, const float* kg  , int tid) {
    Unit u;
#pragma unroll 1
    for (int i = 0; i < 8 && S.next(i, u); ++i) {
        if (tid < 256) tab[i * 256 + tid] = row_rstd((const float*)(ws + E_SSQ), (unsigned)(u.pm * BM + tid));
        else if (qg && u.pn < 8) { const int c = tid - 256; tab[TAB_G + i * 256 + c] = (u.pn < 4 ? qg : kg)[(u.pn & 3) * 256 + c]; }
    }
}
#define PG8_PACK8(y0, y1) (u32x4){cvt_pk_bf16((y0)[0], (y0)[1]), cvt_pk_bf16((y0)[2], (y0)[3]), cvt_pk_bf16((y1)[0], (y1)[1]), cvt_pk_bf16((y1)[2], (y1)[3])}
struct EpiIn {
    static constexpr bool PERM = true, AFTER_DRAIN = false;
    unsigned char* ws; const float* bfg; PG8_LAS float* tab;
    __device__ __forceinline__ void operator()(const f32x4 (&acc)[2][2][4][2], const Unit& u, int ui, int wr, int wc, int fr, int fq) const {
        const int pn = u.pn; const unsigned row0 = (unsigned)(u.pm * BM + wr * 64 + fr);
        const PG8_LAS float* rsp = tab + ui * 256 + wr * 64 + fr;
        if (pn < 8) {
            const PG8_LAS float* gp = tab + TAB_G + ui * 256 + 64 * wc + 8 * fq;
            f32x4 g[2][2];
#pragma unroll
            for (int bj = 0; bj < 2; ++bj)
#pragma unroll
                for (int n = 0; n < 2; ++n) g[bj][n] = *(const PG8_LAS f32x4*)(gp + 32 * bj + 4 * n);
            unsigned char* dst = ws + (pn < 4 ? E_Q : E_K) + (size_t)(unsigned)(((pn & 3) * 256 + wc * 64 + 8 * fq) * 2);
            const float post = pn < 4 ? QSCALE : 1.0f;
            f32x4 ks[2][2];
#pragma unroll
            for (int bj = 0; bj < 2; ++bj)
#pragma unroll
                for (int n = 0; n < 2; ++n) ks[bj][n] = (f32x4){0.f, 0.f, 0.f, 0.f};
#pragma unroll
            for (int ai = 0; ai < 2; ++ai)
#pragma unroll
                for (int m = 0; m < 4; ++m) {
                    const unsigned row = row0 + ai * HALF + m * 16; const float rs = rsp[ai * HALF + m * 16];
                    f32x4 v[2][2]; float ss = 0.f;
#pragma unroll
                    for (int bj = 0; bj < 2; ++bj)
#pragma unroll
                        for (int n = 0; n < 2; ++n) { v[bj][n] = acc[ai][bj][m][n] * rs; const f32x4 x = v[bj][n]; ss += (x[0] * x[0] + x[1] * x[1]) + (x[2] * x[2] + x[3] * x[3]); }
                    ss += __shfl_xor(ss, 16); ss += __shfl_xor(ss, 32);
                    const float r2 = 1.0f / sqrtf(ss * (1.0f / 64.0f) + RMS_EPS);
#pragma unroll
                    for (int bj = 0; bj < 2; ++bj) {
                        const f32x4 y0 = v[bj][0] * r2 * g[bj][0], y1 = v[bj][1] * r2 * g[bj][1];
                        ks[bj][0] += y0; ks[bj][1] += y1;
                        const f32x4 z0 = y0 * post, z1 = y1 * post;
                        *(u32x4*)(dst + (size_t)(row * 2048u + 64u * bj)) = PG8_PACK8(z0, z1);
                    }
                }
            if (pn == 4) {
#pragma unroll
                for (int bj = 0; bj < 2; ++bj)
#pragma unroll
                    for (int n = 0; n < 2; ++n)
#pragma unroll
                        for (int e = 0; e < 4; ++e) { float s = ks[bj][n][e]; s += __shfl_xor(s, 1); s += __shfl_xor(s, 2); s += __shfl_xor(s, 4); s += __shfl_xor(s, 8); ks[bj][n][e] = s; }
                if (fr == 0) { float* kp = (float*)(ws + E_KMP) + (size_t)(unsigned)((((u.pm * 4 + wc) * 2 + wr) * 64 + 8 * fq));
#pragma unroll
                    for (int bj = 0; bj < 2; ++bj)
#pragma unroll
                        for (int n = 0; n < 2; ++n) *(f32x4*)(kp + 32 * bj + 4 * n) = ks[bj][n]; }
            }
        } else if (pn < 12) {
            unsigned char* dst = ws + E_V + (size_t)(unsigned)(((pn & 3) * 256 + wc * 64 + 8 * fq) * 2);
#pragma unroll
            for (int ai = 0; ai < 2; ++ai)
#pragma unroll
                for (int m = 0; m < 4; ++m) {
                    const unsigned row = row0 + ai * HALF + m * 16; const float rs = rsp[ai * HALF + m * 16];
#pragma unroll
                    for (int bj = 0; bj < 2; ++bj) { const f32x4 y0 = acc[ai][bj][m][0] * rs, y1 = acc[ai][bj][m][1] * rs;
                        *(u32x4*)(dst + (size_t)(row * 2048u + 64u * bj)) = PG8_PACK8(y0, y1); }
                }
        } else {
#pragma unroll
            for (int ai = 0; ai < 2; ++ai)
#pragma unroll
                for (int m = 0; m < 4; ++m) {
                    const unsigned row = row0 + ai * HALF + m * 16; const float rs = rsp[ai * HALF + m * 16];
#pragma unroll
                    for (int bj = 0; bj < 2; ++bj) {
                        const f32x4 y0 = acc[ai][bj][m][0] * rs, y1 = acc[ai][bj][m][1] * rs;
                        if (pn == 12 || bj == 0) {
                            const unsigned gcol = (unsigned)((pn == 12 ? 0 : 256) + 128 * bj + 32 * wc + 8 * fq);
                            f32x4 s0, s1;
#pragma unroll
                            for (int e = 0; e < 4; ++e) { s0[e] = 1.0f / (1.0f + __expf(-y0[e])); s1[e] = 1.0f / (1.0f + __expf(-y1[e])); }
                            *(u32x4*)(ws + E_GF + (size_t)((row * 384u + gcol) * 2u)) = PG8_PACK8(s0, s1);
                        } else if (wc == 0 && fq == 0) {
                            float z[6] = {y0[0], y0[1], y0[2], y0[3], y1[0], y1[1]};
#pragma unroll
                            for (int e = 0; e < 6; ++e) { const float zz = z[e] + bfg[e]; z[e] = fminf(zz, 0.f) - log1pf(__expf(-fabsf(zz))); }
                            float* lp = (float*)(ws + E_LS) + (size_t)row;
#pragma unroll
                            for (int e = 0; e < 6; ++e) lp[(size_t)(e * 32768u)] = z[e];
                        }
                    }
                }
        }
    }
};
struct EpiRes {
    static constexpr bool PERM = true, AFTER_DRAIN = false;
    float* out; unsigned char* ws; bool last;
    __device__ __forceinline__ void operator()(const f32x4 (&acc)[2][2][4][2], const Unit& u, int ui, int wr, int wc, int fr, int fq) const {
        const unsigned row0 = (unsigned)(u.pm * BM + wr * 64 + fr), col0 = (unsigned)(u.pn * BM + wc * 32 + 8 * fq);
#pragma unroll
        for (int ai = 0; ai < 2; ++ai) {
#pragma unroll
            for (int m = 0; m < 4; ++m) {
                const unsigned row = row0 + ai * HALF + m * 16; float ss = 0.f;
#pragma unroll
                for (int bj = 0; bj < 2; ++bj) {
                    const unsigned off = row * 1024u + col0 + bj * HALF;
                    const u32x4 xw = *(const u32x4*)(ws + E_XB + (size_t)(off * 2u));
                    f32x4 o0, o1;
                    o0[0] = __builtin_bit_cast(float, xw[0] << 16) + acc[ai][bj][m][0][0]; o0[1] = __builtin_bit_cast(float, xw[0] & 0xffff0000u) + acc[ai][bj][m][0][1];
                    o0[2] = __builtin_bit_cast(float, xw[1] << 16) + acc[ai][bj][m][0][2]; o0[3] = __builtin_bit_cast(float, xw[1] & 0xffff0000u) + acc[ai][bj][m][0][3];
                    o1[0] = __builtin_bit_cast(float, xw[2] << 16) + acc[ai][bj][m][1][0]; o1[1] = __builtin_bit_cast(float, xw[2] & 0xffff0000u) + acc[ai][bj][m][1][1];
                    o1[2] = __builtin_bit_cast(float, xw[3] << 16) + acc[ai][bj][m][1][2]; o1[3] = __builtin_bit_cast(float, xw[3] & 0xffff0000u) + acc[ai][bj][m][1][3];
                    if (last) { *(f32x4*)(out + (size_t)off) = o0; *(f32x4*)(out + (size_t)off + 4) = o1; }
                    else {
                        ss += ((o0[0] * o0[0] + o0[1] * o0[1]) + (o0[2] * o0[2] + o0[3] * o0[3])) + ((o1[0] * o1[0] + o1[1] * o1[1]) + (o1[2] * o1[2] + o1[3] * o1[3]));
                        *(u32x4*)(ws + E_XB + (size_t)(off * 2u)) = PG8_PACK8(o0, o1);
                    }
                }
                if (!last) { ss += __shfl_xor(ss, 16); ss += __shfl_xor(ss, 32);
                    if (fq == 0) ((float*)(ws + E_SSQ))[(size_t)(row * 16u + (unsigned)(u.pn * 4 + wc))] = ss; }
            }
            asm volatile("" ::: "memory");
        }
    }
};
struct EpiUp {
    static constexpr bool PERM = true, AFTER_DRAIN = false;
    unsigned char* ws; PG8_LAS float* tab;
    __device__ __forceinline__ void operator()(const f32x4 (&acc)[2][2][4][2], const Unit& u, int ui, int wr, int wc, int fr, int fq) const {
        const unsigned row0 = (unsigned)(u.pm * BM + wr * 64 + fr), col0 = (unsigned)(u.pn * BM + wc * 32 + 8 * fq);
        const PG8_LAS float* rsp = tab + ui * 256 + wr * 64 + fr;
#pragma unroll
        for (int ai = 0; ai < 2; ++ai)
#pragma unroll
            for (int m = 0; m < 4; ++m) {
                const unsigned row = row0 + ai * HALF + m * 16; const float rs = rsp[ai * HALF + m * 16];
#pragma unroll
                for (int bj = 0; bj < 2; ++bj) {
                    f32x4 y0 = acc[ai][bj][m][0] * rs, y1 = acc[ai][bj][m][1] * rs;
#pragma unroll
                    for (int e = 0; e < 4; ++e) { const float a = fmaxf(y0[e], 0.f), b = fmaxf(y1[e], 0.f); y0[e] = a * a; y1[e] = b * b; }
                    *(u32x4*)(ws + E_H + (size_t)((row * 4096u + col0 + bj * HALF) * 2u)) = PG8_PACK8(y0, y1);
                }
            }
    }
};

template <class Epi, class Sched, bool ALIGN_EPI = false, bool SP2 = false>
__device__ __forceinline__ void gemm_phase(PG8_LAS unsigned char* lds, const Gemm g, const Sched& S, const Epi& E, const int tid) {
    const int wid = __builtin_amdgcn_readfirstlane(tid >> 6), lane = tid & 63, wr = wid >> 2, wc = wid & 3, fr = lane & 15, fq = lane >> 4;
    const int K = g.K, nt = K / BK;
    unsigned voffA[2], voffB[2];
#pragma unroll
    for (int i = 0; i < 2; ++i) { int R, C; stage_rc(tid * 16 + i * 8192, R, C); const int Rb = Epi::PERM ? ((R & ~31) + perm32(R & 31)) : R;
        voffA[i] = (unsigned)(R * K + C) * 2u; voffB[i] = (unsigned)(Rb * K + C) * 2u; }
    const size_t kstep = (size_t)(BK * 2);
    const size_t hstep = (size_t)HALF * K * 2;
    const size_t tstep = 2 * hstep;
    const unsigned ldsw = (unsigned)wid * 1024u;
    const int aoff = lds_byte(wr * 64 + fr, fq * 8), boff = lds_byte(wc * 32 + fr, fq * 8);
#define PG8_SA(b, h) (((b) * 2 + (h)) * HTB)
#define PG8_SB(b, h) ((4 + (b) * 2 + (h)) * HTB)
#define PG8_STAGE(bufoff, gbase, voff) do { _Pragma("unroll") for (int _i = 0; _i < 2; ++_i) \
        __builtin_amdgcn_global_load_lds((const unsigned*)((const char*)(gbase) + (voff)[_i]), (PG8_LAS unsigned*)(lds + (bufoff) + ldsw + _i * 8192), 16, 0, 0); } while (0)
#define PG8_LDA(dst, b, h) do { _Pragma("unroll") for (int m = 0; m < 4; ++m) _Pragma("unroll") for (int k = 0; k < 2; ++k) dst[m][k] = *(const PG8_LAS bf16x8*)(lds + PG8_SA(b, h) + aoff + m * 2048 + k * 1024); } while (0)
#define PG8_LDB(dst, b, h) do { _Pragma("unroll") for (int n = 0; n < 2; ++n) _Pragma("unroll") for (int k = 0; k < 2; ++k) dst[n][k] = *(const PG8_LAS bf16x8*)(lds + PG8_SB(b, h) + boff + n * 2048 + k * 1024); } while (0)
#define PG8_MMA(ai, bj, At, Bt) do { __builtin_amdgcn_s_setprio(1); _Pragma("unroll") for (int m = 0; m < 4; ++m) _Pragma("unroll") for (int n = 0; n < 2; ++n) _Pragma("unroll") for (int k = 0; k < 2; ++k) \
        acc[ai][bj][m][n] = __builtin_amdgcn_mfma_f32_16x16x32_bf16(Bt[n][k], At[m][k], acc[ai][bj][m][n], 0, 0, 0); __builtin_amdgcn_s_setprio(0); } while (0)
#define PG8_WAIT_V(n) asm volatile("s_waitcnt vmcnt(" #n ")" ::: "memory")
#define PG8_WAIT_L(n) asm volatile("s_waitcnt lgkmcnt(" #n ")" ::: "memory")
#define PG8_BAR __builtin_amdgcn_s_barrier()
#define PG8_SCHED __builtin_amdgcn_sched_barrier(0)
    Unit cur, nxt; int ui = 0;
    if (!S.next(0, cur)) return;
    f32x4 acc[2][2][4][2];
#pragma unroll
    for (int a = 0; a < 2; ++a)
#pragma unroll
        for (int b = 0; b < 2; ++b)
#pragma unroll
            for (int m = 0; m < 4; ++m)
#pragma unroll
                for (int n = 0; n < 2; ++n) acc[a][b][m][n] = (f32x4){0.f, 0.f, 0.f, 0.f};
    bf16x8 At[4][2], B0[2][2], B1[2][2];
    const char* cA = (const char*)g.A + (size_t)cur.pm * tstep; const char* cB = (const char*)g.Bt + (size_t)cur.pn * tstep;
    S.a_ready(cur);
    if constexpr (SP2) {
        PG8_STAGE(PG8_SB(0, 0), cB, voffB); PG8_STAGE(PG8_SB(0, 1), cB + hstep, voffB); PG8_STAGE(PG8_SA(0, 0), cA, voffA); PG8_STAGE(PG8_SA(0, 1), cA + hstep, voffA);
        if (wr == 1) PG8_BAR;
        PG8_WAIT_V(2); PG8_BAR;
        PG8_STAGE(PG8_SB(1, 0), cB + kstep, voffB); PG8_STAGE(PG8_SA(1, 0), cA + kstep, voffA); PG8_STAGE(PG8_SB(1, 1), cB + hstep + kstep, voffB);
        PG8_WAIT_V(6); PG8_BAR;
    } else {
        PG8_STAGE(PG8_SB(0, 0), cB, voffB); PG8_STAGE(PG8_SA(0, 0), cA, voffA); PG8_STAGE(PG8_SB(0, 1), cB + hstep, voffB); PG8_STAGE(PG8_SA(0, 1), cA + hstep, voffA);
        if (wr == 1) PG8_BAR;
        PG8_WAIT_V(4); PG8_BAR;
        PG8_STAGE(PG8_SB(1, 0), cB + kstep, voffB); PG8_STAGE(PG8_SA(1, 0), cA + kstep, voffA); PG8_STAGE(PG8_SB(1, 1), cB + hstep + kstep, voffB);
        PG8_WAIT_V(6); PG8_BAR;
    }
    for (;;) {
        const bool has_next = S.next(ui + 1, nxt);
        const char* nA = has_next ? (const char*)g.A + (size_t)nxt.pm * tstep : cA; const char* nB = has_next ? (const char*)g.Bt + (size_t)nxt.pn * tstep : cB;
        for (int t = 0; t < nt; t += 2) {
            const bool last = (t == nt - 2);
            const char* a1 = cA + (size_t)(t + 1) * kstep;
            const char* a2 = last ? nA : cA + (size_t)(t + 2) * kstep; const char* b2 = last ? nB : cB + (size_t)(t + 2) * kstep;
            const char* a3 = a2 + kstep; const char* b3 = b2 + kstep;
            if (last && has_next) S.a_ready(nxt);
            if constexpr (SP2) {
            PG8_LDB(B0, 0, 0); PG8_LDB(B1, 0, 1); PG8_SCHED; PG8_LDA(At, 0, 0); PG8_STAGE(PG8_SA(1, 1), a1 + hstep, voffA);
            PG8_WAIT_V(8); PG8_WAIT_L(0); PG8_BAR; PG8_MMA(0, 0, At, B0); PG8_MMA(0, 1, At, B1); PG8_BAR; PG8_SCHED;
            PG8_LDA(At, 0, 1); PG8_STAGE(PG8_SB(0, 0), b2, voffB); PG8_STAGE(PG8_SB(0, 1), b2 + hstep, voffB); PG8_STAGE(PG8_SA(0, 0), a2, voffA);
            PG8_WAIT_V(8); PG8_WAIT_L(0); PG8_BAR; PG8_MMA(1, 0, At, B0); PG8_MMA(1, 1, At, B1); PG8_BAR; PG8_SCHED;
            PG8_LDB(B0, 1, 0); PG8_LDB(B1, 1, 1); PG8_SCHED; PG8_LDA(At, 1, 0); PG8_STAGE(PG8_SA(0, 1), a2 + hstep, voffA);
            PG8_WAIT_V(8); PG8_WAIT_L(0); PG8_BAR; PG8_MMA(0, 0, At, B0); PG8_MMA(0, 1, At, B1); PG8_BAR; PG8_SCHED;
            PG8_LDA(At, 1, 1); PG8_STAGE(PG8_SB(1, 0), b3, voffB); PG8_STAGE(PG8_SB(1, 1), b3 + hstep, voffB); PG8_STAGE(PG8_SA(1, 0), a3, voffA);
            PG8_WAIT_V(8); PG8_WAIT_L(0); PG8_BAR; PG8_MMA(1, 0, At, B0); PG8_MMA(1, 1, At, B1); PG8_BAR; PG8_SCHED;
            } else {
            PG8_LDB(B0, 0, 0); PG8_SCHED; PG8_LDA(At, 0, 0); PG8_STAGE(PG8_SA(1, 1), a1 + hstep, voffA);
            PG8_WAIT_L(8); PG8_BAR; PG8_WAIT_L(0); PG8_MMA(0, 0, At, B0); PG8_BAR; PG8_SCHED;
            PG8_LDB(B1, 0, 1); PG8_STAGE(PG8_SB(0, 0), b2, voffB);
            PG8_BAR; PG8_WAIT_L(0); PG8_MMA(0, 1, At, B1); PG8_BAR;
            PG8_LDA(At, 0, 1); PG8_STAGE(PG8_SA(0, 0), a2, voffA);
            PG8_BAR; PG8_WAIT_L(0); PG8_MMA(1, 0, At, B0); PG8_BAR; PG8_SCHED;
            PG8_STAGE(PG8_SB(0, 1), b2 + hstep, voffB);
            PG8_WAIT_V(6); PG8_BAR; PG8_MMA(1, 1, At, B1); PG8_BAR;
            PG8_LDB(B0, 1, 0); PG8_SCHED; PG8_LDA(At, 1, 0); PG8_STAGE(PG8_SA(0, 1), a2 + hstep, voffA);
            PG8_WAIT_L(8); PG8_BAR; PG8_WAIT_L(0); PG8_MMA(0, 0, At, B0); PG8_BAR; PG8_SCHED;
            PG8_LDB(B1, 1, 1); PG8_STAGE(PG8_SB(1, 0), b3, voffB);
            PG8_BAR; PG8_WAIT_L(0); PG8_MMA(0, 1, At, B1); PG8_BAR;
            PG8_LDA(At, 1, 1); PG8_STAGE(PG8_SA(1, 0), a3, voffA);
            PG8_BAR; PG8_WAIT_L(0); PG8_MMA(1, 0, At, B0); PG8_BAR; PG8_SCHED;
            PG8_STAGE(PG8_SB(1, 1), b3 + hstep, voffB);
            PG8_WAIT_V(6); PG8_BAR; PG8_MMA(1, 1, At, B1); PG8_BAR;
            }
        }
        if constexpr (ALIGN_EPI) { if (wr == 0) PG8_BAR; }
        if constexpr (!Epi::AFTER_DRAIN) { E(acc, cur, ui, wr, wc, fr, fq); S.done(cur); }
        if (!has_next) break;
#pragma unroll
        for (int a = 0; a < 2; ++a)
#pragma unroll
            for (int b = 0; b < 2; ++b)
#pragma unroll
                for (int m = 0; m < 4; ++m)
#pragma unroll
                    for (int n = 0; n < 2; ++n) acc[a][b][m][n] = (f32x4){0.f, 0.f, 0.f, 0.f};
        cur = nxt; cA = nA; cB = nB; ++ui;
        if constexpr (ALIGN_EPI) { if (wr == 1) PG8_BAR; }
    }
    PG8_WAIT_V(0);
    if constexpr (!ALIGN_EPI) { if (wr == 0) PG8_BAR; }
    PG8_BAR;
    if constexpr (Epi::AFTER_DRAIN) { E.fused(acc, cur, wr, wc, fr, fq, lds, wid, lane); S.done(cur); }
#undef PG8_SA
#undef PG8_SB
#undef PG8_STAGE
#undef PG8_LDA
#undef PG8_LDB
#undef PG8_MMA
#undef PG8_WAIT_V
#undef PG8_WAIT_L
#undef PG8_BAR
#undef PG8_SCHED
}
}

constexpr int NWAVES = 8;
constexpr int BATCH = 8, SEQ = 4096, DM = 1024, NHEAD = 16, FF = 4096, DEPTH = 2;
constexpr int M = BATCH * SEQ;
constexpr int NIN = 3462, NINP = 3584;
constexpr float EPS = 1e-6f, LOG2E = 1.4426950408889634f;
#ifndef MK_ONE_LAUNCH
#define MK_ONE_LAUNCH 1
#endif
constexpr int NPH = 1 + 6 * DEPTH;

constexpr size_t MiB = 1u << 20;
constexpr size_t WS_CTL = 0, CTL_ZERO_BYTES = 1 * MiB;
constexpr size_t WS_W = 2 * MiB, W_LAYER = 25 * MiB, W_IN = 0, W_OUT = 7 * MiB, W_UP = 9 * MiB, W_DOWN = 17 * MiB;
constexpr size_t WS_SSQ = 52 * MiB;
constexpr size_t WS_LS = 54 * MiB;
constexpr size_t WS_KMP = 55 * MiB;
constexpr size_t WS_XB = 64 * MiB;
constexpr size_t WS_Q = 128 * MiB, WS_K = 192 * MiB, WS_V = 256 * MiB, WS_O = 320 * MiB;
constexpr size_t WS_Y = WS_Q;
constexpr size_t WS_H = 128 * MiB;
constexpr size_t WS_GF = 384 * MiB;
constexpr size_t WS_LD = 56 * MiB;
constexpr size_t WS_OD = 408 * MiB;
constexpr size_t WS_END = 480 * MiB;
constexpr int CW_BAR = 4096;

constexpr int RING_OFF = 0, RING_BYTES = 131072;
constexpr int LDSCTL_OFF = RING_BYTES, MISC_OFF = LDSCTL_OFF + 320;
constexpr int LDS_BYTES = 147456;

#define GAS __attribute__((address_space(1)))
#define LAS __attribute__((address_space(3)))
typedef unsigned short bf16;
typedef unsigned v4u __attribute__((ext_vector_type(4)));
typedef float f32x4 __attribute__((ext_vector_type(4)));
typedef GAS unsigned gu32;
#define RLX_AGENT __ATOMIC_RELAXED, __HIP_MEMORY_SCOPE_AGENT
#define LDS_WAIT() asm volatile("s_waitcnt lgkmcnt(0)" ::: "memory")
#define VM_WAIT() asm volatile("s_waitcnt vmcnt(0)" ::: "memory")
__device__ __forceinline__ unsigned f2bf(float f) { unsigned u = __builtin_bit_cast(unsigned, f); return (u + 0x7fffu + ((u >> 16) & 1u)) >> 16; }
__device__ __forceinline__ unsigned pk2(float lo, float hi) { return f2bf(lo) | (f2bf(hi) << 16); }
__device__ __forceinline__ float bflo(unsigned w) { return __builtin_bit_cast(float, w << 16); }
__device__ __forceinline__ float bfhi(unsigned w) { return __builtin_bit_cast(float, w & 0xffff0000u); }
#define XB_TMO      128
#define XB_XCNT(j)  (256  + 64 * (j))
#define XB_XSUB(j)  (1280 + 64 * (j))
#define XB_XGEN(j)  (2304 + 64 * (j))
#define XB_TOP      3328
#define XB_TOPGEN   3392
#define XCD_BAR_WORDS 3456
#define XB_SPIN_CAP (1u << 18)

__device__ __forceinline__ unsigned xb_ld(unsigned* p)              { return __hip_atomic_load(p, __ATOMIC_RELAXED, __HIP_MEMORY_SCOPE_AGENT); }
__device__ __forceinline__ unsigned xb_add(unsigned* p, unsigned v) { return __hip_atomic_fetch_add(p, v, __ATOMIC_RELAXED, __HIP_MEMORY_SCOPE_AGENT); }
__device__ __forceinline__ unsigned xb_xcc_id() { return (unsigned)__builtin_amdgcn_s_getreg((3 << 11) | 20) & 0xFu; }
#define XB_SPIN(cond, bar) do { unsigned _sp = 0; while (cond) { __builtin_amdgcn_s_sleep(1); \
    if ((++_sp & 255u) == 0u) { if (xb_ld(&(bar)[XB_TMO])) break; if (_sp > XB_SPIN_CAP) { atomicAdd(&(bar)[XB_TMO], 1u); break; } } } } while (0)

struct XcdBarrier {
    unsigned* bar; unsigned x;
    volatile LAS unsigned* st;
};

__device__ __forceinline__ XcdBarrier xcd_barrier_post(unsigned* bar, volatile LAS unsigned* st) {
    XcdBarrier b; b.bar = bar; b.x = xb_xcc_id(); b.st = st;
    if (threadIdx.x == 0) (void)xb_add(&bar[XB_XCNT(b.x)], 1u);
    return b;
}
__device__ __forceinline__ void xcd_barrier_complete(unsigned* bar, unsigned x, unsigned& nloc, unsigned& nx) {
    const unsigned G = gridDim.x * gridDim.y * gridDim.z;
    unsigned sum, cnt, mine, sp = 0u;
    for (;;) {
        sum = 0u; cnt = 0u; mine = 0u;
#pragma unroll
        for (unsigned j = 0; j < 16; ++j) { const unsigned c = xb_ld(&bar[XB_XCNT(j)]); sum += c; cnt += (c > 0u) ? 1u : 0u; mine = (j == x) ? c : mine; }
        if (sum == G) break;
        __builtin_amdgcn_s_sleep(1);
        if ((++sp & 255u) == 0u) { if (xb_ld(&bar[XB_TMO])) break; if (sp > XB_SPIN_CAP) { atomicAdd(&bar[XB_TMO], 1u); break; } }
    }
    nloc = mine > 0u ? mine : 1u; nx = cnt > 0u ? cnt : 1u;
}

__device__ __forceinline__ void xcd_barrier(const XcdBarrier& b, const int tid_x) {
    asm volatile("s_waitcnt vmcnt(0)" ::: "memory");
    __syncthreads();
    if (tid_x == 0) {
        unsigned* bar = b.bar;
        __builtin_amdgcn_s_waitcnt(0);
        unsigned nloc = b.st[0], nx = b.st[1];
        if (nloc == 0u) { xcd_barrier_complete(bar, b.x, nloc, nx); b.st[0] = nloc; b.st[1] = nx; }
        const unsigned old = xb_add(&bar[XB_XSUB(b.x)], 1u);
        const unsigned gen = old / nloc;
        if (old + 1u == (gen + 1u) * nloc) {
            __builtin_amdgcn_fence(__ATOMIC_RELEASE, "agent");
            asm volatile("s_waitcnt vmcnt(0)" ::: "memory");
            const unsigned og = xb_add(&bar[XB_TOP], 1u);
            const unsigned tg = og / nx;
            if (og + 1u == (tg + 1u) * nx) xb_add(&bar[XB_TOPGEN], 1u);
            else XB_SPIN(xb_ld(&bar[XB_TOPGEN]) == tg, bar);
            __builtin_amdgcn_fence(__ATOMIC_ACQUIRE, "agent");
            xb_add(&bar[XB_XGEN(b.x)], 1u);
            asm volatile("s_waitcnt vmcnt(0)" ::: "memory");
        } else {
            XB_SPIN(xb_ld(&bar[XB_XGEN(b.x)]) == gen, bar);
            __builtin_amdgcn_fence(__ATOMIC_ACQUIRE, "agent");
            asm volatile("s_waitcnt vmcnt(0)" ::: "memory");
        }
    }
    __syncthreads();
}

namespace att {
typedef unsigned short bf16;
using bf16x8 = __attribute__((ext_vector_type(8))) short;
using s16x4 = __attribute__((ext_vector_type(4))) short;
using f32x16 = __attribute__((ext_vector_type(16))) float;
using f32x4 = __attribute__((ext_vector_type(4))) float;
using u32x4 = __attribute__((ext_vector_type(4))) unsigned;
typedef __attribute__((address_space(3))) const char* lds_cptr;
typedef __attribute__((address_space(3))) float* lds_fptr;
typedef short v4i16_t __attribute__((ext_vector_type(4)));
constexpr int SLOTB = 8192, LDS_K = 0, LDS_V = 3 * SLOTB, LDS_WS = 6 * SLOTB, LDS_OST = LDS_WS + 8 * 256, LDS_X = LDS_OST + 8 * 4096, LDS_X2 = LDS_X + 16384, LDS_END = LDS_X2 + 1024;
constexpr int DMP = 1024;
#define ATT_WAIT_BAR(N) asm volatile("s_waitcnt vmcnt(" #N ") lgkmcnt(0)\n\ts_barrier" ::: "memory")
#define ATT_WAIT_BAR_L() asm volatile("s_waitcnt lgkmcnt(0)\n\ts_barrier" ::: "memory")
__device__ __forceinline__ void glds16(const void* gsrc, unsigned lds_dst) { unsigned keep;
    asm volatile("s_mov_b32 %0, m0\n\ts_mov_b32 m0, %2\n\ts_nop 0\n\tglobal_load_lds_dwordx4 %1, off\n\ts_mov_b32 m0, %0" : "=&s"(keep) : "v"(gsrc), "s"(lds_dst) : "memory"); }
typedef float f32x2_t __attribute__((ext_vector_type(2))); typedef __bf16 bf16x2_t __attribute__((ext_vector_type(2)));
__device__ __forceinline__ unsigned cvtpk(float lo, float hi) { f32x2_t v = {lo, hi}; bf16x2_t b = __builtin_convertvector(v, bf16x2_t); return __builtin_bit_cast(unsigned, b); }
__device__ __forceinline__ s16x4 vtr(lds_cptr p) { return __builtin_bit_cast(s16x4, __builtin_amdgcn_ds_read_tr16_b64_v4i16((__attribute__((address_space(3))) v4i16_t*)p)); }
__device__ __forceinline__ int crow(int r, int hi) { return (r & 3) + 8 * (r >> 2) + 4 * hi; }
#define ATT_NEG (-INFINITY)
#define ATT_SBAR() __builtin_amdgcn_sched_barrier(0)

struct UnitIO {
    const bf16* Q; long qstride;
    const bf16* K0; const bf16* V0; long kstride;
    bf16* O; long ostride;
    float* L; long lstride;
    bool norm;
};
struct BiasMoba {
    float slope2, tqf; int qrel, hi, w, nb0; unsigned selmask;
    __device__ __forceinline__ bool active(int t) const { return t < nb0 || (t - nb0) <= (w >> 1); }
    __device__ __forceinline__ void init(f32x16& c0, f32x16& c1, int t) const {
        float base = slope2 * ((float)(64 * t + 4 * hi) - tqf);
        if (t < nb0) { if (!((selmask >> (t >> 2)) & 1u)) base = ATT_NEG;
#pragma unroll
            for (int r = 0; r < 16; ++r) { const float v = base + slope2 * (float)((r & 3) + 8 * (r >> 2)); c0[r] = v; c1[r] = v + 32.0f * slope2; }
        } else { const int kb = 64 * (t - nb0) + 4 * hi;
#pragma unroll
            for (int r = 0; r < 16; ++r) { const int kv = kb + (r & 3) + 8 * (r >> 2); const float v = base + slope2 * (float)((r & 3) + 8 * (r >> 2)); c0[r] = kv > qrel ? ATT_NEG : v; c1[r] = kv + 32 > qrel ? ATT_NEG : v + 32.0f * slope2; }
        }
    }
};
struct BiasFox {
    lds_fptr cs2; float base; int qrel, hi, w, nb0;
    __device__ __forceinline__ bool active(int t) const { return t < nb0 || (t - nb0) <= (w >> 1); }
    __device__ __forceinline__ void init(f32x16& c0, f32x16& c1, int t) const {
        const lds_fptr p = cs2 + 64 * t + 4 * hi;
#pragma unroll
        for (int g = 0; g < 4; ++g) { const f32x4 a = *(const __attribute__((address_space(3))) f32x4*)(p + 8 * g), b = *(const __attribute__((address_space(3))) f32x4*)(p + 32 + 8 * g);
#pragma unroll
            for (int e = 0; e < 4; ++e) { c0[4 * g + e] = base - a[e]; c1[4 * g + e] = base - b[e]; } }
        if (t >= nb0) { const int kb = 64 * (t - nb0) + 4 * hi;
#pragma unroll
            for (int r = 0; r < 16; ++r) { const int kv = kb + (r & 3) + 8 * (r >> 2); if (kv > qrel) c0[r] = ATT_NEG; if (kv + 32 > qrel) c1[r] = ATT_NEG; } }
    }
};
struct BiasDil {
    float sd; int qrel, hi, w;
    __device__ __forceinline__ bool active(int t) const { return t >= (w >> 1) && t <= (w >> 1) + 2; }
    __device__ __forceinline__ void init(f32x16& c0, f32x16& c1, int t) const {
        const int kb = 64 * t + 4 * hi;
#pragma unroll
        for (int r = 0; r < 16; ++r) { const int off = qrel - (kb + (r & 3) + 8 * (r >> 2)); const float v = -sd * (float)off;
            c0[r] = ((unsigned)off <= 128u) ? v : ATT_NEG; c1[r] = ((unsigned)(off - 32) <= 128u) ? v + 32.0f * sd : ATT_NEG; }
    }
};

template <class BIAS>
__device__ __forceinline__ void attn_tiles(char* shm, const UnitIO& io, int t_begin, int t_end, const BIAS& B, int tid) {
    const int lane = tid & 63, r32 = lane & 31, hi = lane >> 5; const int wid = __builtin_amdgcn_readfirstlane(tid >> 6);
    const unsigned lds0 = (unsigned)(uintptr_t)shm;
    const bf16* ksrc = io.K0 + (long)lane * io.kstride + wid * 8;
    const bf16* vsrc = io.V0 + (long)(16 * (wid & 3) + (lane >> 2)) * io.kstride + (wid >> 2) * 32 + (lane & 3) * 8;
    const unsigned kdst = lds0 + LDS_K + wid * 1024, vdst = lds0 + LDS_V + wid * 1024;
    const long tstep = 64 * io.kstride;
#define ATT_DMA(t, slot) do { glds16(ksrc + (long)(t) * tstep, (unsigned)__builtin_amdgcn_readfirstlane(kdst + (slot))); glds16(vsrc + (long)(t) * tstep, (unsigned)__builtin_amdgcn_readfirstlane(vdst + (slot))); } while (0)
    const lds_cptr shm3 = (lds_cptr)shm;
    const lds_cptr kp0 = shm3 + LDS_K + hi * 1024 + r32 * 16;
    const lds_cptr vp0 = shm3 + LDS_V + ((lane >> 4) & 1) * 32 + (lane & 3) * 8 + (4 * hi + ((lane & 15) >> 2)) * 64;
    float* wsf = (float*)(shm + LDS_WS) + wid * 64;
    bf16x8 qr[4];
    { const bf16* qp = io.Q + (long)r32 * io.qstride + hi * 8;
#pragma unroll
      for (int d0 = 0; d0 < 4; ++d0) qr[d0] = *reinterpret_cast<const bf16x8*>(qp + d0 * 16); }
    ATT_DMA(t_begin, 0);
    asm volatile("" :: "v"(qr[0]), "v"(qr[1]), "v"(qr[2]), "v"(qr[3]));
    const bool two = (t_begin + 1 < t_end); if (two) ATT_DMA(t_begin + 1, SLOTB);
    f32x16 o[2]; o[0] = f32x16{}; o[1] = f32x16{}; float l_reg = 0.f;
    if (two) ATT_WAIT_BAR(2); else ATT_WAIT_BAR(0);
    const bool grpB = wid >= 4;
    if (grpB) ATT_WAIT_BAR_L();
    int sl_c = 0, sl_n = SLOTB, sl_nn = 2 * SLOTB;
#pragma unroll 1
    for (int t = t_begin; t < t_end; ++t) {
        const bool more = (t + 2 < t_end);
        const bool act = B.active(t);
        if (grpB && more) ATT_DMA(t + 2, sl_nn);
        u32x4 pw[4]; f32x16 c1x;
        if (act) {
            bf16x8 kf[8]; const lds_cptr kp = kp0 + sl_c;
#pragma unroll
            for (int j = 0; j < 4; ++j) { kf[2 * j] = *(const __attribute__((address_space(3))) bf16x8*)(kp + j * 2048); kf[2 * j + 1] = *(const __attribute__((address_space(3))) bf16x8*)(kp + j * 2048 + 512); }
            ATT_SBAR();
            f32x16 c0, c1; B.init(c0, c1, t);
            ATT_SBAR();
            asm volatile("" : "+v"(kf[0]), "+v"(kf[1]), "+v"(kf[2]), "+v"(kf[3]), "+v"(kf[4]), "+v"(kf[5]), "+v"(kf[6]), "+v"(kf[7]));
#pragma unroll
            for (int d0 = 0; d0 < 4; ++d0) { c0 = __builtin_amdgcn_mfma_f32_32x32x16_bf16(kf[2 * d0], qr[d0], c0, 0, 0, 0); c1 = __builtin_amdgcn_mfma_f32_32x32x16_bf16(kf[2 * d0 + 1], qr[d0], c1, 0, 0, 0); }
            float s0 = 0.f;
#pragma unroll
            for (int r = 0; r < 16; ++r) { c0[r] = __builtin_amdgcn_exp2f(c0[r]); s0 += c0[r]; }
            l_reg += s0;
#pragma unroll
            for (int i = 0; i < 4; ++i) { pw[0][i] = cvtpk(c0[2 * i], c0[2 * i + 1]); pw[1][i] = cvtpk(c0[8 + 2 * i], c0[9 + 2 * i]); }
            c1x = c1;
        }
        if (grpB) { if (more) ATT_WAIT_BAR(2); else ATT_WAIT_BAR(0); }
        else { ATT_WAIT_BAR_L(); if (more) ATT_DMA(t + 2, sl_nn); }
        if (act) {
            const lds_cptr vp = vp0 + sl_c;
            s16x4 vlo[8], vhi[8];
#pragma unroll
            for (int i = 0; i < 8; ++i) { vlo[i] = vtr(vp + (i >> 2) * 4096 + (i & 3) * 1024); vhi[i] = vtr(vp + (i >> 2) * 4096 + (i & 3) * 1024 + 512); }
            ATT_SBAR();
            { float s1 = 0.f;
#pragma unroll
              for (int r = 0; r < 16; ++r) { c1x[r] = __builtin_amdgcn_exp2f(c1x[r]); s1 += c1x[r]; }
              l_reg += s1;
#pragma unroll
              for (int i = 0; i < 4; ++i) { pw[2][i] = cvtpk(c1x[2 * i], c1x[2 * i + 1]); pw[3][i] = cvtpk(c1x[8 + 2 * i], c1x[9 + 2 * i]); } }
            ATT_SBAR();
            asm volatile("" : "+v"(vlo[0]), "+v"(vhi[0]), "+v"(vlo[1]), "+v"(vhi[1]), "+v"(vlo[2]), "+v"(vhi[2]), "+v"(vlo[3]), "+v"(vhi[3]));
#pragma unroll
            for (int ks = 0; ks < 4; ++ks) { const bf16x8 vf = (bf16x8){vlo[ks][0], vlo[ks][1], vlo[ks][2], vlo[ks][3], vhi[ks][0], vhi[ks][1], vhi[ks][2], vhi[ks][3]};
                o[0] = __builtin_amdgcn_mfma_f32_32x32x16_bf16(__builtin_bit_cast(bf16x8, pw[ks]), vf, o[0], 0, 0, 0); }
            ATT_SBAR();
            asm volatile("" : "+v"(vlo[4]), "+v"(vhi[4]), "+v"(vlo[5]), "+v"(vhi[5]), "+v"(vlo[6]), "+v"(vhi[6]), "+v"(vlo[7]), "+v"(vhi[7]));
#pragma unroll
            for (int ks = 0; ks < 4; ++ks) { const bf16x8 vf = (bf16x8){vlo[4 + ks][0], vlo[4 + ks][1], vlo[4 + ks][2], vlo[4 + ks][3], vhi[4 + ks][0], vhi[4 + ks][1], vhi[4 + ks][2], vhi[4 + ks][3]};
                o[1] = __builtin_amdgcn_mfma_f32_32x32x16_bf16(__builtin_bit_cast(bf16x8, pw[ks]), vf, o[1], 0, 0, 0); }
        }
        if (grpB) ATT_WAIT_BAR_L();
        else { if (more) ATT_WAIT_BAR(2); else ATT_WAIT_BAR(0); }
        const int tmp = sl_c; sl_c = sl_n; sl_n = sl_nn; sl_nn = tmp;
    }
    if (!grpB) ATT_WAIT_BAR_L();
#undef ATT_DMA
    { auto rr = __builtin_amdgcn_permlane32_swap(__float_as_uint(l_reg), __float_as_uint(l_reg), false, false); l_reg = __uint_as_float(rr[0]) + __uint_as_float(rr[1]); }
    if (hi == 0) wsf[32 + r32] = l_reg;
    asm volatile("s_waitcnt lgkmcnt(0)" ::: "memory");
    float rli[16];
#pragma unroll
    for (int r = 0; r < 16; ++r) rli[r] = io.norm ? __builtin_amdgcn_rcpf(wsf[32 + crow(r, hi)]) : 1.0f;
    if (!io.norm && hi == 0) io.L[(long)r32 * io.lstride] = l_reg;
    { bf16* stg = (bf16*)(shm + LDS_OST) + wid * 2048;
#pragma unroll
      for (int r = 0; r < 16; ++r) { const int orow = crow(r, hi);
#pragma unroll
          for (int d0 = 0; d0 < 2; ++d0) stg[orow * 64 + d0 * 32 + r32] = (bf16)(cvtpk(o[d0][r] * rli[r], 0.f) & 0xffffu); }
      asm volatile("s_waitcnt lgkmcnt(0)" ::: "memory");
#pragma unroll
      for (int i = 0; i < 4; ++i) { const int row = i * 8 + (lane >> 3), ch = lane & 7; const u32x4 v = *(const u32x4*)(stg + row * 64 + ch * 8); *(u32x4*)(io.O + (long)row * io.ostride + ch * 8) = v; } }
    asm volatile("s_waitcnt lgkmcnt(0)" ::: "memory");
}
}

struct Frame {
    LAS unsigned char* lds;
    volatile LAS unsigned* MISC;
    gu32* ctl;
    int tid, lane, wave;
    int vcu, G;
};
struct Ptrs {
    const float *x, *attn_norm, *w_in, *b_forget, *q_gain, *k_gain, *out_gain, *w_out, *mlp_norm, *w_up, *w_down;
    float* out; unsigned char* ws;
};

__device__ __forceinline__ float wave_sum(float v) {
#pragma unroll
    for (int o = 1; o < 64; o <<= 1) v += __shfl_xor(v, o);
    return v;
}

__device__ __forceinline__ int win_src(int cp) {
    const int tile = cp >> 8, within = cp & 255;
    if (tile < 12) { const int bj = within >> 7, wc = (within >> 5) & 3, j = within & 31; return tile * 256 + 64 * wc + 32 * bj + j; }
    if (tile == 12) return 3078 + within;
    if (within < 128) return 3078 + 256 + within;
    if (within < 134) return 3072 + (within - 128);
    return -1;
}
template <int MODE>
__device__ __forceinline__ void transpose_item(const float* W, int K, int N, const float* gain, bf16* WT, LAS float* scr, int item, int nblk, int lane) {
    const int kb = item / nblk, nb = item % nblk, k0 = 64 * kb, n0 = 32 * nb;
    const int sc = (MODE == 0) ? win_src(n0 + (lane & 31)) : (n0 + (lane & 31));
    const GAS float* src = (const GAS float*)W + (size_t)(k0 + (lane >> 5)) * N + (sc >= 0 ? sc : 0);
    const float keep = sc >= 0 ? 1.f : 0.f;
    float v[32];
#pragma unroll
    for (int i = 0; i < 32; ++i) v[i] = src[(size_t)(2 * i) * N];
    const int c = lane & 7;
    f32x4 g0 = (f32x4){1.f, 1.f, 1.f, 1.f}, g1 = g0;
    if (gain) { g0 = *(const GAS f32x4*)(gain + k0 + 8 * c); g1 = *(const GAS f32x4*)(gain + k0 + 8 * c + 4); }
#pragma unroll
    for (int i = 0; i < 32; ++i) scr[(2 * i + (lane >> 5)) * 33 + (lane & 31)] = v[i] * keep;
    LDS_WAIT(); asm volatile("" ::: "memory");
#pragma unroll
    for (int j = 0; j < 4; ++j) { const int n = (lane >> 3) + 8 * j; const LAS float* s = scr + (8 * c) * 33 + n;
        v4u o; o.x = pk2(s[0 * 33] * g0[0], s[1 * 33] * g0[1]); o.y = pk2(s[2 * 33] * g0[2], s[3 * 33] * g0[3]); o.z = pk2(s[4 * 33] * g1[0], s[5 * 33] * g1[1]); o.w = pk2(s[6 * 33] * g1[2], s[7 * 33] * g1[3]);
        *(GAS v4u*)(WT + (size_t)(n0 + n) * K + k0 + 8 * c) = o; }
    LDS_WAIT(); asm volatile("" ::: "memory");
}
__device__ __forceinline__ void p0_prologue(Frame& F, const Ptrs& P) {
    LAS float* scr = (LAS float*)(F.lds + RING_OFF + F.wave * 16384);
    const int gw = F.vcu * NWAVES + F.wave, NGW = F.G * NWAVES;
    constexpr int I_IN = (DM / 64) * (NINP / 32), I_OUT = (DM / 64) * (DM / 32), I_UP = (DM / 64) * (FF / 32), I_DN = (FF / 64) * (DM / 32);
    constexpr int I_LAYER = I_IN + I_OUT + I_UP + I_DN;
    for (int it = gw; it < DEPTH * I_LAYER; it += NGW) {
        const int l = it / I_LAYER; int r = it % I_LAYER;
        unsigned char* wl = P.ws + WS_W + (size_t)l * W_LAYER;
        if (r < I_IN) { transpose_item<0>(P.w_in + (size_t)l * DM * NIN, DM, NIN, P.attn_norm + l * DM, (bf16*)(wl + W_IN), scr, r, NINP / 32, F.lane); continue; } r -= I_IN;
        if (r < I_OUT) { transpose_item<1>(P.w_out + (size_t)l * DM * DM, DM, DM, P.out_gain + l * DM, (bf16*)(wl + W_OUT), scr, r, DM / 32, F.lane); continue; } r -= I_OUT;
        if (r < I_UP) { transpose_item<1>(P.w_up + (size_t)l * DM * FF, DM, FF, P.mlp_norm + l * DM, (bf16*)(wl + W_UP), scr, r, FF / 32, F.lane); continue; } r -= I_UP;
        transpose_item<1>(P.w_down + (size_t)l * FF * DM, FF, DM, nullptr, (bf16*)(wl + W_DOWN), scr, r, DM / 32, F.lane);
    }
    bf16* XB = (bf16*)(P.ws + WS_XB); float* SSQ = (float*)(P.ws + WS_SSQ);
#pragma unroll 1
    for (int m0 = gw; m0 < M; m0 += 4 * NGW) {
        f32x4 v[4][4]; float s[4];
#pragma unroll
        for (int q = 0; q < 4; ++q) { const int m = m0 + q * NGW; const GAS f32x4* xr = (const GAS f32x4*)(P.x + (size_t)(m < M ? m : m0) * DM) + F.lane;
#pragma unroll
            for (int j = 0; j < 4; ++j) v[q][j] = xr[64 * j]; }
#pragma unroll
        for (int q = 0; q < 4; ++q) { float t = 0.f;
#pragma unroll
            for (int j = 0; j < 4; ++j) t += (v[q][j].x * v[q][j].x + v[q][j].y * v[q][j].y) + (v[q][j].z * v[q][j].z + v[q][j].w * v[q][j].w);
            s[q] = wave_sum(t); }
#pragma unroll
        for (int q = 0; q < 4; ++q) { const int m = m0 + q * NGW; if (m < M) {
            GAS unsigned long long* o8 = (GAS unsigned long long*)(XB + (size_t)m * DM) + F.lane;
#pragma unroll
            for (int j = 0; j < 4; ++j) o8[64 * j] = (unsigned long long)pk2(v[q][j].x, v[q][j].y) | ((unsigned long long)pk2(v[q][j].z, v[q][j].w) << 32);
            if (F.lane < 16) SSQ[(size_t)m * 16 + F.lane] = F.lane == 0 ? s[q] : 0.f; } }
    }
}

__device__ __forceinline__ void unpack8(const v4u w, float* f) { f[0] = bflo(w.x); f[1] = bfhi(w.x); f[2] = bflo(w.y); f[3] = bfhi(w.y); f[4] = bflo(w.z); f[5] = bfhi(w.z); f[6] = bflo(w.w); f[7] = bfhi(w.w); }

struct AttnBufs { const bf16 *Q, *K, *V; bf16* O; bf16* OD; float* LD; const float* LS; const float* KMP; };
constexpr size_t OD_BRANCH = (size_t)M * 384, LD_BRANCH = (size_t)M * 8;

__device__ __forceinline__ void moba_unit(Frame& F, const AttnBufs& A, int b, int h, int qb) {
    char* shm = (char*)F.lds; const int tid = F.tid, lane = tid & 63, r32 = lane & 31, hi = lane >> 5, w = F.wave;
    LAS float* KM = (LAS float*)(F.lds + att::LDS_X);
    for (int i = tid; i < 1024; i += 512) { const int j = i >> 6, d = i & 63; float v = 0.f;
        if (j < qb) { const float* p = A.KMP + ((size_t)((b * 16 + j) * 4 + h) * 2) * 64 + d; v = p[0] + p[64]; } KM[i] = v; }
    const size_t row0 = (size_t)b * SEQ + qb * 256 + w * 32;
    const bf16* Qw = A.Q + row0 * DM + h * 64;
    float qf[32];
    { const bf16* qp = Qw + (size_t)r32 * DM + hi * 8;
#pragma unroll
      for (int d0 = 0; d0 < 4; ++d0) { const v4u wv = *(const v4u*)(qp + d0 * 16); unpack8(wv, qf + 8 * d0); } }
    __syncthreads();
    float g0 = -INFINITY, g1 = -INFINITY, g2 = -INFINITY; int i0 = -1, i1 = -1, i2 = -1;
#pragma unroll 1
    for (int j = 0; j < qb; ++j) {
        float dot = 0.f;
#pragma unroll
        for (int d0 = 0; d0 < 4; ++d0) { const f32x4 ka = *(const LAS f32x4*)(KM + j * 64 + d0 * 16 + hi * 8), kb = *(const LAS f32x4*)(KM + j * 64 + d0 * 16 + hi * 8 + 4);
#pragma unroll
            for (int e = 0; e < 4; ++e) { dot += qf[8 * d0 + e] * ka[e]; dot += qf[8 * d0 + 4 + e] * kb[e]; } }
        { auto rr = __builtin_amdgcn_permlane32_swap(__float_as_uint(dot), __float_as_uint(dot), false, false); dot = __uint_as_float(rr[0]) + __uint_as_float(rr[1]); }
        if (dot > g0) { g2 = g1; i2 = i1; g1 = g0; i1 = i0; g0 = dot; i0 = j; } else if (dot > g1) { g2 = g1; i2 = i1; g1 = dot; i1 = j; } else if (dot > g2) { g2 = dot; i2 = j; }
    }
    unsigned selmask = 0u; if (i0 >= 0) selmask |= 1u << i0; if (i1 >= 0) selmask |= 1u << i1; if (i2 >= 0) selmask |= 1u << i2;
    att::BiasMoba B; B.slope2 = exp2f(-8.0f * (float)(7 + h) / 10.0f) * LOG2E; B.qrel = w * 32 + r32; B.tqf = (float)(qb * 256 + B.qrel); B.hi = hi; B.w = w; B.nb0 = 4 * qb; B.selmask = selmask;
    att::UnitIO io; io.Q = Qw; io.qstride = DM; io.K0 = A.K + (size_t)b * SEQ * DM + h * 64; io.V0 = A.V + (size_t)b * SEQ * DM + h * 64; io.kstride = DM;
    io.O = A.O + row0 * DM + h * 64; io.ostride = DM; io.L = nullptr; io.lstride = 0; io.norm = true;
#ifdef PROBE_UNIT_OVH
    att::attn_tiles(shm, io, 4 * qb + 3, 4 * qb + 4, B, tid);
#endif
    att::attn_tiles(shm, io, 0, 4 * qb + 4, B, tid);
}
__device__ __forceinline__ void fox_unit(Frame& F, const AttnBufs& A, int b, int h, int qb) {
    char* shm = (char*)F.lds; const int tid = F.tid, lane = tid & 63, r32 = lane & 31, hi = lane >> 5, w = F.wave;
    LAS float* CS = (LAS float*)(F.lds + att::LDS_X); LAS float* WT = (LAS float*)(F.lds + att::LDS_X2);
    const int n = 256 * (qb + 1);
    const float* ls = A.LS + (size_t)(h - 4) * M + (size_t)b * SEQ;
    float v[8]; float run = 0.f;
    if (8 * tid < n) { const f32x4 a = *(const f32x4*)(ls + 8 * tid), c = *(const f32x4*)(ls + 8 * tid + 4);
        v[0] = a[0]; v[1] = a[1]; v[2] = a[2]; v[3] = a[3]; v[4] = c[0]; v[5] = c[1]; v[6] = c[2]; v[7] = c[3];
#pragma unroll
        for (int e = 0; e < 8; ++e) { run += v[e] * LOG2E; v[e] = run; } }
    else {
#pragma unroll
        for (int e = 0; e < 8; ++e) v[e] = 0.f; }
    float inc = run;
#pragma unroll
    for (int o = 1; o < 64; o <<= 1) { const float up = __shfl_up(inc, o); if (lane >= o) inc += up; }
    if (lane == 63) WT[w] = inc;
    __syncthreads();
    float woff = 0.f;
#pragma unroll
    for (int k = 0; k < 8; ++k) { const float tk = WT[k]; if (k < w) woff += tk; }
    const float excl = woff + inc - run;
    if (8 * tid < n) {
        *(LAS f32x4*)(CS + 8 * tid) = (f32x4){v[0] + excl, v[1] + excl, v[2] + excl, v[3] + excl}; *(LAS f32x4*)(CS + 8 * tid + 4) = (f32x4){v[4] + excl, v[5] + excl, v[6] + excl, v[7] + excl}; }
    __syncthreads();
    const int nb0 = 4 * qb; const float c_first = CS[qb * 256];
    int t_begin = 0;
    { bool skip = false; if (lane < nb0) skip = (c_first - CS[64 * lane + 63]) < -100.0f;
      const unsigned long long bm = __ballot(skip); t_begin = (int)__builtin_ctzll(~bm); if (t_begin > nb0) t_begin = nb0; }
    t_begin = __builtin_amdgcn_readfirstlane(t_begin);
    att::BiasFox B; B.cs2 = CS; B.qrel = w * 32 + r32; B.base = CS[qb * 256 + B.qrel]; B.hi = hi; B.w = w; B.nb0 = nb0;
    const size_t row0 = (size_t)b * SEQ + qb * 256 + w * 32;
    att::UnitIO io; io.Q = A.Q + row0 * DM + h * 64; io.qstride = DM; io.K0 = A.K + (size_t)b * SEQ * DM + h * 64; io.V0 = A.V + (size_t)b * SEQ * DM + h * 64; io.kstride = DM;
    io.O = A.O + row0 * DM + h * 64; io.ostride = DM; io.L = nullptr; io.lstride = 0; io.norm = true;
#ifdef PROBE_UNIT_OVH
    att::attn_tiles(shm, io, nb0 + 3, nb0 + 4, B, tid);
#endif
    att::attn_tiles(shm, io, t_begin, nb0 + 4, B, tid);
}
__device__ __forceinline__ void dil_unit(Frame& F, const AttnBufs& A, int b, int h, int g, int r, int c) {
    char* shm = (char*)F.lds; const int tid = F.tid, lane = tid & 63, r32 = lane & 31, hi = lane >> 5, w = F.wave;
    const int dil = (g == 0) ? 1 : (g == 1 ? 4 : 16);
    const int i0 = 256 * c;
    att::BiasDil B; B.sd = exp2f(-8.0f * (float)(h - 10 + 1) / 10.0f) * LOG2E * (float)dil; B.qrel = 128 + w * 32 + r32; B.hi = hi; B.w = w;
    const long tok_q0 = (long)b * SEQ + r + (long)dil * (i0 + w * 32);
    const long tok_k0 = (long)b * SEQ + r + (long)dil * (i0 - 128);
    att::UnitIO io; io.Q = A.Q + tok_q0 * DM + h * 64; io.qstride = (long)DM * dil; io.K0 = A.K + tok_k0 * DM + h * 64; io.V0 = A.V + tok_k0 * DM + h * 64; io.kstride = (long)DM * dil;
    io.O = A.OD + (size_t)g * OD_BRANCH + tok_q0 * 384 + (h - 10) * 64; io.ostride = (long)384 * dil; io.L = A.LD + (size_t)g * LD_BRANCH + tok_q0 * 8 + (h - 10); io.lstride = (long)8 * dil; io.norm = false;
#ifdef PROBE_UNIT_OVH
    att::attn_tiles(shm, io, 5, 6, B, tid);
#endif
    att::attn_tiles(shm, io, c == 0 ? 2 : 0, 6, B, tid);
}
__device__ __forceinline__ void attn_phase(Frame& F, const AttnBufs& A) {
#ifndef PROBE_DUP_ATT
#define PROBE_DUP_ATT 0
#endif
    const int v = F.vcu, G = F.G;
    for (int rep = 0; rep < ((PROBE_DUP_ATT & 1) ? 2 : 1); ++rep)
    for (int i = v; i < 512; i += G) { const int k = i >> 8, j = i & 255, bh = j >> 3, s = j & 7; moba_unit(F, A, bh >> 2, bh & 3, k == 0 ? s : 15 - s); }
    for (int rep = 0; rep < ((PROBE_DUP_ATT & 2) ? 2 : 1); ++rep)
    for (int f = v; f < 768; f += G) { const int k = f >> 8, bhf = f >> 4, qb = ((f & 15) + 5 * k) & 15; fox_unit(F, A, bhf / 6, 4 + bhf % 6, qb); }
    for (int rep = 0; rep < ((PROBE_DUP_ATT & 4) ? 2 : 1); ++rep)
    for (int u = v; u < 2304; u += G) { const int bh6 = u / 48, rest = u % 48, g = rest >> 4, idx = rest & 15;
        const int r = (g == 0) ? 0 : (g == 1 ? (idx >> 2) : idx), c = (g == 0) ? idx : (g == 1 ? (idx & 3) : 0);
        dil_unit(F, A, bh6 / 6, 10 + bh6 % 6, g, r, c); }
}
struct NormRow { v4u oa, oc, d0, d1, d2, ga, gc; float l0, l1, l2; };
__device__ __forceinline__ void norm_load(NormRow& R, int m, int lane, const bf16* O, const bf16* GF, const bf16* OD, const float* LD) {
    R.oa = *(const GAS v4u*)(O + (size_t)m * DM + 8 * lane);
    if (lane < 16) { R.oc = *(const GAS v4u*)(O + (size_t)m * DM + 512 + 8 * lane); R.gc = *(const GAS v4u*)(GF + (size_t)m * 384 + 256 + 8 * lane); }
    else { const int dc = 8 * lane - 128, hd = dc >> 6;
        R.d0 = *(const GAS v4u*)(OD + (size_t)m * 384 + dc); R.d1 = *(const GAS v4u*)(OD + OD_BRANCH + (size_t)m * 384 + dc); R.d2 = *(const GAS v4u*)(OD + 2 * OD_BRANCH + (size_t)m * 384 + dc);
        R.l0 = LD[(size_t)m * 8 + hd]; R.l1 = LD[LD_BRANCH + (size_t)m * 8 + hd]; R.l2 = LD[2 * LD_BRANCH + (size_t)m * 8 + hd]; }
    if (lane >= 32) R.ga = *(const GAS v4u*)(GF + (size_t)m * 384 + 8 * lane - 256);
}
__device__ __forceinline__ void norm_finish(const NormRow& R, int m, int lane, bf16* Y) {
    float fa[8], fc[8];
    unpack8(R.oa, fa);
    if (lane < 16) unpack8(R.oc, fc);
    else { float f0[8], f1[8], f2[8]; unpack8(R.d0, f0); unpack8(R.d1, f1); unpack8(R.d2, f2);
        const float inv = 1.0f / (R.l0 + R.l1 + R.l2);
#pragma unroll
        for (int e = 0; e < 8; ++e) fc[e] = (f0[e] + f1[e] + f2[e]) * inv; }
    float sa = 0.f, sc = 0.f;
#pragma unroll
    for (int e = 0; e < 8; ++e) { sa += fa[e] * fa[e]; sc += fc[e] * fc[e]; }
    const float s_moba = wave_sum(lane < 32 ? sa : 0.f), s_fox = wave_sum((lane >= 32 ? sa : 0.f) + (lane < 16 ? sc : 0.f)), s_dil = wave_sum(lane >= 16 ? sc : 0.f);
    const float r_moba = 1.0f / sqrtf(s_moba * (1.0f / 256.0f) + EPS), r_fox = 1.0f / sqrtf(s_fox * (1.0f / 384.0f) + EPS), r_dil = 1.0f / sqrtf(s_dil * (1.0f / 384.0f) + EPS);
    float ga[8], gc[8];
#pragma unroll
    for (int e = 0; e < 8; ++e) { ga[e] = 1.f; gc[e] = 1.f; }
    if (lane >= 32) unpack8(R.ga, ga);
    if (lane < 16) unpack8(R.gc, gc);
    const float ra = lane < 32 ? r_moba : r_fox, rc = lane < 16 ? r_fox : r_dil;
    v4u ya, yc;
    ya.x = pk2(fa[0] * ra * ga[0], fa[1] * ra * ga[1]); ya.y = pk2(fa[2] * ra * ga[2], fa[3] * ra * ga[3]); ya.z = pk2(fa[4] * ra * ga[4], fa[5] * ra * ga[5]); ya.w = pk2(fa[6] * ra * ga[6], fa[7] * ra * ga[7]);
    yc.x = pk2(fc[0] * rc * gc[0], fc[1] * rc * gc[1]); yc.y = pk2(fc[2] * rc * gc[2], fc[3] * rc * gc[3]); yc.z = pk2(fc[4] * rc * gc[4], fc[5] * rc * gc[5]); yc.w = pk2(fc[6] * rc * gc[6], fc[7] * rc * gc[7]);
    *(GAS v4u*)(Y + (size_t)m * DM + 8 * lane) = ya; *(GAS v4u*)(Y + (size_t)m * DM + 512 + 8 * lane) = yc;
}
__device__ __forceinline__ void norm_phase(Frame& F, const bf16* O, const bf16* GF, const bf16* OD, const float* LD, bf16* Y) {
    const int gw = F.vcu * NWAVES + F.wave, NGW = F.G * NWAVES, lane = F.lane;
#pragma unroll 1
    for (int m = gw; m < M; m += 4 * NGW) {
        NormRow R0, R1, R2, R3; const int m1 = m + NGW, m2 = m + 2 * NGW, m3 = m + 3 * NGW;
        norm_load(R0, m, lane, O, GF, OD, LD); if (m1 < M) norm_load(R1, m1, lane, O, GF, OD, LD); if (m2 < M) norm_load(R2, m2, lane, O, GF, OD, LD); if (m3 < M) norm_load(R3, m3, lane, O, GF, OD, LD);
        norm_finish(R0, m, lane, Y); if (m1 < M) norm_finish(R1, m1, lane, Y); if (m2 < M) norm_finish(R2, m2, lane, Y); if (m3 < M) norm_finish(R3, m3, lane, Y);
    }
}

struct Args { const float* in[11]; float* out; unsigned char* ws; int ph_lo, ph_hi; };
__global__ void __launch_bounds__(NWAVES * 64, 2) mk_fwd(Args args) {
    __shared__ __attribute__((aligned(16))) unsigned char lds[LDS_BYTES];
    for (int u = threadIdx.x; u < (LDS_BYTES - LDSCTL_OFF) / 4; u += NWAVES * 64) ((LAS unsigned*)((LAS unsigned char*)lds + LDSCTL_OFF))[u] = 0u;
    __syncthreads();
    const int lo = args.ph_lo, hi = args.ph_hi;
    XcdBarrier bar; bar.bar = (unsigned*)(args.ws + WS_CTL) + CW_BAR; bar.x = 0; bar.st = nullptr;
    if (hi - lo > 1) bar = xcd_barrier_post((unsigned*)(args.ws + WS_CTL) + CW_BAR, (volatile LAS unsigned*)((LAS unsigned char*)lds + MISC_OFF) + 8);
#ifndef PROBE_DUP_PHASE
#define PROBE_DUP_PHASE -1
#endif
    int dup_left = 1;
#pragma unroll 1
    for (int ph = lo; ph < hi; ++ph) {
        unsigned char* ws = args.ws; asm volatile("" : "+s"(ws));
        int tid_ = threadIdx.x; asm volatile("" : "+v"(tid_));
        int bid_ = blockIdx.x, G_ = gridDim.x; asm volatile("" : "+s"(bid_), "+s"(G_));
        Frame F;
        F.lds = (LAS unsigned char*)lds;
        F.MISC = (volatile LAS unsigned*)(F.lds + MISC_OFF);
        F.tid = tid_; F.lane = F.tid & 63; F.wave = __builtin_amdgcn_readfirstlane(F.tid >> 6);
        F.G = G_; F.vcu = (F.G % 8 == 0) ? (bid_ % 8) * (F.G / 8) + bid_ / 8 : bid_;
        F.ctl = (gu32*)(ws + WS_CTL);
        Ptrs P;
        P.x = args.in[0]; P.attn_norm = args.in[1]; P.w_in = args.in[2]; P.b_forget = args.in[3]; P.q_gain = args.in[4]; P.k_gain = args.in[5];
        P.out_gain = args.in[6]; P.w_out = args.in[7]; P.mlp_norm = args.in[8]; P.w_up = args.in[9]; P.w_down = args.in[10]; P.out = args.out; P.ws = ws;
        PG8_LAS float* tab = (PG8_LAS float*)(F.lds + pg8::TAB_OFF);
        if (ph == 0) { p0_prologue(F, P); }
        else {
            const int l = (ph - 1) / 6, k = (ph - 1) % 6;
            unsigned char* wl = ws + WS_W + (size_t)l * W_LAYER;
            bf16* XB = (bf16*)(ws + WS_XB);
            if (k == 0) {
                pg8::Gemm g{XB, (const bf16*)(wl + W_IN), M, NINP, DM}; pg8::StaticOrder S; S.init(M, NINP, F.G, bid_);
                pg8::EpiIn E{ws, P.b_forget + l * 6, tab};
                pg8::prep_tables(S, tab, ws, P.q_gain + l * 1024, P.k_gain + l * 1024, F.tid); __syncthreads();
                pg8::gemm_phase<pg8::EpiIn, pg8::StaticOrder, true, true>(F.lds + RING_OFF, g, S, E, F.tid);
            } else if (k == 1) {
                const AttnBufs AB{(const bf16*)(ws + WS_Q), (const bf16*)(ws + WS_K), (const bf16*)(ws + WS_V), (bf16*)(ws + WS_O), (bf16*)(ws + WS_OD), (float*)(ws + WS_LD), (const float*)(ws + WS_LS), (const float*)(ws + WS_KMP)};
                attn_phase(F, AB);
            } else if (k == 2) {
                norm_phase(F, (const bf16*)(ws + WS_O), (const bf16*)(ws + WS_GF), (const bf16*)(ws + WS_OD), (const float*)(ws + WS_LD), (bf16*)(ws + WS_Y));
            } else if (k == 4) {
                pg8::Gemm g{XB, (const bf16*)(wl + W_UP), M, FF, DM}; pg8::StaticOrder S; S.init(M, FF, F.G, bid_);
                pg8::EpiUp E{ws, tab};
                pg8::prep_tables(S, tab, ws, nullptr, nullptr, F.tid); __syncthreads();
                pg8::gemm_phase<pg8::EpiUp, pg8::StaticOrder, true, true>(F.lds + RING_OFF, g, S, E, F.tid);
            } else {
                const bool dn = (k == 5);
                pg8::Gemm g{dn ? (const bf16*)(ws + WS_H) : (const bf16*)(ws + WS_Y), (const bf16*)(wl + (dn ? W_DOWN : W_OUT)), M, DM, dn ? FF : DM};
                pg8::StaticOrder S; S.init(M, DM, F.G, bid_);
                pg8::EpiRes E{P.out, ws, ph == NPH - 1};
                pg8::gemm_phase<pg8::EpiRes, pg8::StaticOrder, true, true>(F.lds + RING_OFF, g, S, E, F.tid);
            }
        }
        if (ph == PROBE_DUP_PHASE && dup_left > 0) { --dup_left; --ph; }
        if (ph + 1 < hi) { XcdBarrier b2 = bar; asm volatile("" : "+s"(b2.bar)); xcd_barrier(b2, F.tid); }
#ifdef PROBE_DBL_BAR
        if (ph + 1 < hi) { XcdBarrier b3 = bar; asm volatile("" : "+s"(b3.bar)); xcd_barrier(b3, F.tid); }
#endif
    }
}

extern "C" void kernel_launch(void* const* d_in, const int* in_sizes, int n_in, void* d_out, int out_size, void* d_ws, size_t ws_size, hipStream_t stream) {
    static int grid = 0;
    if (grid == 0) {
        if (n_in != 11 || in_sizes[0] != M * DM || out_size != M * DM || ws_size < WS_END) { fprintf(stderr, "kernel_launch: unexpected shapes (n_in %d in0 %d out %d ws %zu)\n", n_in, n_in > 0 ? in_sizes[0] : -1, out_size, ws_size); grid = -1; return; }
        int dev = 0, cus = 0, per_cu = 0;
        if (hipGetDevice(&dev) != hipSuccess || hipDeviceGetAttribute(&cus, hipDeviceAttributeMultiprocessorCount, dev) != hipSuccess) { grid = -1; return; }
        if (hipOccupancyMaxActiveBlocksPerMultiprocessor(&per_cu, (const void*)mk_fwd, NWAVES * 64, 0) != hipSuccess || per_cu < 1) { fprintf(stderr, "kernel_launch: occupancy query says %d blocks per CU\n", per_cu); (void)hipGetLastError(); grid = -1; return; }
        grid = cus;
    }
    if (grid < 0) return;
    (void)hipMemsetAsync((char*)d_ws + WS_CTL, 0, CTL_ZERO_BYTES, stream);
    Args a{};
    for (int i = 0; i < 11; ++i) a.in[i] = (const float*)d_in[i];
    a.out = (float*)d_out; a.ws = (unsigned char*)d_ws;
#if MK_ONE_LAUNCH
    a.ph_lo = 0; a.ph_hi = NPH;
    hipLaunchKernelGGL(mk_fwd, dim3(grid), dim3(NWAVES * 64), 0, stream, a);
#else
    for (int p = 0; p < NPH; ++p) { a.ph_lo = p; a.ph_hi = p + 1; hipLaunchKernelGGL(mk_fwd, dim3(grid), dim3(NWAVES * 64), 0, stream, a); }
#endif
}
```

```cpp
#include <hip/hip_runtime.h>
#include <cstdio>
#include <cstdint>
namespace pg8 {
#define PG8_LAS __attribute__((address_space(3)))
typedef unsigned short bf16_t;
typedef short bf16x8 __attribute__((ext_vector_type(8)));
typedef float f32x4 __attribute__((ext_vector_type(4)));
typedef unsigned u32x4 __attribute__((ext_vector_type(4)));
constexpr int BM = 256, BK = 64, HALF = 128, HTB = HALF * BK * 2  , STAGE_BYTES = 8 * HTB, NXCD = 8, WGM = 8;

__host__ __device__ __forceinline__ int lds_byte(int r, int c) { const int st = (r >> 4) * 2 + (c >> 5), rr = r & 15, cc = c & 31, ob = rr * 64 + cc * 2; return st * 1024 + (ob ^ (((ob >> 9) & 1) << 5)); }
__host__ __device__ __forceinline__ void stage_rc(int b, int& R, int& C) { const int st = b / 1024, sb = b % 1024, swz = sb ^ (((sb >> 9) & 1) << 5); R = (st >> 1) * 16 + swz / 64; C = (st & 1) * 32 + (swz % 64) / 2; }
__host__ __device__ __forceinline__ int perm32(int rho) { const int n = rho >> 4, i = rho & 15; return 8 * (i >> 2) + 4 * n + (i & 3); }

struct Unit { int pm, pn; };
struct Gemm { const bf16_t* A; const bf16_t* Bt; int M, N, K; int lda; long padj; };

struct StaticOrder {
    int nM, nN, nwg, G, c;
    __host__ __device__ void init(int M, int N, int G_, int c_) { nM = M / BM; nN = N / BM; nwg = nM * nN; G = G_; c = c_; }
    __host__ __device__ bool next(int i, Unit& u) const {
        const long L = (long)i * G + c; if (L >= nwg) return false;
        int wgid = (int)L; { const int q = nwg / NXCD, r = nwg % NXCD, xcd = wgid % NXCD, off = wgid / NXCD; wgid = (xcd < r ? xcd * (q + 1) : r * (q + 1) + (xcd - r) * q) + off; }
        const int nig = WGM * nN, gid = wgid / nig, fm = gid * WGM, gsz = (nM - fm) < WGM ? (nM - fm) : WGM;
        u.pm = fm + ((wgid % nig) % gsz); u.pn = (wgid % nig) / gsz; return true;
    }
    __device__ __forceinline__ void a_ready(const Unit&) const {}
    __device__ __forceinline__ void done(const Unit&) const {}
};


__device__ __forceinline__ unsigned cvt_pk_bf16(float lo, float hi) { unsigned r; asm volatile("v_cvt_pk_bf16_f32 %0, %1, %2" : "=v"(r) : "v"(lo), "v"(hi)); return r; }
constexpr float RMS_EPS = 1e-6f;
constexpr float QSCALE = 0.125f * 1.4426950408889634f;
constexpr int TAB_OFF = 131072 + 512, TAB_G = 2048;
constexpr size_t EMiB = 1u << 20;
constexpr size_t E_SSQ = 52 * EMiB, E_LS = 54 * EMiB, E_KMP = 55 * EMiB, E_PRM = 56 * EMiB, E_XB = 64 * EMiB, E_QKVO = 128 * EMiB  , E_H = 128 * EMiB, E_GF = 384 * EMiB;
__device__ __forceinline__ float row_rstd(const float* ssq, unsigned row) {
    const float* p = ssq + (size_t)(row * 16u);
    const f32x4 a = *(const f32x4*)(p), b = *(const f32x4*)(p + 4), c = *(const f32x4*)(p + 8), d = *(const f32x4*)(p + 12);
    const float s = ((a[0] + a[1]) + (a[2] + a[3])) + ((b[0] + b[1]) + (b[2] + b[3])) + ((c[0] + c[1]) + (c[2] + c[3])) + ((d[0] + d[1]) + (d[2] + d[3]));
    return 1.0f / sqrtf(s * (1.0f / 1024.0f) + RMS_EPS);
}
template <class Sched>
__device__ __forceinline__ void prep_tables(const Sched& S, PG8_LAS float* tab, const unsigned char* ws, const float* qg, const float* kg  , int tid) {
    Unit u;
#pragma unroll 1
    for (int i = 0; i < 8 && S.next(i, u); ++i) {
        if (tid < 256) tab[i * 256 + tid] = row_rstd((const float*)(ws + E_SSQ), (unsigned)(u.pm * BM + tid));
        else if (qg && u.pn < 8) { const int c = tid - 256; tab[TAB_G + i * 256 + c] = u.pn < 4 ? qg[(u.pn & 3) * 256 + c] * QSCALE : kg[(u.pn & 3) * 256 + c]; }
    }
}
#define PG8_GAS __attribute__((address_space(1)))
#define PG8_PACK8(y0, y1) (u32x4){cvt_pk_bf16((y0)[0], (y0)[1]), cvt_pk_bf16((y0)[2], (y0)[3]), cvt_pk_bf16((y1)[0], (y1)[1]), cvt_pk_bf16((y1)[2], (y1)[3])}
struct EpiIn {
    static constexpr bool PERM = true, AFTER_DRAIN = false;
    unsigned char* ws; const float* bfg; PG8_LAS float* tab;
    __device__ __forceinline__ void operator()(const f32x4 (&acc)[2][2][4][2], const Unit& u, int ui, int wr, int wc, int fr, int fq) const {
        const int pn = u.pn; const unsigned row0 = (unsigned)(u.pm * BM + wr * 64 + fr);
        const PG8_LAS float* rsp = tab + ui * 256 + wr * 64 + fr;
        if (pn < 8) {
            const PG8_LAS float* gp = tab + TAB_G + ui * 256 + 64 * wc + 8 * fq;
            f32x4 g[2][2];
#pragma unroll
            for (int bj = 0; bj < 2; ++bj)
#pragma unroll
                for (int n = 0; n < 2; ++n) g[bj][n] = *(const PG8_LAS f32x4*)(gp + 32 * bj + 4 * n);
            unsigned char* dst = ws + E_QKVO + (size_t)((unsigned)(u.pm >> 4) * (24u << 20) + (pn < 4 ? 0u : (8u << 20)) + (unsigned)(((pn & 3) * 256 + wc * 64 + 8 * fq) * 2));
            float ss[2][4], e2[2][4];
#pragma unroll
            for (int ai = 0; ai < 2; ++ai)
#pragma unroll
                for (int m = 0; m < 4; ++m) {
                    const float rs = rsp[ai * HALF + m * 16]; e2[ai][m] = RMS_EPS * __builtin_amdgcn_rcpf(rs * rs);
                    f32x4 s4 = acc[ai][0][m][0] * acc[ai][0][m][0]; s4 += acc[ai][0][m][1] * acc[ai][0][m][1]; s4 += acc[ai][1][m][0] * acc[ai][1][m][0]; s4 += acc[ai][1][m][1] * acc[ai][1][m][1];
                    ss[ai][m] = (s4[0] + s4[1]) + (s4[2] + s4[3]);
                }
            float sw[2][4];
#pragma unroll
            for (int ai = 0; ai < 2; ++ai)
#pragma unroll
                for (int m = 0; m < 4; ++m) sw[ai][m] = __builtin_bit_cast(float, __builtin_amdgcn_ds_swizzle(__builtin_bit_cast(int, ss[ai][m]), 0x401F));
#pragma unroll
            for (int ai = 0; ai < 2; ++ai)
#pragma unroll
                for (int m = 0; m < 4; ++m) { float s = ss[ai][m] + sw[ai][m]; s += __shfl_xor(s, 32);
                    ss[ai][m] = __builtin_amdgcn_rsqf(s * (1.0f / 64.0f) + e2[ai][m]); }
            if (pn != 4) {
#pragma unroll
                for (int ai = 0; ai < 2; ++ai)
#pragma unroll
                    for (int m = 0; m < 4; ++m) {
                        const unsigned row = row0 + ai * HALF + m * 16; const float r2 = ss[ai][m];
#pragma unroll
                        for (int bj = 0; bj < 2; ++bj) {
                            const f32x4 z0 = acc[ai][bj][m][0] * (g[bj][0] * r2), z1 = acc[ai][bj][m][1] * (g[bj][1] * r2);
                            *(u32x4*)(dst + (size_t)(row * 2048u + 64u * bj)) = PG8_PACK8(z0, z1);
                        }
                    }
            } else {
                f32x4 ks[2][2];
#pragma unroll
                for (int bj = 0; bj < 2; ++bj)
#pragma unroll
                    for (int n = 0; n < 2; ++n) ks[bj][n] = (f32x4){0.f, 0.f, 0.f, 0.f};
#pragma unroll
                for (int ai = 0; ai < 2; ++ai)
#pragma unroll
                    for (int m = 0; m < 4; ++m) {
                        const unsigned row = row0 + ai * HALF + m * 16; const float r2 = ss[ai][m];
#pragma unroll
                        for (int bj = 0; bj < 2; ++bj) {
                            const f32x4 z0 = acc[ai][bj][m][0] * (g[bj][0] * r2), z1 = acc[ai][bj][m][1] * (g[bj][1] * r2);
                            ks[bj][0] += z0; ks[bj][1] += z1;
                            *(u32x4*)(dst + (size_t)(row * 2048u + 64u * bj)) = PG8_PACK8(z0, z1);
                        }
                    }
#pragma unroll
                for (int bj = 0; bj < 2; ++bj)
#pragma unroll
                    for (int n = 0; n < 2; ++n)
#pragma unroll
                        for (int e = 0; e < 4; ++e) { float s = ks[bj][n][e]; s += __shfl_xor(s, 1); s += __shfl_xor(s, 2); s += __shfl_xor(s, 4); s += __shfl_xor(s, 8); ks[bj][n][e] = s; }
                if (fr == 0) { float* kp = (float*)(ws + E_KMP) + (size_t)(unsigned)((((u.pm * 4 + wc) * 2 + wr) * 64 + 8 * fq));
#pragma unroll
                    for (int bj = 0; bj < 2; ++bj)
#pragma unroll
                        for (int n = 0; n < 2; ++n) *(f32x4*)(kp + 32 * bj + 4 * n) = ks[bj][n]; }
            }
        } else if (pn < 12) {
            unsigned char* dst = ws + E_QKVO + (size_t)((unsigned)(u.pm >> 4) * (24u << 20) + (16u << 20) + (unsigned)(((pn & 3) * 256 + wc * 64 + 8 * fq) * 2));
#pragma unroll
            for (int ai = 0; ai < 2; ++ai)
#pragma unroll
                for (int m = 0; m < 4; ++m) {
                    const unsigned row = row0 + ai * HALF + m * 16; const float rs = rsp[ai * HALF + m * 16];
#pragma unroll
                    for (int bj = 0; bj < 2; ++bj) { const f32x4 y0 = acc[ai][bj][m][0] * rs, y1 = acc[ai][bj][m][1] * rs;
                        *(u32x4*)(dst + (size_t)(row * 2048u + 64u * bj)) = PG8_PACK8(y0, y1); }
                }
        } else {
#pragma unroll
            for (int ai = 0; ai < 2; ++ai)
#pragma unroll
                for (int m = 0; m < 4; ++m) {
                    const unsigned row = row0 + ai * HALF + m * 16; const float rs = rsp[ai * HALF + m * 16];
#pragma unroll
                    for (int bj = 0; bj < 2; ++bj) {
                        const f32x4 y0 = acc[ai][bj][m][0] * rs, y1 = acc[ai][bj][m][1] * rs;
                        if (pn == 12 || bj == 0) {
                            const unsigned gcol = (unsigned)((pn == 12 ? 0 : 256) + 128 * bj + 32 * wc + 8 * fq);
                            f32x4 s0, s1;
#pragma unroll
                            for (int e = 0; e < 4; ++e) { s0[e] = __builtin_amdgcn_rcpf(1.0f + __builtin_amdgcn_exp2f(y0[e] * -1.4426950408889634f)); s1[e] = __builtin_amdgcn_rcpf(1.0f + __builtin_amdgcn_exp2f(y1[e] * -1.4426950408889634f)); }
                            *(u32x4*)(ws + E_GF + (size_t)((row * 384u + gcol) * 2u)) = PG8_PACK8(s0, s1);
                        } else if (wc == 0 && fq == 0) {
                            float z[6] = {y0[0], y0[1], y0[2], y0[3], y1[0], y1[1]};
#pragma unroll
                            for (int e = 0; e < 6; ++e) { const float zz = z[e] + bfg[e]; z[e] = fminf(zz, 0.f) - log1pf(__expf(-fabsf(zz))); }
                            float* lp = (float*)(ws + E_LS) + (size_t)row;
#pragma unroll
                            for (int e = 0; e < 6; ++e) lp[(size_t)(e * 32768u)] = z[e];
                        }
                    }
                }
        }
    }
};
struct EpiRes {
    static constexpr bool PERM = true, AFTER_DRAIN = false;
    float* out; unsigned char* ws; bool last;
    __device__ __forceinline__ void operator()(const f32x4 (&acc)[2][2][4][2], const Unit& u, int ui, int wr, int wc, int fr, int fq) const {
        const unsigned row0 = (unsigned)(u.pm * BM + wr * 64 + fr), col0 = (unsigned)(u.pn * BM + wc * 32 + 8 * fq);
        u32x4 xw[2][4][2];
#pragma unroll
        for (int ai = 0; ai < 2; ++ai)
#pragma unroll
            for (int m = 0; m < 4; ++m)
#pragma unroll
                for (int bj = 0; bj < 2; ++bj) { const unsigned off = (row0 + ai * HALF + m * 16) * 1024u + col0 + bj * HALF;
                    xw[ai][m][bj] = *(const PG8_GAS u32x4*)((PG8_GAS unsigned char*)ws + E_XB + (size_t)(off * 2u)); }
        float ssv[2][4];
#pragma unroll
        for (int ai = 0; ai < 2; ++ai) {
#pragma unroll
            for (int m = 0; m < 4; ++m) {
                const unsigned row = row0 + ai * HALF + m * 16; float ss = 0.f;
#pragma unroll
                for (int bj = 0; bj < 2; ++bj) {
                    const unsigned off = row * 1024u + col0 + bj * HALF;
                    const u32x4 x4 = xw[ai][m][bj];
                    f32x4 o0, o1;
                    o0[0] = __builtin_bit_cast(float, x4[0] << 16) + acc[ai][bj][m][0][0]; o0[1] = __builtin_bit_cast(float, x4[0] & 0xffff0000u) + acc[ai][bj][m][0][1];
                    o0[2] = __builtin_bit_cast(float, x4[1] << 16) + acc[ai][bj][m][0][2]; o0[3] = __builtin_bit_cast(float, x4[1] & 0xffff0000u) + acc[ai][bj][m][0][3];
                    o1[0] = __builtin_bit_cast(float, x4[2] << 16) + acc[ai][bj][m][1][0]; o1[1] = __builtin_bit_cast(float, x4[2] & 0xffff0000u) + acc[ai][bj][m][1][1];
                    o1[2] = __builtin_bit_cast(float, x4[3] << 16) + acc[ai][bj][m][1][2]; o1[3] = __builtin_bit_cast(float, x4[3] & 0xffff0000u) + acc[ai][bj][m][1][3];
                    if (last) { *(PG8_GAS f32x4*)((PG8_GAS float*)out + (size_t)off) = o0; *(PG8_GAS f32x4*)((PG8_GAS float*)out + (size_t)off + 4) = o1; }
                    else {
                        const f32x4 q4 = o0 * o0 + o1 * o1; ss += (q4[0] + q4[1]) + (q4[2] + q4[3]);
                        *(PG8_GAS u32x4*)((PG8_GAS unsigned char*)ws + E_XB + (size_t)(off * 2u)) = PG8_PACK8(o0, o1);
                    }
                }
                ssv[ai][m] = ss;
            }
        }
        if (!last) {
            float sw[2][4];
#pragma unroll
            for (int ai = 0; ai < 2; ++ai)
#pragma unroll
                for (int m = 0; m < 4; ++m) sw[ai][m] = __shfl_xor(ssv[ai][m], 16);
#pragma unroll
            for (int ai = 0; ai < 2; ++ai)
#pragma unroll
                for (int m = 0; m < 4; ++m) ssv[ai][m] += sw[ai][m];
#pragma unroll
            for (int ai = 0; ai < 2; ++ai)
#pragma unroll
                for (int m = 0; m < 4; ++m) sw[ai][m] = __shfl_xor(ssv[ai][m], 32);
            if (fq == 0) {
#pragma unroll
                for (int ai = 0; ai < 2; ++ai)
#pragma unroll
                    for (int m = 0; m < 4; ++m) ((PG8_GAS float*)((PG8_GAS unsigned char*)ws + E_SSQ))[(size_t)((row0 + ai * HALF + m * 16) * 16u + (unsigned)(u.pn * 4 + wc))] = ssv[ai][m] + sw[ai][m];
            }
        }
    }
};
struct EpiUp {
    static constexpr bool PERM = true, AFTER_DRAIN = false;
    unsigned char* ws; PG8_LAS float* tab; int probe_mode;
    __device__ __forceinline__ void operator()(const f32x4 (&acc)[2][2][4][2], const Unit& u, int ui, int wr, int wc, int fr, int fq) const {
#ifdef PROBE_EPI_UP
        if (probe_mode == 2) { asm volatile("" :: "v"(acc[0][0][0][0]), "v"(acc[1][1][3][1])); return; }
#endif
        const unsigned row0 = (unsigned)(u.pm * BM + wr * 64 + fr), colp = (unsigned)((u.pn & 3) * BM + wc * 32 + 8 * fq);
        const PG8_LAS float* rsp = tab + ui * 256 + wr * 64 + fr;
        float rsv[2][4];
#pragma unroll
        for (int ai = 0; ai < 2; ++ai)
#pragma unroll
            for (int m = 0; m < 4; ++m) rsv[ai][m] = rsp[ai * HALF + m * 16];
#pragma unroll
        for (int ai = 0; ai < 2; ++ai)
#pragma unroll
            for (int m = 0; m < 4; ++m) {
                const unsigned row = row0 + ai * HALF + m * 16; const float rs = rsv[ai][m];
#pragma unroll
                for (int bj = 0; bj < 2; ++bj) {
                    f32x4 y0 = acc[ai][bj][m][0] * rs, y1 = acc[ai][bj][m][1] * rs;
#pragma unroll
                    for (int e = 0; e < 4; ++e) { const float a = fmaxf(y0[e], 0.f), b = fmaxf(y1[e], 0.f); y0[e] = a * a; y1[e] = b * b; }
                    const u32x4 hw = PG8_PACK8(y0, y1);
#ifdef PROBE_EPI_UP
                    if (probe_mode == 1) { asm volatile("" :: "v"(hw)); } else
#endif
                    *(PG8_GAS u32x4*)((PG8_GAS unsigned char*)ws + E_QKVO + (size_t)((unsigned)(u.pm >> 4) * (24u << 20) + (unsigned)(u.pn >> 2) * (8u << 20) + row * 2048u + (colp + bj * HALF) * 2u)) = hw;
                }
            }
    }
};

template <class Epi, class Sched, bool ALIGN_EPI = false, bool SP2 = false>
__device__ __forceinline__ void gemm_phase(PG8_LAS unsigned char* lds, const Gemm g, const Sched& S, const Epi& E, const int tid) {
    const int wid = __builtin_amdgcn_readfirstlane(tid >> 6), lane = tid & 63, wr = wid >> 2, wc = wid & 3, fr = lane & 15, fq = lane >> 4;
    const int K = g.K, nt = K / BK;
    unsigned voffA[2], voffB[2];
#pragma unroll
    for (int i = 0; i < 2; ++i) { int R, C; stage_rc(tid * 16 + i * 8192, R, C); const int Rb = Epi::PERM ? ((R & ~31) + perm32(R & 31)) : R;
        voffA[i] = (unsigned)(R * g.lda + C) * 2u; voffB[i] = (unsigned)(Rb * K + C) * 2u; }
    const size_t kstep = (size_t)(BK * 2);
    const size_t hstep = (size_t)HALF * K * 2;
    const size_t tstep = 2 * hstep;
    const size_t hstepA = (size_t)HALF * g.lda * 2, tstepA = 2 * hstepA; const long padj = g.padj;
#define PG8_KOFFA(tt) ((size_t)(tt) * kstep + (size_t)((tt) >> 4) * (size_t)padj)
    const unsigned ldsw = (unsigned)wid * 1024u;
    const int aoff = lds_byte(wr * 64 + fr, fq * 8), boff = lds_byte(wc * 32 + fr, fq * 8);
#define PG8_SA(b, h) (((b) * 2 + (h)) * HTB)
#define PG8_SB(b, h) ((4 + (b) * 2 + (h)) * HTB)
#define PG8_STAGE(bufoff, gbase, voff) do { _Pragma("unroll") for (int _i = 0; _i < 2; ++_i) \
        __builtin_amdgcn_global_load_lds((const unsigned*)((const char*)(gbase) + (voff)[_i]), (PG8_LAS unsigned*)(lds + (bufoff) + ldsw + _i * 8192), 16, 0, 0); } while (0)
#define PG8_LDA(dst, b, h) do { _Pragma("unroll") for (int m = 0; m < 4; ++m) _Pragma("unroll") for (int k = 0; k < 2; ++k) dst[m][k] = *(const PG8_LAS bf16x8*)(lds + PG8_SA(b, h) + aoff + m * 2048 + k * 1024); } while (0)
#define PG8_LDB(dst, b, h) do { _Pragma("unroll") for (int n = 0; n < 2; ++n) _Pragma("unroll") for (int k = 0; k < 2; ++k) dst[n][k] = *(const PG8_LAS bf16x8*)(lds + PG8_SB(b, h) + boff + n * 2048 + k * 1024); } while (0)
#define PG8_MMA(ai, bj, At, Bt) do { __builtin_amdgcn_s_setprio(1); _Pragma("unroll") for (int m = 0; m < 4; ++m) _Pragma("unroll") for (int n = 0; n < 2; ++n) _Pragma("unroll") for (int k = 0; k < 2; ++k) \
        acc[ai][bj][m][n] = __builtin_amdgcn_mfma_f32_16x16x32_bf16(Bt[n][k], At[m][k], acc[ai][bj][m][n], 0, 0, 0); __builtin_amdgcn_s_setprio(0); } while (0)
#define PG8_WAIT_V(n) asm volatile("s_waitcnt vmcnt(" #n ")" ::: "memory")
#define PG8_WAIT_L(n) asm volatile("s_waitcnt lgkmcnt(" #n ")" ::: "memory")
#define PG8_BAR __builtin_amdgcn_s_barrier()
#define PG8_SCHED __builtin_amdgcn_sched_barrier(0)
    Unit cur, nxt; int ui = 0;
    if (!S.next(0, cur)) return;
    f32x4 acc[2][2][4][2];
#pragma unroll
    for (int a = 0; a < 2; ++a)
#pragma unroll
        for (int b = 0; b < 2; ++b)
#pragma unroll
            for (int m = 0; m < 4; ++m)
#pragma unroll
                for (int n = 0; n < 2; ++n) acc[a][b][m][n] = (f32x4){0.f, 0.f, 0.f, 0.f};
    bf16x8 At[4][2], B0[2][2], B1[2][2];
    const char* cA = (const char*)g.A + (size_t)cur.pm * tstepA; const char* cB = (const char*)g.Bt + (size_t)cur.pn * tstep;
    S.a_ready(cur);
    if constexpr (SP2) {
        PG8_STAGE(PG8_SB(0, 0), cB, voffB); PG8_STAGE(PG8_SB(0, 1), cB + hstep, voffB); PG8_STAGE(PG8_SA(0, 0), cA, voffA); PG8_STAGE(PG8_SA(0, 1), cA + hstepA, voffA);
        if (wr == 1) PG8_BAR;
        PG8_WAIT_V(2); PG8_BAR;
        PG8_STAGE(PG8_SB(1, 0), cB + kstep, voffB); PG8_STAGE(PG8_SA(1, 0), cA + kstep, voffA); PG8_STAGE(PG8_SB(1, 1), cB + hstep + kstep, voffB);
        PG8_WAIT_V(6); PG8_BAR;
    } else {
        PG8_STAGE(PG8_SB(0, 0), cB, voffB); PG8_STAGE(PG8_SA(0, 0), cA, voffA); PG8_STAGE(PG8_SB(0, 1), cB + hstep, voffB); PG8_STAGE(PG8_SA(0, 1), cA + hstepA, voffA);
        if (wr == 1) PG8_BAR;
        PG8_WAIT_V(4); PG8_BAR;
        PG8_STAGE(PG8_SB(1, 0), cB + kstep, voffB); PG8_STAGE(PG8_SA(1, 0), cA + kstep, voffA); PG8_STAGE(PG8_SB(1, 1), cB + hstep + kstep, voffB);
        PG8_WAIT_V(6); PG8_BAR;
    }
    for (;;) {
        const bool has_next = S.next(ui + 1, nxt);
        const char* nA = has_next ? (const char*)g.A + (size_t)nxt.pm * tstepA : cA; const char* nB = has_next ? (const char*)g.Bt + (size_t)nxt.pn * tstep : cB;
        for (int t = 0; t < nt; t += 2) {
            const bool last = (t == nt - 2);
            const char* a1 = cA + PG8_KOFFA(t + 1);
            const char* a2 = last ? nA : cA + PG8_KOFFA(t + 2); const char* b2 = last ? nB : cB + (size_t)(t + 2) * kstep;
            const char* a3 = a2 + kstep; const char* b3 = b2 + kstep;
            if (last && has_next) S.a_ready(nxt);
            if constexpr (SP2) {
            PG8_LDB(B0, 0, 0); PG8_LDB(B1, 0, 1); PG8_SCHED; PG8_LDA(At, 0, 0); PG8_STAGE(PG8_SA(1, 1), a1 + hstepA, voffA);
            PG8_WAIT_V(8); PG8_WAIT_L(0); PG8_BAR; PG8_MMA(0, 0, At, B0); PG8_MMA(0, 1, At, B1); PG8_BAR; PG8_SCHED;
            PG8_LDA(At, 0, 1); PG8_STAGE(PG8_SB(0, 0), b2, voffB); PG8_STAGE(PG8_SB(0, 1), b2 + hstep, voffB); PG8_STAGE(PG8_SA(0, 0), a2, voffA);
            PG8_WAIT_V(8); PG8_WAIT_L(0); PG8_BAR; PG8_MMA(1, 0, At, B0); PG8_MMA(1, 1, At, B1); PG8_BAR; PG8_SCHED;
            PG8_LDB(B0, 1, 0); PG8_LDB(B1, 1, 1); PG8_SCHED; PG8_LDA(At, 1, 0); PG8_STAGE(PG8_SA(0, 1), a2 + hstepA, voffA);
            PG8_WAIT_V(8); PG8_WAIT_L(0); PG8_BAR; PG8_MMA(0, 0, At, B0); PG8_MMA(0, 1, At, B1); PG8_BAR; PG8_SCHED;
            PG8_LDA(At, 1, 1); PG8_STAGE(PG8_SB(1, 0), b3, voffB); PG8_STAGE(PG8_SB(1, 1), b3 + hstep, voffB); PG8_STAGE(PG8_SA(1, 0), a3, voffA);
            PG8_WAIT_V(8); PG8_WAIT_L(0); PG8_BAR; PG8_MMA(1, 0, At, B0); PG8_MMA(1, 1, At, B1); PG8_BAR; PG8_SCHED;
            } else {
            PG8_LDB(B0, 0, 0); PG8_SCHED; PG8_LDA(At, 0, 0); PG8_STAGE(PG8_SA(1, 1), a1 + hstepA, voffA);
            PG8_WAIT_L(8); PG8_BAR; PG8_WAIT_L(0); PG8_MMA(0, 0, At, B0); PG8_BAR; PG8_SCHED;
            PG8_LDB(B1, 0, 1); PG8_STAGE(PG8_SB(0, 0), b2, voffB);
            PG8_BAR; PG8_WAIT_L(0); PG8_MMA(0, 1, At, B1); PG8_BAR;
            PG8_LDA(At, 0, 1); PG8_STAGE(PG8_SA(0, 0), a2, voffA);
            PG8_BAR; PG8_WAIT_L(0); PG8_MMA(1, 0, At, B0); PG8_BAR; PG8_SCHED;
            PG8_STAGE(PG8_SB(0, 1), b2 + hstep, voffB);
            PG8_WAIT_V(6); PG8_BAR; PG8_MMA(1, 1, At, B1); PG8_BAR;
            PG8_LDB(B0, 1, 0); PG8_SCHED; PG8_LDA(At, 1, 0); PG8_STAGE(PG8_SA(0, 1), a2 + hstepA, voffA);
            PG8_WAIT_L(8); PG8_BAR; PG8_WAIT_L(0); PG8_MMA(0, 0, At, B0); PG8_BAR; PG8_SCHED;
            PG8_LDB(B1, 1, 1); PG8_STAGE(PG8_SB(1, 0), b3, voffB);
            PG8_BAR; PG8_WAIT_L(0); PG8_MMA(0, 1, At, B1); PG8_BAR;
            PG8_LDA(At, 1, 1); PG8_STAGE(PG8_SA(1, 0), a3, voffA);
            PG8_BAR; PG8_WAIT_L(0); PG8_MMA(1, 0, At, B0); PG8_BAR; PG8_SCHED;
            PG8_STAGE(PG8_SB(1, 1), b3 + hstep, voffB);
            PG8_WAIT_V(6); PG8_BAR; PG8_MMA(1, 1, At, B1); PG8_BAR;
            }
        }
        if constexpr (ALIGN_EPI) { if (wr == 0) PG8_BAR; }
        if constexpr (!Epi::AFTER_DRAIN) { E(acc, cur, ui, wr, wc, fr, fq); S.done(cur); }
        if (!has_next) break;
#pragma unroll
        for (int a = 0; a < 2; ++a)
#pragma unroll
            for (int b = 0; b < 2; ++b)
#pragma unroll
                for (int m = 0; m < 4; ++m)
#pragma unroll
                    for (int n = 0; n < 2; ++n) acc[a][b][m][n] = (f32x4){0.f, 0.f, 0.f, 0.f};
        cur = nxt; cA = nA; cB = nB; ++ui;
        if constexpr (ALIGN_EPI) { if (wr == 1) PG8_BAR; }
    }
    PG8_WAIT_V(0);
    if constexpr (!ALIGN_EPI) { if (wr == 0) PG8_BAR; }
    PG8_BAR;
    if constexpr (Epi::AFTER_DRAIN) { E.fused(acc, cur, wr, wc, fr, fq, lds, wid, lane); S.done(cur); }
#undef PG8_SA
#undef PG8_KOFFA
#undef PG8_SB
#undef PG8_STAGE
#undef PG8_LDA
#undef PG8_LDB
#undef PG8_MMA
#undef PG8_WAIT_V
#undef PG8_WAIT_L
#undef PG8_BAR
#undef PG8_SCHED
}
}

constexpr int NWAVES = 8;
constexpr int BATCH = 8, SEQ = 4096, DM = 1024, NHEAD = 16, FF = 4096, DEPTH = 2;
constexpr int M = BATCH * SEQ;
constexpr int NIN = 3462, NINP = 3584;
constexpr float EPS = 1e-6f, LOG2E = 1.4426950408889634f;
#ifndef MK_ONE_LAUNCH
#define MK_ONE_LAUNCH 1
#endif
constexpr int NPH = 1 + 6 * DEPTH;

constexpr size_t MiB = 1u << 20;
constexpr size_t WS_CTL = 0, CTL_ZERO_BYTES = 1 * MiB;
constexpr size_t WS_W = 2 * MiB, W_LAYER = 25 * MiB, W_IN = 0, W_OUT = 7 * MiB, W_UP = 9 * MiB, W_DOWN = 17 * MiB;
constexpr size_t WS_SSQ = 52 * MiB;
constexpr size_t WS_LS = 54 * MiB;
constexpr size_t WS_KMP = 55 * MiB;
constexpr size_t WS_XB = 64 * MiB;
constexpr size_t WS_QKVO = 128 * MiB;
constexpr size_t QKVO_BATCH_ADJ = 24 * MiB;
constexpr size_t QKVO_K = 8 * MiB, QKVO_V = 16 * MiB, QKVO_O = 24 * MiB;
constexpr size_t WS_H = 128 * MiB;
constexpr size_t WS_GF = 384 * MiB;
constexpr size_t WS_LD = 56 * MiB;
constexpr size_t WS_OD = 408 * MiB;
constexpr size_t WS_END = 480 * MiB;
constexpr int CW_BAR = 4096, CW_GBAR = 8192, CW_XCC = 12288, CW_QBAR = 16384;

constexpr int RING_OFF = 0, RING_BYTES = 131072;
constexpr int LDSCTL_OFF = RING_BYTES, MISC_OFF = LDSCTL_OFF + 320;
constexpr int LDS_BYTES = 147456;

#define GAS __attribute__((address_space(1)))
#define LAS __attribute__((address_space(3)))
typedef unsigned short bf16;
typedef unsigned v4u __attribute__((ext_vector_type(4)));
typedef float f32x4 __attribute__((ext_vector_type(4)));
typedef GAS unsigned gu32;
#define RLX_AGENT __ATOMIC_RELAXED, __HIP_MEMORY_SCOPE_AGENT
#define LDS_WAIT() asm volatile("s_waitcnt lgkmcnt(0)" ::: "memory")
#define VM_WAIT() asm volatile("s_waitcnt vmcnt(0)" ::: "memory")
__device__ __forceinline__ unsigned f2bf(float f) { unsigned u = __builtin_bit_cast(unsigned, f); return (u + 0x7fffu + ((u >> 16) & 1u)) >> 16; }
__device__ __forceinline__ unsigned pk2(float lo, float hi) { return f2bf(lo) | (f2bf(hi) << 16); }
__device__ __forceinline__ float bflo(unsigned w) { return __builtin_bit_cast(float, w << 16); }
__device__ __forceinline__ float bfhi(unsigned w) { return __builtin_bit_cast(float, w & 0xffff0000u); }
#define XB_TMO      128
#define XB_XCNT(j)  (256  + 64 * (j))
#define XB_XSUB(j)  (1280 + 64 * (j))
#define XB_XGEN(j)  (2304 + 64 * (j))
#define XB_TOP      3328
#define XB_TOPGEN   3392
#define XCD_BAR_WORDS 3456
#define XB_SPIN_CAP (1u << 18)

__device__ __forceinline__ unsigned xb_ld(unsigned* p)              { return __hip_atomic_load(p, __ATOMIC_RELAXED, __HIP_MEMORY_SCOPE_AGENT); }
__device__ __forceinline__ unsigned xb_add(unsigned* p, unsigned v) { return __hip_atomic_fetch_add(p, v, __ATOMIC_RELAXED, __HIP_MEMORY_SCOPE_AGENT); }
__device__ __forceinline__ unsigned xb_xcc_id() { return (unsigned)__builtin_amdgcn_s_getreg((3 << 11) | 20) & 0xFu; }
#define XB_SPIN(cond, bar) do { unsigned _sp = 0; while (cond) { __builtin_amdgcn_s_sleep(1); \
    if ((++_sp & 255u) == 0u) { if (xb_ld(&(bar)[XB_TMO])) break; if (_sp > XB_SPIN_CAP) { atomicAdd(&(bar)[XB_TMO], 1u); break; } } } } while (0)

struct XcdBarrier {
    unsigned* bar; unsigned x;
    volatile LAS unsigned* st;
};

__device__ __forceinline__ XcdBarrier xcd_barrier_post(unsigned* bar, volatile LAS unsigned* st) {
    XcdBarrier b; b.bar = bar; b.x = xb_xcc_id(); b.st = st;
    if (threadIdx.x == 0) (void)xb_add(&bar[XB_XCNT(b.x)], 1u);
    return b;
}
__device__ __forceinline__ void xcd_barrier_complete(unsigned* bar, unsigned x, unsigned& nloc, unsigned& nx) {
    const unsigned G = gridDim.x * gridDim.y * gridDim.z;
    unsigned sum, cnt, mine, sp = 0u;
    for (;;) {
        sum = 0u; cnt = 0u; mine = 0u;
#pragma unroll
        for (unsigned j = 0; j < 16; ++j) { const unsigned c = xb_ld(&bar[XB_XCNT(j)]); sum += c; cnt += (c > 0u) ? 1u : 0u; mine = (j == x) ? c : mine; }
        if (sum == G) break;
        __builtin_amdgcn_s_sleep(1);
        if ((++sp & 255u) == 0u) { if (xb_ld(&bar[XB_TMO])) break; if (sp > XB_SPIN_CAP) { atomicAdd(&bar[XB_TMO], 1u); break; } }
    }
    nloc = mine > 0u ? mine : 1u; nx = cnt > 0u ? cnt : 1u;
}

__device__ __forceinline__ void xcd_barrier(const XcdBarrier& b, const int tid_x) {
    asm volatile("s_waitcnt vmcnt(0)" ::: "memory");
    __syncthreads();
    if (tid_x == 0) {
        unsigned* bar = b.bar;
        __builtin_amdgcn_s_waitcnt(0);
        unsigned nloc = b.st[0], nx = b.st[1];
        if (nloc == 0u) { xcd_barrier_complete(bar, b.x, nloc, nx); b.st[0] = nloc; b.st[1] = nx; }
        const unsigned old = xb_add(&bar[XB_XSUB(b.x)], 1u);
        const unsigned gen = old / nloc;
        if (old + 1u == (gen + 1u) * nloc) {
            __builtin_amdgcn_fence(__ATOMIC_RELEASE, "agent");
            asm volatile("s_waitcnt vmcnt(0)" ::: "memory");
            const unsigned og = xb_add(&bar[XB_TOP], 1u);
            const unsigned tg = og / nx;
            if (og + 1u == (tg + 1u) * nx) xb_add(&bar[XB_TOPGEN], 1u);
            else XB_SPIN(xb_ld(&bar[XB_TOPGEN]) == tg, bar);
            __builtin_amdgcn_fence(__ATOMIC_ACQUIRE, "agent");
            xb_add(&bar[XB_XGEN(b.x)], 1u);
            asm volatile("s_waitcnt vmcnt(0)" ::: "memory");
        } else {
            XB_SPIN(xb_ld(&bar[XB_XGEN(b.x)]) == gen, bar);
            __builtin_amdgcn_fence(__ATOMIC_ACQUIRE, "agent");
            asm volatile("s_waitcnt vmcnt(0)" ::: "memory");
        }
    }
    __syncthreads();
}

namespace att {
typedef unsigned short bf16;
using bf16x8 = __attribute__((ext_vector_type(8))) short;
using s16x4 = __attribute__((ext_vector_type(4))) short;
using f32x16 = __attribute__((ext_vector_type(16))) float;
using f32x4 = __attribute__((ext_vector_type(4))) float;
using u32x4 = __attribute__((ext_vector_type(4))) unsigned;
typedef __attribute__((address_space(3))) const char* lds_cptr;
typedef __attribute__((address_space(3))) float* lds_fptr;
typedef short v4i16_t __attribute__((ext_vector_type(4)));
constexpr int SLOTB = 8192, LDS_K = 0, LDS_V = 3 * SLOTB, LDS_WS = 6 * SLOTB, LDS_OST = LDS_WS + 8 * 256, LDS_X = LDS_OST + 8 * 4096, LDS_X2 = LDS_X + 16384, LDS_END = LDS_X2 + 1024;
constexpr int DMP = 1024;
#define ATT_WAIT_BAR(N) asm volatile("s_waitcnt vmcnt(" #N ") lgkmcnt(0)\n\ts_barrier" ::: "memory")
#define ATT_WAIT_BAR_L() asm volatile("s_waitcnt lgkmcnt(0)\n\ts_barrier" ::: "memory")
__device__ __forceinline__ void glds16(const void* gsrc, unsigned lds_dst) { unsigned keep;
    asm volatile("s_mov_b32 %0, m0\n\ts_mov_b32 m0, %2\n\ts_nop 0\n\tglobal_load_lds_dwordx4 %1, off\n\ts_mov_b32 m0, %0" : "=&s"(keep) : "v"(gsrc), "s"(lds_dst) : "memory"); }
typedef float f32x2_t __attribute__((ext_vector_type(2))); typedef __bf16 bf16x2_t __attribute__((ext_vector_type(2)));
__device__ __forceinline__ unsigned cvtpk(float lo, float hi) { f32x2_t v = {lo, hi}; bf16x2_t b = __builtin_convertvector(v, bf16x2_t); return __builtin_bit_cast(unsigned, b); }
__device__ __forceinline__ s16x4 vtr(lds_cptr p) { return __builtin_bit_cast(s16x4, __builtin_amdgcn_ds_read_tr16_b64_v4i16((__attribute__((address_space(3))) v4i16_t*)p)); }
__device__ __forceinline__ int crow(int r, int hi) { return (r & 3) + 8 * (r >> 2) + 4 * hi; }
#define ATT_NEG (-INFINITY)
#define ATT_SBAR() __builtin_amdgcn_sched_barrier(0)

struct UnitIO {
    const bf16* Q; long qstride;
    const bf16* K0; const bf16* V0; long kstride;
    bf16* O; long ostride;
    float* L; long lstride;
    bool norm;
};
struct BiasMoba {
    float slope2, tqf; int qrel, hi, w, nb0, u; unsigned selmask;
    __device__ __forceinline__ bool active(int t) const { return t < nb0 || (t - nb0) <= (w >> 1); }
    __device__ __forceinline__ void init(f32x16& c0, f32x16& c1, int t) const {
        float base = slope2 * ((float)(64 * t + 4 * hi) - tqf);
        if (t < nb0) { if (!((selmask >> (t >> 2)) & 1u)) base = ATT_NEG; }
        const float d32 = 32.0f * slope2;
#pragma unroll
        for (int i = 0; i < 8; ++i) { const int r = 2 * i; const f32x2_t kc = (f32x2_t){slope2 * (float)((r & 3) + 8 * (r >> 2)), slope2 * (float)(((r + 1) & 3) + 8 * ((r + 1) >> 2))};
            const f32x2_t p = kc + base, q = p + d32; c0[r] = p[0]; c0[r + 1] = p[1]; c1[r] = q[0]; c1[r + 1] = q[1]; }
        if (t - nb0 == (w >> 1)) {
#pragma unroll
            for (int r = 0; r < 16; ++r) { const int ko = (r & 3) + 8 * (r >> 2); if (ko > u) c0[r] = ATT_NEG; if (ko > u - 32) c1[r] = ATT_NEG; }
        }
    }
};
struct BiasFox {
    lds_fptr cs2; float base; int qrel, hi, w, nb0, u;
    __device__ __forceinline__ bool active(int t) const { return t < nb0 || (t - nb0) <= (w >> 1); }
    __device__ __forceinline__ void init(f32x16& c0, f32x16& c1, int t) const {
        const lds_fptr p = cs2 + 64 * t + 4 * hi;
        f32x4 a[4], b[4];
#pragma unroll
        for (int g = 0; g < 4; ++g) { a[g] = *(const __attribute__((address_space(3))) f32x4*)(p + 8 * g); b[g] = *(const __attribute__((address_space(3))) f32x4*)(p + 32 + 8 * g); }
        asm volatile("" : "+v"(a[0]), "+v"(a[1]), "+v"(a[2]), "+v"(a[3]), "+v"(b[0]), "+v"(b[1]), "+v"(b[2]), "+v"(b[3]));
#pragma unroll
        for (int g = 0; g < 4; ++g) { const f32x2_t a0 = (f32x2_t){a[g][0], a[g][1]}, a1 = (f32x2_t){a[g][2], a[g][3]}, b0 = (f32x2_t){b[g][0], b[g][1]}, b1 = (f32x2_t){b[g][2], b[g][3]};
            const f32x2_t x0 = base - a0, x1 = base - a1, y0 = base - b0, y1 = base - b1;
            c0[4 * g] = x0[0]; c0[4 * g + 1] = x0[1]; c0[4 * g + 2] = x1[0]; c0[4 * g + 3] = x1[1]; c1[4 * g] = y0[0]; c1[4 * g + 1] = y0[1]; c1[4 * g + 2] = y1[0]; c1[4 * g + 3] = y1[1]; }
        if (t - nb0 == (w >> 1)) {
#pragma unroll
            for (int r = 0; r < 16; ++r) { const int ko = (r & 3) + 8 * (r >> 2); if (ko > u) c0[r] = ATT_NEG; if (ko > u - 32) c1[r] = ATT_NEG; }
        }
    }
};
struct BiasDil {
    float sd; int qrel, hi, w; f32x2_t kc[8]; float basel, d32, d64; int u;
    __device__ __forceinline__ void setup(int r32) { u = 32 * (w & 1) + r32 - 4 * hi; basel = -sd * (float)(128 + u); d32 = 32.0f * sd; d64 = 64.0f * sd;
#pragma unroll
        for (int i = 0; i < 8; ++i) { const int r = 2 * i; kc[i] = (f32x2_t){sd * (float)((r & 3) + 8 * (r >> 2)), sd * (float)(((r + 1) & 3) + 8 * ((r + 1) >> 2))}; } }
    __device__ __forceinline__ bool active(int t) const { return t >= (w >> 1) && t <= (w >> 1) + 2; }
    __device__ __forceinline__ void init(f32x16& c0, f32x16& c1, int t) const {
        const int dt = t - (w >> 1);
        const float base = basel + (float)dt * d64;
#pragma unroll
        for (int i = 0; i < 8; ++i) { const f32x2_t p = kc[i] + base, q = p + d32; c0[2 * i] = p[0]; c0[2 * i + 1] = p[1]; c1[2 * i] = q[0]; c1[2 * i + 1] = q[1]; }
        if (dt == 0) {
#pragma unroll
            for (int r = 0; r < 16; ++r) { const int ko = (r & 3) + 8 * (r >> 2); if (ko < u) c0[r] = ATT_NEG; if (ko < u - 32) c1[r] = ATT_NEG; }
        } else if (dt == 2) {
#pragma unroll
            for (int r = 0; r < 16; ++r) { const int ko = (r & 3) + 8 * (r >> 2); if (ko > u) c0[r] = ATT_NEG; if (ko > u - 32) c1[r] = ATT_NEG; }
        }
    }
};

template <class BIAS>
__device__ __forceinline__ void attn_tiles(char* shm, const UnitIO& io, int t_begin, int t_end, const BIAS& B, int tid) {
    const int lane = tid & 63, r32 = lane & 31, hi = lane >> 5; const int wid = __builtin_amdgcn_readfirstlane(tid >> 6);
    const unsigned lds0 = (unsigned)(uintptr_t)shm;
    const bf16* ksrc = io.K0 + (long)lane * io.kstride + wid * 8;
    const bf16* vsrc = io.V0 + (long)(16 * (wid & 3) + (lane >> 2)) * io.kstride + (wid >> 2) * 32 + (lane & 3) * 8;
    const unsigned kdst = lds0 + LDS_K + wid * 1024, vdst = lds0 + LDS_V + wid * 1024;
    const long tstep = 64 * io.kstride;
#define ATT_DMA(t, slot) do { glds16(ksrc + (long)(t) * tstep, (unsigned)__builtin_amdgcn_readfirstlane(kdst + (slot))); glds16(vsrc + (long)(t) * tstep, (unsigned)__builtin_amdgcn_readfirstlane(vdst + (slot))); } while (0)
    const lds_cptr shm3 = (lds_cptr)shm;
    const lds_cptr kp0 = shm3 + LDS_K + hi * 1024 + r32 * 16;
    const lds_cptr vp0 = shm3 + LDS_V + ((lane >> 4) & 1) * 32 + (lane & 3) * 8 + (4 * hi + ((lane & 15) >> 2)) * 64;
    float* wsf = (float*)(shm + LDS_WS) + wid * 64;
    bf16x8 qr[4];
    { const bf16* qp = io.Q + (long)r32 * io.qstride + hi * 8;
#pragma unroll
      for (int d0 = 0; d0 < 4; ++d0) qr[d0] = *reinterpret_cast<const bf16x8*>(qp + d0 * 16); }
    ATT_DMA(t_begin, 0);
    asm volatile("" :: "v"(qr[0]), "v"(qr[1]), "v"(qr[2]), "v"(qr[3]));
    const bool two = (t_begin + 1 < t_end); if (two) ATT_DMA(t_begin + 1, SLOTB);
    f32x16 o[2]; o[0] = f32x16{}; o[1] = f32x16{}; float l_reg = 0.f;
    if (two) ATT_WAIT_BAR(2); else ATT_WAIT_BAR(0);
    if (wid >= 4) __builtin_amdgcn_s_setprio(1);
    int sl_c = 0, sl_n = SLOTB, sl_nn = 2 * SLOTB;
#pragma unroll 1
    for (int t = t_begin; t < t_end; ++t) {
        const bool more = (t + 2 < t_end);
        const bool act = B.active(t);
        if (more) ATT_DMA(t + 2, sl_nn);
        u32x4 pw[4]; f32x16 c1x;
        if (act) {
            bf16x8 kf[8]; const lds_cptr kp = kp0 + sl_c;
#pragma unroll
            for (int j = 0; j < 4; ++j) { kf[2 * j] = *(const __attribute__((address_space(3))) bf16x8*)(kp + j * 2048); kf[2 * j + 1] = *(const __attribute__((address_space(3))) bf16x8*)(kp + j * 2048 + 512); }
            ATT_SBAR();
            f32x16 c0, c1; B.init(c0, c1, t);
            ATT_SBAR();
            asm volatile("" : "+v"(kf[0]), "+v"(kf[1]), "+v"(kf[2]), "+v"(kf[3]), "+v"(kf[4]), "+v"(kf[5]), "+v"(kf[6]), "+v"(kf[7]));
#pragma unroll
            for (int d0 = 0; d0 < 4; ++d0) { c0 = __builtin_amdgcn_mfma_f32_32x32x16_bf16(kf[2 * d0], qr[d0], c0, 0, 0, 0); c1 = __builtin_amdgcn_mfma_f32_32x32x16_bf16(kf[2 * d0 + 1], qr[d0], c1, 0, 0, 0); }
            float s0 = 0.f;
#pragma unroll
            for (int r = 0; r < 16; ++r) c0[r] = __builtin_amdgcn_exp2f(c0[r]);
            { f32x2_t s2 = (f32x2_t){c0[0], c0[1]};
#pragma unroll
              for (int i = 1; i < 8; ++i) s2 += (f32x2_t){c0[2 * i], c0[2 * i + 1]};
              s0 = s2[0] + s2[1]; }
            l_reg += s0;
#pragma unroll
            for (int i = 0; i < 4; ++i) { pw[0][i] = cvtpk(c0[2 * i], c0[2 * i + 1]); pw[1][i] = cvtpk(c0[8 + 2 * i], c0[9 + 2 * i]); }
            c1x = c1;
        }

        if (act) {
            const lds_cptr vp = vp0 + sl_c;
            s16x4 vlo[8], vhi[8];
#pragma unroll
            for (int i = 0; i < 8; ++i) { vlo[i] = vtr(vp + (i >> 2) * 4096 + (i & 3) * 1024); vhi[i] = vtr(vp + (i >> 2) * 4096 + (i & 3) * 1024 + 512); }
            ATT_SBAR();
            { float s1 = 0.f;
#pragma unroll
              for (int r = 0; r < 16; ++r) c1x[r] = __builtin_amdgcn_exp2f(c1x[r]);
              { f32x2_t s2 = (f32x2_t){c1x[0], c1x[1]};
#pragma unroll
                for (int i = 1; i < 8; ++i) s2 += (f32x2_t){c1x[2 * i], c1x[2 * i + 1]};
                s1 = s2[0] + s2[1]; }
              l_reg += s1;
#pragma unroll
              for (int i = 0; i < 4; ++i) { pw[2][i] = cvtpk(c1x[2 * i], c1x[2 * i + 1]); pw[3][i] = cvtpk(c1x[8 + 2 * i], c1x[9 + 2 * i]); } }
            ATT_SBAR();
            asm volatile("" : "+v"(vlo[0]), "+v"(vhi[0]), "+v"(vlo[1]), "+v"(vhi[1]), "+v"(vlo[2]), "+v"(vhi[2]), "+v"(vlo[3]), "+v"(vhi[3]));
#pragma unroll
            for (int ks = 0; ks < 4; ++ks) { const bf16x8 vf = (bf16x8){vlo[ks][0], vlo[ks][1], vlo[ks][2], vlo[ks][3], vhi[ks][0], vhi[ks][1], vhi[ks][2], vhi[ks][3]};
                o[0] = __builtin_amdgcn_mfma_f32_32x32x16_bf16(__builtin_bit_cast(bf16x8, pw[ks]), vf, o[0], 0, 0, 0); }
            ATT_SBAR();
            asm volatile("" : "+v"(vlo[4]), "+v"(vhi[4]), "+v"(vlo[5]), "+v"(vhi[5]), "+v"(vlo[6]), "+v"(vhi[6]), "+v"(vlo[7]), "+v"(vhi[7]));
#pragma unroll
            for (int ks = 0; ks < 4; ++ks) { const bf16x8 vf = (bf16x8){vlo[4 + ks][0], vlo[4 + ks][1], vlo[4 + ks][2], vlo[4 + ks][3], vhi[4 + ks][0], vhi[4 + ks][1], vhi[4 + ks][2], vhi[4 + ks][3]};
                o[1] = __builtin_amdgcn_mfma_f32_32x32x16_bf16(__builtin_bit_cast(bf16x8, pw[ks]), vf, o[1], 0, 0, 0); }
        }
        if (more) ATT_WAIT_BAR(2); else ATT_WAIT_BAR(0);
        const int tmp = sl_c; sl_c = sl_n; sl_n = sl_nn; sl_nn = tmp;
    }
    if (wid >= 4) __builtin_amdgcn_s_setprio(0);
#undef ATT_DMA
    { auto rr = __builtin_amdgcn_permlane32_swap(__float_as_uint(l_reg), __float_as_uint(l_reg), false, false); l_reg = __uint_as_float(rr[0]) + __uint_as_float(rr[1]); }
    if (hi == 0) wsf[32 + r32] = l_reg;
    asm volatile("s_waitcnt lgkmcnt(0)" ::: "memory");
    float rli[16];
#pragma unroll
    for (int r = 0; r < 16; ++r) rli[r] = io.norm ? __builtin_amdgcn_rcpf(wsf[32 + crow(r, hi)]) : 1.0f;
    if (!io.norm && hi == 0) io.L[(long)r32 * io.lstride] = l_reg;
    { bf16* stg = (bf16*)(shm + LDS_OST) + wid * 2048;
#pragma unroll
      for (int r = 0; r < 16; ++r) { const int orow = crow(r, hi);
#pragma unroll
          for (int d0 = 0; d0 < 2; ++d0) stg[orow * 64 + d0 * 32 + r32] = (bf16)(cvtpk(o[d0][r] * rli[r], 0.f) & 0xffffu); }
      asm volatile("s_waitcnt lgkmcnt(0)" ::: "memory");
#pragma unroll
      for (int i = 0; i < 4; ++i) { const int row = i * 8 + (lane >> 3), ch = lane & 7; const u32x4 v = *(const u32x4*)(stg + row * 64 + ch * 8); *(u32x4*)(io.O + (long)row * io.ostride + ch * 8) = v; } }
    asm volatile("s_waitcnt lgkmcnt(0)" ::: "memory");
}
}


struct Frame {
    LAS unsigned char* lds;
    volatile LAS unsigned* MISC;
    gu32* ctl;
    int tid, lane, wave;
    int vcu, G;
};
struct Ptrs {
    const float *x, *attn_norm, *w_in, *b_forget, *q_gain, *k_gain, *out_gain, *w_out, *mlp_norm, *w_up, *w_down;
    float* out; unsigned char* ws;
};

__device__ __forceinline__ float wave_sum(float v) {
#pragma unroll
    for (int o = 1; o < 64; o <<= 1) v += __shfl_xor(v, o);
    return v;
}

__device__ __forceinline__ int win_src(int cp) {
    const int tile = cp >> 8, within = cp & 255;
    if (tile < 12) { const int bj = within >> 7, wc = (within >> 5) & 3, j = within & 31; return tile * 256 + 64 * wc + 32 * bj + j; }
    if (tile == 12) return 3078 + within;
    if (within < 128) return 3078 + 256 + within;
    if (within < 134) return 3072 + (within - 128);
    return -1;
}
template <int MODE>
__device__ __forceinline__ void transpose_item(const float* W, int K, int N, const float* gain, bf16* WT, LAS float* scr, int item, int nblk, int lane) {
    const int kb = item / nblk, nb = item % nblk, k0 = 64 * kb, n0 = 32 * nb;
    const int sc = (MODE == 0) ? win_src(n0 + (lane & 31)) : (n0 + (lane & 31));
    const GAS float* src = (const GAS float*)W + (size_t)(k0 + (lane >> 5)) * N + (sc >= 0 ? sc : 0);
    const float keep = sc >= 0 ? 1.f : 0.f;
    float v[32];
#pragma unroll
    for (int i = 0; i < 32; ++i) v[i] = src[(size_t)(2 * i) * N];
    const int c = lane & 7;
    f32x4 g0 = (f32x4){1.f, 1.f, 1.f, 1.f}, g1 = g0;
    if (gain) { g0 = *(const GAS f32x4*)(gain + k0 + 8 * c); g1 = *(const GAS f32x4*)(gain + k0 + 8 * c + 4); }
#pragma unroll
    for (int i = 0; i < 32; ++i) scr[(2 * i + (lane >> 5)) * 33 + (lane & 31)] = v[i] * keep;
    LDS_WAIT(); asm volatile("" ::: "memory");
#pragma unroll
    for (int j = 0; j < 4; ++j) { const int n = (lane >> 3) + 8 * j; const LAS float* s = scr + (8 * c) * 33 + n;
        v4u o; o.x = pk2(s[0 * 33] * g0[0], s[1 * 33] * g0[1]); o.y = pk2(s[2 * 33] * g0[2], s[3 * 33] * g0[3]); o.z = pk2(s[4 * 33] * g1[0], s[5 * 33] * g1[1]); o.w = pk2(s[6 * 33] * g1[2], s[7 * 33] * g1[3]);
        *(GAS v4u*)(WT + (size_t)(n0 + n) * K + k0 + 8 * c) = o; }
    LDS_WAIT(); asm volatile("" ::: "memory");
}
__device__ __forceinline__ void p0_prologue(Frame& F, const Ptrs& P) {
    LAS float* scr = (LAS float*)(F.lds + RING_OFF + F.wave * 16384);
    const int gw = F.vcu * NWAVES + F.wave, NGW = F.G * NWAVES;
    constexpr int I_IN = (DM / 64) * (NINP / 32), I_OUT = (DM / 64) * (DM / 32), I_UP = (DM / 64) * (FF / 32), I_DN = (FF / 64) * (DM / 32);
    constexpr int I_LAYER = I_IN + I_OUT + I_UP + I_DN;
    for (int it = gw; it < DEPTH * I_LAYER; it += NGW) {
        const int l = it / I_LAYER; int r = it % I_LAYER;
        unsigned char* wl = P.ws + WS_W + (size_t)l * W_LAYER;
        if (r < I_IN) { transpose_item<0>(P.w_in + (size_t)l * DM * NIN, DM, NIN, P.attn_norm + l * DM, (bf16*)(wl + W_IN), scr, r, NINP / 32, F.lane); continue; } r -= I_IN;
        if (r < I_OUT) { transpose_item<1>(P.w_out + (size_t)l * DM * DM, DM, DM, P.out_gain + l * DM, (bf16*)(wl + W_OUT), scr, r, DM / 32, F.lane); continue; } r -= I_OUT;
        if (r < I_UP) { transpose_item<1>(P.w_up + (size_t)l * DM * FF, DM, FF, P.mlp_norm + l * DM, (bf16*)(wl + W_UP), scr, r, FF / 32, F.lane); continue; } r -= I_UP;
        transpose_item<1>(P.w_down + (size_t)l * FF * DM, FF, DM, nullptr, (bf16*)(wl + W_DOWN), scr, r, DM / 32, F.lane);
    }
    bf16* XB = (bf16*)(P.ws + WS_XB); float* SSQ = (float*)(P.ws + WS_SSQ);
#pragma unroll 1
    for (int m0 = gw; m0 < M; m0 += 4 * NGW) {
        f32x4 v[4][4]; float s[4];
#pragma unroll
        for (int q = 0; q < 4; ++q) { const int m = m0 + q * NGW; const GAS f32x4* xr = (const GAS f32x4*)(P.x + (size_t)(m < M ? m : m0) * DM) + F.lane;
#pragma unroll
            for (int j = 0; j < 4; ++j) v[q][j] = xr[64 * j]; }
#pragma unroll
        for (int q = 0; q < 4; ++q) { float t = 0.f;
#pragma unroll
            for (int j = 0; j < 4; ++j) t += (v[q][j].x * v[q][j].x + v[q][j].y * v[q][j].y) + (v[q][j].z * v[q][j].z + v[q][j].w * v[q][j].w);
            s[q] = wave_sum(t); }
#pragma unroll
        for (int q = 0; q < 4; ++q) { const int m = m0 + q * NGW; if (m < M) {
            GAS unsigned long long* o8 = (GAS unsigned long long*)(XB + (size_t)m * DM) + F.lane;
#pragma unroll
            for (int j = 0; j < 4; ++j) o8[64 * j] = (unsigned long long)pk2(v[q][j].x, v[q][j].y) | ((unsigned long long)pk2(v[q][j].z, v[q][j].w) << 32);
            if (F.lane < 16) SSQ[(size_t)m * 16 + F.lane] = F.lane == 0 ? s[q] : 0.f; } }
    }
}

__device__ __forceinline__ void unpack8(const v4u w, float* f) { f[0] = bflo(w.x); f[1] = bfhi(w.x); f[2] = bflo(w.y); f[3] = bfhi(w.y); f[4] = bflo(w.z); f[5] = bfhi(w.z); f[6] = bflo(w.w); f[7] = bfhi(w.w); }


struct AttnBufs { const bf16 *Q, *K, *V; bf16* O;     bf16* OD; float* LD; const float* LS; const float* KMP; };
constexpr size_t OD_BRANCH = (size_t)M * 384, LD_BRANCH = (size_t)M * 8, BADJ = QKVO_BATCH_ADJ / 2;

__device__ __forceinline__ void moba_unit(Frame& F, const AttnBufs& A, int b, int h, int qb) {
    char* shm = (char*)F.lds; const int tid = F.tid, lane = tid & 63, r32 = lane & 31, hi = lane >> 5, w = F.wave;
    LAS float* KM = (LAS float*)(F.lds + att::LDS_X);
    for (int i = tid; i < 1024; i += 512) { const int j = i >> 6, d = i & 63; float v = 0.f;
        if (j < qb) { const float* p = A.KMP + ((size_t)((b * 16 + j) * 4 + h) * 2) * 64 + d; v = p[0] + p[64]; } KM[i] = v; }
    const size_t row0 = (size_t)b * SEQ + qb * 256 + w * 32;
    const size_t bo = (size_t)b * BADJ;
    const bf16* Qw = A.Q + bo + row0 * DM + h * 64;
    float qf[32];
    { const bf16* qp = Qw + (size_t)r32 * DM + hi * 8;
#pragma unroll
      for (int d0 = 0; d0 < 4; ++d0) { const v4u wv = *(const v4u*)(qp + d0 * 16); unpack8(wv, qf + 8 * d0); } }
    __syncthreads();
    float g0 = -INFINITY, g1 = -INFINITY, g2 = -INFINITY; int i0 = -1, i1 = -1, i2 = -1;
#pragma unroll 1
    for (int j = 0; j < qb; ++j) {
        float dot = 0.f;
#pragma unroll
        for (int d0 = 0; d0 < 4; ++d0) { const f32x4 ka = *(const LAS f32x4*)(KM + j * 64 + d0 * 16 + hi * 8), kb = *(const LAS f32x4*)(KM + j * 64 + d0 * 16 + hi * 8 + 4);
#pragma unroll
            for (int e = 0; e < 4; ++e) { dot += qf[8 * d0 + e] * ka[e]; dot += qf[8 * d0 + 4 + e] * kb[e]; } }
        { auto rr = __builtin_amdgcn_permlane32_swap(__float_as_uint(dot), __float_as_uint(dot), false, false); dot = __uint_as_float(rr[0]) + __uint_as_float(rr[1]); }
        if (dot > g0) { g2 = g1; i2 = i1; g1 = g0; i1 = i0; g0 = dot; i0 = j; } else if (dot > g1) { g2 = g1; i2 = i1; g1 = dot; i1 = j; } else if (dot > g2) { g2 = dot; i2 = j; }
    }
    unsigned selmask = 0u; if (i0 >= 0) selmask |= 1u << i0; if (i1 >= 0) selmask |= 1u << i1; if (i2 >= 0) selmask |= 1u << i2;
    att::BiasMoba B; B.slope2 = exp2f(-8.0f * (float)(7 + h) / 10.0f) * LOG2E; B.qrel = w * 32 + r32; B.tqf = (float)(qb * 256 + B.qrel); B.hi = hi; B.w = w; B.nb0 = 4 * qb; B.selmask = selmask; B.u = 32 * (w & 1) + r32 - 4 * hi;
    att::UnitIO io; io.Q = Qw; io.qstride = DM; io.K0 = A.K + bo + (size_t)b * SEQ * DM + h * 64; io.V0 = A.V + bo + (size_t)b * SEQ * DM + h * 64; io.kstride = DM;
    io.O = A.O + bo + row0 * DM + h * 64; io.ostride = DM; io.L = nullptr; io.lstride = 0; io.norm = true;
#ifdef PROBE_UNIT_OVH
    att::attn_tiles(shm, io, 4 * qb + 3, 4 * qb + 4, B, tid);
#endif
    att::attn_tiles(shm, io, 0, 4 * qb + 4, B, tid);
}
__device__ __forceinline__ void fox_unit(Frame& F, const AttnBufs& A, int b, int h, int qb) {
    char* shm = (char*)F.lds; const int tid = F.tid, lane = tid & 63, r32 = lane & 31, hi = lane >> 5, w = F.wave;
    LAS float* CS = (LAS float*)(F.lds + att::LDS_X); LAS float* WT = (LAS float*)(F.lds + att::LDS_X2);
    const int n = 256 * (qb + 1);
    const float* ls = A.LS + (size_t)(h - 4) * M + (size_t)b * SEQ;
    float v[8]; float run = 0.f;
    if (8 * tid < n) { const f32x4 a = *(const f32x4*)(ls + 8 * tid), c = *(const f32x4*)(ls + 8 * tid + 4);
        v[0] = a[0]; v[1] = a[1]; v[2] = a[2]; v[3] = a[3]; v[4] = c[0]; v[5] = c[1]; v[6] = c[2]; v[7] = c[3];
#pragma unroll
        for (int e = 0; e < 8; ++e) { run += v[e] * LOG2E; v[e] = run; } }
    else {
#pragma unroll
        for (int e = 0; e < 8; ++e) v[e] = 0.f; }
    float inc = run;
#pragma unroll
    for (int o = 1; o < 64; o <<= 1) { const float up = __shfl_up(inc, o); if (lane >= o) inc += up; }
    if (lane == 63) WT[w] = inc;
    __syncthreads();
    float woff = 0.f;
#pragma unroll
    for (int k = 0; k < 8; ++k) { const float tk = WT[k]; if (k < w) woff += tk; }
    const float excl = woff + inc - run;
    if (8 * tid < n) {
        *(LAS f32x4*)(CS + 8 * tid) = (f32x4){v[0] + excl, v[1] + excl, v[2] + excl, v[3] + excl}; *(LAS f32x4*)(CS + 8 * tid + 4) = (f32x4){v[4] + excl, v[5] + excl, v[6] + excl, v[7] + excl}; }
    __syncthreads();
    const int nb0 = 4 * qb; const float c_first = CS[qb * 256];
    int t_begin = 0;
    { bool skip = false; if (lane < nb0) skip = (c_first - CS[64 * lane + 63]) < -70.0f;
      const unsigned long long bm = __ballot(skip); t_begin = (int)__builtin_ctzll(~bm); if (t_begin > nb0) t_begin = nb0; }
    t_begin = __builtin_amdgcn_readfirstlane(t_begin);
    att::BiasFox B; B.cs2 = CS; B.qrel = w * 32 + r32; B.base = CS[qb * 256 + B.qrel]; B.hi = hi; B.w = w; B.nb0 = nb0; B.u = 32 * (w & 1) + r32 - 4 * hi;
    const size_t row0 = (size_t)b * SEQ + qb * 256 + w * 32;
    const size_t bo = (size_t)b * BADJ;
    att::UnitIO io; io.Q = A.Q + bo + row0 * DM + h * 64; io.qstride = DM; io.K0 = A.K + bo + (size_t)b * SEQ * DM + h * 64; io.V0 = A.V + bo + (size_t)b * SEQ * DM + h * 64; io.kstride = DM;
    io.O = A.O + bo + row0 * DM + h * 64; io.ostride = DM; io.L = nullptr; io.lstride = 0; io.norm = true;
#ifdef PROBE_UNIT_OVH
    att::attn_tiles(shm, io, nb0 + 3, nb0 + 4, B, tid);
#endif
    att::attn_tiles(shm, io, t_begin, nb0 + 4, B, tid);
}
__device__ __forceinline__ void dil_unit(Frame& F, const AttnBufs& A, int b, int h, int g, int r, int c) {
    char* shm = (char*)F.lds; const int tid = F.tid, lane = tid & 63, r32 = lane & 31, hi = lane >> 5, w = F.wave;
    const int dil = (g == 0) ? 1 : (g == 1 ? 4 : 16);
    const int i0 = 256 * c;
    att::BiasDil B; B.sd = exp2f(-8.0f * (float)(h - 10 + 1) / 10.0f) * LOG2E * (float)dil; B.qrel = 128 + w * 32 + r32; B.hi = hi; B.w = w; B.setup(r32);
    const long tok_q0 = (long)b * SEQ + r + (long)dil * (i0 + w * 32);
    const long tok_k0 = (long)b * SEQ + r + (long)dil * (i0 - 128);
    const long bo = (long)b * (long)BADJ;
    att::UnitIO io; io.Q = A.Q + bo + tok_q0 * DM + h * 64; io.qstride = (long)DM * dil; io.K0 = A.K + bo + tok_k0 * DM + h * 64; io.V0 = A.V + bo + tok_k0 * DM + h * 64; io.kstride = (long)DM * dil;
    io.O = A.OD + (size_t)g * OD_BRANCH + tok_q0 * 384 + (h - 10) * 64; io.ostride = (long)384 * dil; io.L = A.LD + (size_t)g * LD_BRANCH + tok_q0 * 8 + (h - 10); io.lstride = (long)8 * dil; io.norm = false;
#ifdef PROBE_UNIT_OVH
    att::attn_tiles(shm, io, 5, 6, B, tid);
#endif
    att::attn_tiles(shm, io, c == 0 ? 2 : 0, 6, B, tid);
}
__device__ __forceinline__ void attn_phase(Frame& F, const AttnBufs& A) {
#ifndef PROBE_DUP_ATT
#define PROBE_DUP_ATT 0
#endif
    const int g = F.vcu >> 5, r = F.vcu & 31;
    for (int rep = 0; rep < ((PROBE_DUP_ATT & 1) ? 2 : 1); ++rep)
    for (int k = 0; k < 2; ++k) { const int h = r >> 3, s = r & 7; moba_unit(F, A, g, h, k == 0 ? s : 15 - s); }
    for (int rep = 0; rep < ((PROBE_DUP_ATT & 2) ? 2 : 1); ++rep)
    for (int k = 0; k < 3; ++k) { const int idx = r + 32 * k, hf = idx >> 4, qb = ((idx & 15) + 5 * k) & 15; fox_unit(F, A, g, 4 + hf, qb); }
    for (int rep = 0; rep < ((PROBE_DUP_ATT & 4) ? 2 : 1); ++rep)
    for (int k = 0; k < 9; ++k) { const int idx = r + 32 * k, h6 = idx / 48, rest = idx % 48, br = rest >> 4, i16 = rest & 15;
        const int rr = (br == 0) ? 0 : (br == 1 ? (i16 >> 2) : i16), c = (br == 0) ? i16 : (br == 1 ? (i16 & 3) : 0);
        dil_unit(F, A, g, 10 + h6, br, rr, c); }
}
struct NormRow { v4u oa, oc, d0, d1, d2, ga, gc; float l0, l1, l2; };
__device__ __forceinline__ void norm_load(NormRow& R, int m, int lane, const bf16* O, const bf16* GF, const bf16* OD, const float* LD) {
    R.oa = *(const GAS v4u*)(O + (size_t)m * DM + 8 * lane);
    if (lane < 16) { R.oc = *(const GAS v4u*)(O + (size_t)m * DM + 512 + 8 * lane); R.gc = *(const GAS v4u*)(GF + (size_t)m * 384 + 256 + 8 * lane); }
    else { const int dc = 8 * lane - 128, hd = dc >> 6;
        R.d0 = *(const GAS v4u*)(OD + (size_t)m * 384 + dc); R.d1 = *(const GAS v4u*)(OD + OD_BRANCH + (size_t)m * 384 + dc); R.d2 = *(const GAS v4u*)(OD + 2 * OD_BRANCH + (size_t)m * 384 + dc);
        R.l0 = LD[(size_t)m * 8 + hd]; R.l1 = LD[LD_BRANCH + (size_t)m * 8 + hd]; R.l2 = LD[2 * LD_BRANCH + (size_t)m * 8 + hd]; }
    if (lane >= 32) R.ga = *(const GAS v4u*)(GF + (size_t)m * 384 + 8 * lane - 256);
}
__device__ __forceinline__ void norm_finish(const NormRow& R, int m, int lane, bf16* Y) {
    float fa[8], fc[8];
    unpack8(R.oa, fa);
    if (lane < 16) unpack8(R.oc, fc);
    else { float f0[8], f1[8], f2[8]; unpack8(R.d0, f0); unpack8(R.d1, f1); unpack8(R.d2, f2);
        const float inv = 1.0f / (R.l0 + R.l1 + R.l2);
#pragma unroll
        for (int e = 0; e < 8; ++e) fc[e] = (f0[e] + f1[e] + f2[e]) * inv; }
    float sa = 0.f, sc = 0.f;
#pragma unroll
    for (int e = 0; e < 8; ++e) { sa += fa[e] * fa[e]; sc += fc[e] * fc[e]; }
    const float s_moba = wave_sum(lane < 32 ? sa : 0.f), s_fox = wave_sum((lane >= 32 ? sa : 0.f) + (lane < 16 ? sc : 0.f)), s_dil = wave_sum(lane >= 16 ? sc : 0.f);
    const float r_moba = 1.0f / sqrtf(s_moba * (1.0f / 256.0f) + EPS), r_fox = 1.0f / sqrtf(s_fox * (1.0f / 384.0f) + EPS), r_dil = 1.0f / sqrtf(s_dil * (1.0f / 384.0f) + EPS);
    float ga[8], gc[8];
#pragma unroll
    for (int e = 0; e < 8; ++e) { ga[e] = 1.f; gc[e] = 1.f; }
    if (lane >= 32) unpack8(R.ga, ga);
    if (lane < 16) unpack8(R.gc, gc);
    const float ra = lane < 32 ? r_moba : r_fox, rc = lane < 16 ? r_fox : r_dil;
    v4u ya, yc;
    ya.x = pk2(fa[0] * ra * ga[0], fa[1] * ra * ga[1]); ya.y = pk2(fa[2] * ra * ga[2], fa[3] * ra * ga[3]); ya.z = pk2(fa[4] * ra * ga[4], fa[5] * ra * ga[5]); ya.w = pk2(fa[6] * ra * ga[6], fa[7] * ra * ga[7]);
    yc.x = pk2(fc[0] * rc * gc[0], fc[1] * rc * gc[1]); yc.y = pk2(fc[2] * rc * gc[2], fc[3] * rc * gc[3]); yc.z = pk2(fc[4] * rc * gc[4], fc[5] * rc * gc[5]); yc.w = pk2(fc[6] * rc * gc[6], fc[7] * rc * gc[7]);
    *(GAS v4u*)(Y + (size_t)m * DM + 8 * lane) = ya; *(GAS v4u*)(Y + (size_t)m * DM + 512 + 8 * lane) = yc;
}
__device__ __forceinline__ void norm_phase(Frame& F, const bf16* O, const bf16* GF, const bf16* OD, const float* LD, bf16* Y) {
    const int g = F.vcu >> 5, r = F.vcu & 31, lane = F.lane;
    const int base = g * SEQ + ((r & 7) + ((r >> 4) << 3)) * 256 + ((r >> 3) & 1) * 128 + F.wave * 16;
#pragma unroll 1
    for (int j = 0; j < 16; j += 4) {
        const int m = base + j;
        NormRow R0, R1, R2, R3;
        norm_load(R0, m, lane, O, GF, OD, LD); norm_load(R1, m + 1, lane, O, GF, OD, LD); norm_load(R2, m + 2, lane, O, GF, OD, LD); norm_load(R3, m + 3, lane, O, GF, OD, LD);
        norm_finish(R0, m, lane, Y); norm_finish(R1, m + 1, lane, Y); norm_finish(R2, m + 2, lane, Y); norm_finish(R3, m + 3, lane, Y);
    }
}
__device__ __forceinline__ void group_barrier(unsigned* cnt, volatile LAS unsigned* epoch  , volatile LAS unsigned* fast, const unsigned nwg, int tid) {
    asm volatile("s_waitcnt vmcnt(0)" ::: "memory");
    __syncthreads();
    if (tid == 0) {
        if (fast[0] == 0u) __builtin_amdgcn_fence(__ATOMIC_RELEASE, "agent");
        asm volatile("s_waitcnt vmcnt(0)" ::: "memory");
        const unsigned e = epoch[0] + 1u; epoch[0] = e; const unsigned target = nwg * e;
        (void)__hip_atomic_fetch_add(cnt, 1u, __ATOMIC_RELAXED, __HIP_MEMORY_SCOPE_AGENT);
        unsigned sp = 0;
        while (__hip_atomic_load(cnt, __ATOMIC_RELAXED, __HIP_MEMORY_SCOPE_AGENT) < target) { __builtin_amdgcn_s_sleep(1); if (++sp > (1u << 22)) break; }
        __builtin_amdgcn_fence(__ATOMIC_ACQUIRE, "agent");
        asm volatile("s_waitcnt vmcnt(0)" ::: "memory");
    }
    __syncthreads();
}

struct Args { const float* in[11]; float* out; unsigned char* ws; int ph_lo, ph_hi; };
__global__ void __launch_bounds__(NWAVES * 64, 2) mk_fwd(Args args) {
    __shared__ __attribute__((aligned(16))) unsigned char lds[LDS_BYTES];
    for (int u = threadIdx.x; u < (LDS_BYTES - LDSCTL_OFF) / 4; u += NWAVES * 64) ((LAS unsigned*)((LAS unsigned char*)lds + LDSCTL_OFF))[u] = 0u;
    __syncthreads();
    const int lo = args.ph_lo, hi = args.ph_hi;
    const int wave_id0 = __builtin_amdgcn_readfirstlane((int)threadIdx.x >> 6);
    XcdBarrier bar; bar.bar = (unsigned*)(args.ws + WS_CTL) + CW_BAR; bar.x = 0; bar.st = nullptr;
    if (hi - lo > 1) bar = xcd_barrier_post((unsigned*)(args.ws + WS_CTL) + CW_BAR, (volatile LAS unsigned*)((LAS unsigned char*)lds + MISC_OFF) + 8);
#ifndef PROBE_DUP_PHASE
#define PROBE_DUP_PHASE -1
#endif
    int dup_left = 1;
#pragma unroll 1
    for (int ph = lo; ph < hi; ++ph) {
        const int ph_exec = ph;
        unsigned char* ws = args.ws; asm volatile("" : "+s"(ws));
        int wv_ = wave_id0; asm volatile("" : "+s"(wv_));
        int tid_ = (wv_ << 6) | (int)__builtin_amdgcn_mbcnt_hi(~0u, __builtin_amdgcn_mbcnt_lo(~0u, 0u)); asm volatile("" : "+v"(tid_));
        int bid_ = blockIdx.x, G_ = gridDim.x; asm volatile("" : "+s"(bid_), "+s"(G_));
        Frame F;
        F.lds = (LAS unsigned char*)lds;
        F.MISC = (volatile LAS unsigned*)(F.lds + MISC_OFF);
        F.tid = tid_; F.lane = F.tid & 63; F.wave = __builtin_amdgcn_readfirstlane(F.tid >> 6);
        F.G = G_; F.vcu = (F.G % 8 == 0) ? (bid_ % 8) * (F.G / 8) + bid_ / 8 : bid_;
        F.ctl = (gu32*)(ws + WS_CTL);
        Ptrs P;
        P.x = args.in[0]; P.attn_norm = args.in[1]; P.w_in = args.in[2]; P.b_forget = args.in[3]; P.q_gain = args.in[4]; P.k_gain = args.in[5];
        P.out_gain = args.in[6]; P.w_out = args.in[7]; P.mlp_norm = args.in[8]; P.w_up = args.in[9]; P.w_down = args.in[10]; P.out = args.out; P.ws = ws;
        PG8_LAS float* tab = (PG8_LAS float*)(F.lds + pg8::TAB_OFF);
        if (ph == 0) {
            if (F.tid == 0) __hip_atomic_store((unsigned*)(ws + WS_CTL) + CW_XCC + F.vcu, ((unsigned)__builtin_amdgcn_s_getreg((3 << 11) | 20) & 0xFu) + 1u, __ATOMIC_RELAXED, __HIP_MEMORY_SCOPE_AGENT);
            p0_prologue(F, P); }
        else {
            const int l = (ph - 1) / 6, k = (ph - 1) % 6;
            unsigned char* wl = ws + WS_W + (size_t)l * W_LAYER;
            bf16* XB = (bf16*)(ws + WS_XB);
            if (k == 0) {
                pg8::Gemm g{XB, (const bf16*)(wl + W_IN), M, NINP, DM, DM, 0}; pg8::StaticOrder S; S.init(M, NINP, F.G, bid_);
                pg8::EpiIn E{ws, P.b_forget + l * 6, tab};
                pg8::prep_tables(S, tab, ws, P.q_gain + l * 1024, P.k_gain + l * 1024, F.tid); __syncthreads();
                pg8::gemm_phase<pg8::EpiIn, pg8::StaticOrder, true, true>(F.lds + RING_OFF, g, S, E, F.tid);
            } else if (k == 1) {
                const AttnBufs AB{(const bf16*)(ws + WS_QKVO), (const bf16*)(ws + WS_QKVO + QKVO_K), (const bf16*)(ws + WS_QKVO + QKVO_V), (bf16*)(ws + WS_QKVO + QKVO_O), (bf16*)(ws + WS_OD), (float*)(ws + WS_LD), (const float*)(ws + WS_LS), (const float*)(ws + WS_KMP)};
                attn_phase(F, AB);
            } else if (k == 2) {
                unsigned char* qb_ = ws + WS_QKVO + (size_t)(F.vcu >> 5) * QKVO_BATCH_ADJ;
                norm_phase(F, (const bf16*)(qb_ + QKVO_O), (const bf16*)(ws + WS_GF), (const bf16*)(ws + WS_OD), (const float*)(ws + WS_LD), (bf16*)qb_);
            } else if (k == 4) {
                pg8::Gemm g{XB, (const bf16*)(wl + W_UP), M, FF, DM, DM, 0}; pg8::StaticOrder S; S.init(M, FF, F.G, bid_);
#ifdef PROBE_EPI_UP
                pg8::EpiUp E{ws, tab, (ph == PROBE_DUP_PHASE && dup_left == 1) ? PROBE_EPI_UP : 0};
#else
                pg8::EpiUp E{ws, tab, 0};
#endif
                pg8::prep_tables(S, tab, ws, nullptr, nullptr, F.tid); __syncthreads();
                pg8::gemm_phase<pg8::EpiUp, pg8::StaticOrder, true, true>(F.lds + RING_OFF, g, S, E, F.tid);
            } else {
                const bool dn = (k == 5);
                pg8::Gemm g{(const bf16*)(ws + WS_QKVO + (size_t)(F.vcu >> 5) * QKVO_BATCH_ADJ), (const bf16*)(wl + (dn ? W_DOWN : W_OUT)), M, DM, dn ? FF : DM, DM, (long)(8 * MiB) - 2048};
                pg8::StaticOrder S; S.init(M, DM, F.G, bid_);
                pg8::EpiRes E{P.out, ws, ph == NPH - 1};
                pg8::gemm_phase<pg8::EpiRes, pg8::StaticOrder, true, true>(F.lds + RING_OFF, g, S, E, F.tid);
            }
        }
        if (ph == PROBE_DUP_PHASE && dup_left > 0) { --dup_left; --ph; }
        if (ph + 1 < hi) {
            if (ph_exec == 0 || F.G != 256) { XcdBarrier b2 = bar; asm volatile("" : "+s"(b2.bar)); xcd_barrier(b2, F.tid);
#ifndef GROUP_STAGGER
#define GROUP_STAGGER 0
#endif
#ifndef NO_XCD_FAST
                if (F.G == 256 && F.tid < 64) {
                    const unsigned mine = ((unsigned)__builtin_amdgcn_s_getreg((3 << 11) | 20) & 0xFu) + 1u;
                    const unsigned v = __hip_atomic_load((unsigned*)(ws + WS_CTL) + CW_XCC + (F.vcu & ~31) + (F.tid & 31), __ATOMIC_RELAXED, __HIP_MEMORY_SCOPE_AGENT);
                    const unsigned long long eq = __ballot(v == mine);
                    if (F.tid == 0) F.MISC[11] = (eq == ~0ull) ? 1u : 0u; }
#endif
                if (GROUP_STAGGER > 0 && F.G == 256) { const unsigned long long t0 = __builtin_amdgcn_s_memrealtime(); const unsigned long long dl = (unsigned long long)(F.vcu >> 5) * GROUP_STAGGER;
                    while (__builtin_amdgcn_s_memrealtime() - t0 < dl) __builtin_amdgcn_s_sleep(8); } }
            else {
                const int kk = (ph_exec - 1) % 6;
                if (kk >= 2) { unsigned* qc = (unsigned*)(ws + WS_CTL) + CW_QBAR + 64 * ((F.vcu >> 5) * 8 + (F.vcu & 7)); group_barrier(qc, F.MISC + 12, F.MISC + 11, 4u, F.tid); }
                else { unsigned* gc = (unsigned*)(ws + WS_CTL) + CW_GBAR + 64 * (F.vcu >> 5); group_barrier(gc, F.MISC + 10, F.MISC + 11, 32u, F.tid); }
            }
        }
    }
}

extern "C" void kernel_launch(void* const* d_in, const int* in_sizes, int n_in, void* d_out, int out_size, void* d_ws, size_t ws_size, hipStream_t stream) {
    static int grid = 0;
    if (grid == 0) {
        if (n_in != 11 || in_sizes[0] != M * DM || out_size != M * DM || ws_size < WS_END) { fprintf(stderr, "kernel_launch: unexpected shapes (n_in %d in0 %d out %d ws %zu)\n", n_in, n_in > 0 ? in_sizes[0] : -1, out_size, ws_size); grid = -1; return; }
        int dev = 0, cus = 0, per_cu = 0;
        if (hipGetDevice(&dev) != hipSuccess || hipDeviceGetAttribute(&cus, hipDeviceAttributeMultiprocessorCount, dev) != hipSuccess) { grid = -1; return; }
        if (hipOccupancyMaxActiveBlocksPerMultiprocessor(&per_cu, (const void*)mk_fwd, NWAVES * 64, 0) != hipSuccess || per_cu < 1) { fprintf(stderr, "kernel_launch: occupancy query says %d blocks per CU\n", per_cu); (void)hipGetLastError(); grid = -1; return; }
        if (cus != 256) { fprintf(stderr, "kernel_launch: built for a 256-CU device (8 groups of 32 workgroups, one batch element each); found %d CUs\n", cus); grid = -1; return; }
        grid = cus;
    }
    if (grid < 0) return;
    (void)hipMemsetAsync((char*)d_ws + WS_CTL, 0, CTL_ZERO_BYTES, stream);
    Args a{};
    for (int i = 0; i < 11; ++i) a.in[i] = (const float*)d_in[i];
    a.out = (float*)d_out; a.ws = (unsigned char*)d_ws;
#if MK_ONE_LAUNCH
    a.ph_lo = 0; a.ph_hi = NPH;
    hipLaunchKernelGGL(mk_fwd, dim3(grid), dim3(NWAVES * 64), 0, stream, a);
#else
    for (int p = 0; p < NPH; ++p) { a.ph_lo = p; a.ph_hi = p + 1; hipLaunchKernelGGL(mk_fwd, dim3(grid), dim3(NWAVES * 64), 0, stream, a); }
#endif
}
```

```cpp
#include <hip/hip_runtime.h>
#include <cstdio>
#include <cstdint>
namespace pg8 {
#define PG8_LAS __attribute__((address_space(3)))
typedef unsigned short bf16_t;
typedef short bf16x8 __attribute__((ext_vector_type(8)));
typedef float f32x4 __attribute__((ext_vector_type(4)));
typedef unsigned u32x4 __attribute__((ext_vector_type(4)));
constexpr int BM = 256, BK = 64, HALF = 128, HTB = HALF * BK * 2  , STAGE_BYTES = 8 * HTB, NXCD = 8, WGM = 8;

__host__ __device__ __forceinline__ int lds_byte(int r, int c) { const int st = (r >> 4) * 2 + (c >> 5), rr = r & 15, cc = c & 31, ob = rr * 64 + cc * 2; return st * 1024 + (ob ^ (((ob >> 9) & 1) << 5)); }
__host__ __device__ __forceinline__ void stage_rc(int b, int& R, int& C) { const int st = b / 1024, sb = b % 1024, swz = sb ^ (((sb >> 9) & 1) << 5); R = (st >> 1) * 16 + swz / 64; C = (st & 1) * 32 + (swz % 64) / 2; }
__host__ __device__ __forceinline__ int perm32(int rho) { const int n = rho >> 4, i = rho & 15; return 8 * (i >> 2) + 4 * n + (i & 3); }

struct Unit { int pm, pn; };
struct Gemm { const bf16_t* A; const bf16_t* Bt; int M, N, K; int lda; long padj; };

struct StaticOrder {
    int nM, nN, nwg, G, c;
    __host__ __device__ void init(int M, int N, int G_, int c_) { nM = M / BM; nN = N / BM; nwg = nM * nN; G = G_; c = c_; }
    __host__ __device__ bool next(int i, Unit& u) const {
        const long L = (long)i * G + c; if (L >= nwg) return false;
        int wgid = (int)L; { const int q = nwg / NXCD, r = nwg % NXCD, xcd = wgid % NXCD, off = wgid / NXCD; wgid = (xcd < r ? xcd * (q + 1) : r * (q + 1) + (xcd - r) * q) + off; }
        const int nig = WGM * nN, gid = wgid / nig, fm = gid * WGM, gsz = (nM - fm) < WGM ? (nM - fm) : WGM;
        u.pm = fm + ((wgid % nig) % gsz); u.pn = (wgid % nig) / gsz; return true;
    }
    __device__ __forceinline__ void a_ready(const Unit&) const {}
    __device__ __forceinline__ void done(const Unit&) const {}
};


__device__ __forceinline__ unsigned cvt_pk_bf16(float lo, float hi) { unsigned r; asm volatile("v_cvt_pk_bf16_f32 %0, %1, %2" : "=v"(r) : "v"(lo), "v"(hi)); return r; }
constexpr float RMS_EPS = 1e-6f;
constexpr float QSCALE = 0.125f * 1.4426950408889634f;
constexpr int TAB_OFF = 131072 + 512, TAB_G = 2048;
constexpr size_t EMiB = 1u << 20;
constexpr size_t E_SSQ = 52 * EMiB, E_LS = 54 * EMiB, E_KMP = 55 * EMiB, E_PRM = 56 * EMiB, E_XB = 64 * EMiB, E_QKVO = 128 * EMiB  , E_H = 128 * EMiB, E_GF = 384 * EMiB;
__device__ __forceinline__ float row_rstd(const float* ssq, unsigned row) {
    const float* p = ssq + (size_t)(row * 16u);
    const f32x4 a = *(const f32x4*)(p), b = *(const f32x4*)(p + 4), c = *(const f32x4*)(p + 8), d = *(const f32x4*)(p + 12);
    const float s = ((a[0] + a[1]) + (a[2] + a[3])) + ((b[0] + b[1]) + (b[2] + b[3])) + ((c[0] + c[1]) + (c[2] + c[3])) + ((d[0] + d[1]) + (d[2] + d[3]));
    return 1.0f / sqrtf(s * (1.0f / 1024.0f) + RMS_EPS);
}
template <class Sched>
__device__ __forceinline__ void prep_tables(const Sched& S, PG8_LAS float* tab, const unsigned char* ws, const float* qg, const float* kg  , int tid) {
    Unit u;
#pragma unroll 1
    for (int i = 0; i < 8 && S.next(i, u); ++i) {
        if (tid < 256) tab[i * 256 + tid] = row_rstd((const float*)(ws + E_SSQ), (unsigned)(u.pm * BM + tid));
        else if (qg && u.pn < 8) { const int c = tid - 256; tab[TAB_G + i * 256 + c] = u.pn < 4 ? qg[(u.pn & 3) * 256 + c] * QSCALE : kg[(u.pn & 3) * 256 + c]; }
    }
}
#define PG8_GAS __attribute__((address_space(1)))
#define PG8_PACK8(y0, y1) (u32x4){cvt_pk_bf16((y0)[0], (y0)[1]), cvt_pk_bf16((y0)[2], (y0)[3]), cvt_pk_bf16((y1)[0], (y1)[1]), cvt_pk_bf16((y1)[2], (y1)[3])}
struct EpiIn {
    static constexpr bool PERM = true, AFTER_DRAIN = false;
    unsigned char* ws; const float* bfg; PG8_LAS float* tab;
    __device__ __forceinline__ void operator()(const f32x4 (&acc)[2][2][4][2], const Unit& u, int ui, int wr, int wc, int fr, int fq) const {
        const int pn = u.pn; const unsigned row0 = (unsigned)(u.pm * BM + wr * 64 + fr);
        const PG8_LAS float* rsp = tab + ui * 256 + wr * 64 + fr;
        if (pn < 8) {
            const PG8_LAS float* gp = tab + TAB_G + ui * 256 + 64 * wc + 8 * fq;
            f32x4 g[2][2];
#pragma unroll
            for (int bj = 0; bj < 2; ++bj)
#pragma unroll
                for (int n = 0; n < 2; ++n) g[bj][n] = *(const PG8_LAS f32x4*)(gp + 32 * bj + 4 * n);
            unsigned char* dst = ws + E_QKVO + (size_t)((unsigned)(u.pm >> 4) * (24u << 20) + (pn < 4 ? 0u : (8u << 20)) + (unsigned)(((pn & 3) * 256 + wc * 64 + 8 * fq) * 2));
            float ss[2][4], e2[2][4];
#pragma unroll
            for (int ai = 0; ai < 2; ++ai)
#pragma unroll
                for (int m = 0; m < 4; ++m) {
                    const float rs = rsp[ai * HALF + m * 16]; e2[ai][m] = RMS_EPS * __builtin_amdgcn_rcpf(rs * rs);
                    f32x4 s4 = acc[ai][0][m][0] * acc[ai][0][m][0]; s4 += acc[ai][0][m][1] * acc[ai][0][m][1]; s4 += acc[ai][1][m][0] * acc[ai][1][m][0]; s4 += acc[ai][1][m][1] * acc[ai][1][m][1];
                    ss[ai][m] = (s4[0] + s4[1]) + (s4[2] + s4[3]);
                }
            float sw[2][4];
#pragma unroll
            for (int ai = 0; ai < 2; ++ai)
#pragma unroll
                for (int m = 0; m < 4; ++m) sw[ai][m] = __builtin_bit_cast(float, __builtin_amdgcn_ds_swizzle(__builtin_bit_cast(int, ss[ai][m]), 0x401F));
#pragma unroll
            for (int ai = 0; ai < 2; ++ai)
#pragma unroll
                for (int m = 0; m < 4; ++m) { float s = ss[ai][m] + sw[ai][m]; s += __shfl_xor(s, 32);
                    ss[ai][m] = __builtin_amdgcn_rsqf(s * (1.0f / 64.0f) + e2[ai][m]); }
            if (pn != 4) {
#pragma unroll
                for (int ai = 0; ai < 2; ++ai)
#pragma unroll
                    for (int m = 0; m < 4; ++m) {
                        const unsigned row = row0 + ai * HALF + m * 16; const float r2 = ss[ai][m];
#pragma unroll
                        for (int bj = 0; bj < 2; ++bj) {
                            const f32x4 z0 = acc[ai][bj][m][0] * (g[bj][0] * r2), z1 = acc[ai][bj][m][1] * (g[bj][1] * r2);
                            *(u32x4*)(dst + (size_t)(row * 2048u + 64u * bj)) = PG8_PACK8(z0, z1);
                        }
                    }
            } else {
                f32x4 ks[2][2];
#pragma unroll
                for (int bj = 0; bj < 2; ++bj)
#pragma unroll
                    for (int n = 0; n < 2; ++n) ks[bj][n] = (f32x4){0.f, 0.f, 0.f, 0.f};
#pragma unroll
                for (int ai = 0; ai < 2; ++ai)
#pragma unroll
                    for (int m = 0; m < 4; ++m) {
                        const unsigned row = row0 + ai * HALF + m * 16; const float r2 = ss[ai][m];
#pragma unroll
                        for (int bj = 0; bj < 2; ++bj) {
                            const f32x4 z0 = acc[ai][bj][m][0] * (g[bj][0] * r2), z1 = acc[ai][bj][m][1] * (g[bj][1] * r2);
                            ks[bj][0] += z0; ks[bj][1] += z1;
                            *(u32x4*)(dst + (size_t)(row * 2048u + 64u * bj)) = PG8_PACK8(z0, z1);
                        }
                    }
#pragma unroll
                for (int bj = 0; bj < 2; ++bj)
#pragma unroll
                    for (int n = 0; n < 2; ++n)
#pragma unroll
                        for (int e = 0; e < 4; ++e) { float s = ks[bj][n][e]; s += __shfl_xor(s, 1); s += __shfl_xor(s, 2); s += __shfl_xor(s, 4); s += __shfl_xor(s, 8); ks[bj][n][e] = s; }
                if (fr == 0) { float* kp = (float*)(ws + E_KMP) + (size_t)(unsigned)((((u.pm * 4 + wc) * 2 + wr) * 64 + 8 * fq));
#pragma unroll
                    for (int bj = 0; bj < 2; ++bj)
#pragma unroll
                        for (int n = 0; n < 2; ++n) *(f32x4*)(kp + 32 * bj + 4 * n) = ks[bj][n]; }
            }
        } else if (pn < 12) {
            unsigned char* dst = ws + E_QKVO + (size_t)((unsigned)(u.pm >> 4) * (24u << 20) + (16u << 20) + (unsigned)(((pn & 3) * 256 + wc * 64 + 8 * fq) * 2));
#pragma unroll
            for (int ai = 0; ai < 2; ++ai)
#pragma unroll
                for (int m = 0; m < 4; ++m) {
                    const unsigned row = row0 + ai * HALF + m * 16; const float rs = rsp[ai * HALF + m * 16];
#pragma unroll
                    for (int bj = 0; bj < 2; ++bj) { const f32x4 y0 = acc[ai][bj][m][0] * rs, y1 = acc[ai][bj][m][1] * rs;
                        *(u32x4*)(dst + (size_t)(row * 2048u + 64u * bj)) = PG8_PACK8(y0, y1); }
                }
        } else {
#pragma unroll
            for (int ai = 0; ai < 2; ++ai)
#pragma unroll
                for (int m = 0; m < 4; ++m) {
                    const unsigned row = row0 + ai * HALF + m * 16; const float rs = rsp[ai * HALF + m * 16];
#pragma unroll
                    for (int bj = 0; bj < 2; ++bj) {
                        const f32x4 y0 = acc[ai][bj][m][0] * rs, y1 = acc[ai][bj][m][1] * rs;
                        if (pn == 12 || bj == 0) {
                            const unsigned gcol = (unsigned)((pn == 12 ? 0 : 256) + 128 * bj + 32 * wc + 8 * fq);
                            f32x4 s0, s1;
#pragma unroll
                            for (int e = 0; e < 4; ++e) { s0[e] = __builtin_amdgcn_rcpf(1.0f + __builtin_amdgcn_exp2f(y0[e] * -1.4426950408889634f)); s1[e] = __builtin_amdgcn_rcpf(1.0f + __builtin_amdgcn_exp2f(y1[e] * -1.4426950408889634f)); }
                            *(u32x4*)(ws + E_GF + (size_t)((row * 384u + gcol) * 2u)) = PG8_PACK8(s0, s1);
                        } else if (wc == 0 && fq == 0) {
                            float z[6] = {y0[0], y0[1], y0[2], y0[3], y1[0], y1[1]};
#pragma unroll
                            for (int e = 0; e < 6; ++e) { const float zz = z[e] + bfg[e]; z[e] = fminf(zz, 0.f) - log1pf(__expf(-fabsf(zz))); }
                            float* lp = (float*)(ws + E_LS) + (size_t)row;
#pragma unroll
                            for (int e = 0; e < 6; ++e) lp[(size_t)(e * 32768u)] = z[e];
                        }
                    }
                }
        }
    }
};
struct EpiRes {
    static constexpr bool PERM = true, AFTER_DRAIN = false;
    float* out; unsigned char* ws; bool last;
    __device__ __forceinline__ void operator()(const f32x4 (&acc)[2][2][4][2], const Unit& u, int ui, int wr, int wc, int fr, int fq) const {
        const unsigned row0 = (unsigned)(u.pm * BM + wr * 64 + fr), col0 = (unsigned)(u.pn * BM + wc * 32 + 8 * fq);
        u32x4 xw[2][4][2];
#pragma unroll
        for (int ai = 0; ai < 2; ++ai)
#pragma unroll
            for (int m = 0; m < 4; ++m)
#pragma unroll
                for (int bj = 0; bj < 2; ++bj) { const unsigned off = (row0 + ai * HALF + m * 16) * 1024u + col0 + bj * HALF;
                    xw[ai][m][bj] = *(const PG8_GAS u32x4*)((PG8_GAS unsigned char*)ws + E_XB + (size_t)(off * 2u)); }
        float ssv[2][4];
#pragma unroll
        for (int ai = 0; ai < 2; ++ai) {
#pragma unroll
            for (int m = 0; m < 4; ++m) {
                const unsigned row = row0 + ai * HALF + m * 16; float ss = 0.f;
#pragma unroll
                for (int bj = 0; bj < 2; ++bj) {
                    const unsigned off = row * 1024u + col0 + bj * HALF;
                    const u32x4 x4 = xw[ai][m][bj];
                    f32x4 o0, o1;
                    o0[0] = __builtin_bit_cast(float, x4[0] << 16) + acc[ai][bj][m][0][0]; o0[1] = __builtin_bit_cast(float, x4[0] & 0xffff0000u) + acc[ai][bj][m][0][1];
                    o0[2] = __builtin_bit_cast(float, x4[1] << 16) + acc[ai][bj][m][0][2]; o0[3] = __builtin_bit_cast(float, x4[1] & 0xffff0000u) + acc[ai][bj][m][0][3];
                    o1[0] = __builtin_bit_cast(float, x4[2] << 16) + acc[ai][bj][m][1][0]; o1[1] = __builtin_bit_cast(float, x4[2] & 0xffff0000u) + acc[ai][bj][m][1][1];
                    o1[2] = __builtin_bit_cast(float, x4[3] << 16) + acc[ai][bj][m][1][2]; o1[3] = __builtin_bit_cast(float, x4[3] & 0xffff0000u) + acc[ai][bj][m][1][3];
                    if (last) { *(PG8_GAS f32x4*)((PG8_GAS float*)out + (size_t)off) = o0; *(PG8_GAS f32x4*)((PG8_GAS float*)out + (size_t)off + 4) = o1; }
                    else {
                        const f32x4 q4 = o0 * o0 + o1 * o1; ss += (q4[0] + q4[1]) + (q4[2] + q4[3]);
                        *(PG8_GAS u32x4*)((PG8_GAS unsigned char*)ws + E_XB + (size_t)(off * 2u)) = PG8_PACK8(o0, o1);
                    }
                }
                ssv[ai][m] = ss;
            }
        }
        if (!last) {
            float sw[2][4];
#pragma unroll
            for (int ai = 0; ai < 2; ++ai)
#pragma unroll
                for (int m = 0; m < 4; ++m) sw[ai][m] = __shfl_xor(ssv[ai][m], 16);
#pragma unroll
            for (int ai = 0; ai < 2; ++ai)
#pragma unroll
                for (int m = 0; m < 4; ++m) ssv[ai][m] += sw[ai][m];
#pragma unroll
            for (int ai = 0; ai < 2; ++ai)
#pragma unroll
                for (int m = 0; m < 4; ++m) sw[ai][m] = __shfl_xor(ssv[ai][m], 32);
            if (fq == 0) {
#pragma unroll
                for (int ai = 0; ai < 2; ++ai)
#pragma unroll
                    for (int m = 0; m < 4; ++m) ((PG8_GAS float*)((PG8_GAS unsigned char*)ws + E_SSQ))[(size_t)((row0 + ai * HALF + m * 16) * 16u + (unsigned)(u.pn * 4 + wc))] = ssv[ai][m] + sw[ai][m];
            }
        }
    }
};
struct EpiUp {
    static constexpr bool PERM = true, AFTER_DRAIN = false;
    unsigned char* ws; PG8_LAS float* tab; int probe_mode;
    __device__ __forceinline__ void operator()(const f32x4 (&acc)[2][2][4][2], const Unit& u, int ui, int wr, int wc, int fr, int fq) const {
#ifdef PROBE_EPI_UP
        if (probe_mode == 2) { asm volatile("" :: "v"(acc[0][0][0][0]), "v"(acc[1][1][3][1])); return; }
#endif
        const unsigned row0 = (unsigned)(u.pm * BM + wr * 64 + fr), colp = (unsigned)((u.pn & 3) * BM + wc * 32 + 8 * fq);
        const PG8_LAS float* rsp = tab + ui * 256 + wr * 64 + fr;
        float rsv[2][4];
#pragma unroll
        for (int ai = 0; ai < 2; ++ai)
#pragma unroll
            for (int m = 0; m < 4; ++m) rsv[ai][m] = rsp[ai * HALF + m * 16];
#pragma unroll
        for (int ai = 0; ai < 2; ++ai)
#pragma unroll
            for (int m = 0; m < 4; ++m) {
                const unsigned row = row0 + ai * HALF + m * 16; const float rs = rsv[ai][m];
#pragma unroll
                for (int bj = 0; bj < 2; ++bj) {
                    f32x4 y0 = acc[ai][bj][m][0] * rs, y1 = acc[ai][bj][m][1] * rs;
#pragma unroll
                    for (int e = 0; e < 4; ++e) { const float a = fmaxf(y0[e], 0.f), b = fmaxf(y1[e], 0.f); y0[e] = a * a; y1[e] = b * b; }
                    const u32x4 hw = PG8_PACK8(y0, y1);
#ifdef PROBE_EPI_UP
                    if (probe_mode == 1) { asm volatile("" :: "v"(hw)); } else
#endif
                    *(PG8_GAS u32x4*)((PG8_GAS unsigned char*)ws + E_QKVO + (size_t)((unsigned)(u.pm >> 4) * (24u << 20) + (unsigned)(u.pn >> 2) * (8u << 20) + row * 2048u + (colp + bj * HALF) * 2u)) = hw;
                }
            }
    }
};

template <class Epi, class Sched, bool ALIGN_EPI = false, bool SP2 = false>
__device__ __forceinline__ void gemm_phase(PG8_LAS unsigned char* lds, const Gemm g, const Sched& S, const Epi& E, const int tid) {
    const int wid = __builtin_amdgcn_readfirstlane(tid >> 6), lane = tid & 63, wr = wid >> 2, wc = wid & 3, fr = lane & 15, fq = lane >> 4;
    const int K = g.K, nt = K / BK;
    unsigned voffA[2], voffB[2];
#pragma unroll
    for (int i = 0; i < 2; ++i) { int R, C; stage_rc(tid * 16 + i * 8192, R, C); const int Rb = Epi::PERM ? ((R & ~31) + perm32(R & 31)) : R;
        voffA[i] = (unsigned)(R * g.lda + C) * 2u; voffB[i] = (unsigned)(Rb * K + C) * 2u; }
    const size_t kstep = (size_t)(BK * 2);
    const size_t hstep = (size_t)HALF * K * 2;
    const size_t tstep = 2 * hstep;
    const size_t hstepA = (size_t)HALF * g.lda * 2, tstepA = 2 * hstepA; const long padj = g.padj;
#define PG8_KOFFA(tt) ((size_t)(tt) * kstep + (size_t)((tt) >> 4) * (size_t)padj)
    const unsigned ldsw = (unsigned)wid * 1024u;
    const int aoff = lds_byte(wr * 64 + fr, fq * 8), boff = lds_byte(wc * 32 + fr, fq * 8);
#define PG8_SA(b, h) (((b) * 2 + (h)) * HTB)
#define PG8_SB(b, h) ((4 + (b) * 2 + (h)) * HTB)
#define PG8_STAGE(bufoff, gbase, voff) do { _Pragma("unroll") for (int _i = 0; _i < 2; ++_i) \
        __builtin_amdgcn_global_load_lds((const unsigned*)((const char*)(gbase) + (voff)[_i]), (PG8_LAS unsigned*)(lds + (bufoff) + ldsw + _i * 8192), 16, 0, 0); } while (0)
#define PG8_LDA(dst, b, h) do { _Pragma("unroll") for (int m = 0; m < 4; ++m) _Pragma("unroll") for (int k = 0; k < 2; ++k) dst[m][k] = *(const PG8_LAS bf16x8*)(lds + PG8_SA(b, h) + aoff + m * 2048 + k * 1024); } while (0)
#define PG8_LDB(dst, b, h) do { _Pragma("unroll") for (int n = 0; n < 2; ++n) _Pragma("unroll") for (int k = 0; k < 2; ++k) dst[n][k] = *(const PG8_LAS bf16x8*)(lds + PG8_SB(b, h) + boff + n * 2048 + k * 1024); } while (0)
#define PG8_MMA(ai, bj, At, Bt) do { __builtin_amdgcn_s_setprio(1); _Pragma("unroll") for (int m = 0; m < 4; ++m) _Pragma("unroll") for (int n = 0; n < 2; ++n) _Pragma("unroll") for (int k = 0; k < 2; ++k) \
        acc[ai][bj][m][n] = __builtin_amdgcn_mfma_f32_16x16x32_bf16(Bt[n][k], At[m][k], acc[ai][bj][m][n], 0, 0, 0); __builtin_amdgcn_s_setprio(0); } while (0)
#define PG8_WAIT_V(n) asm volatile("s_waitcnt vmcnt(" #n ")" ::: "memory")
#define PG8_WAIT_L(n) asm volatile("s_waitcnt lgkmcnt(" #n ")" ::: "memory")
#define PG8_BAR __builtin_amdgcn_s_barrier()
#define PG8_SCHED __builtin_amdgcn_sched_barrier(0)
    Unit cur, nxt; int ui = 0;
    if (!S.next(0, cur)) return;
    f32x4 acc[2][2][4][2];
#pragma unroll
    for (int a = 0; a < 2; ++a)
#pragma unroll
        for (int b = 0; b < 2; ++b)
#pragma unroll
            for (int m = 0; m < 4; ++m)
#pragma unroll
                for (int n = 0; n < 2; ++n) acc[a][b][m][n] = (f32x4){0.f, 0.f, 0.f, 0.f};
    bf16x8 At[4][2], B0[2][2], B1[2][2];
    const char* cA = (const char*)g.A + (size_t)cur.pm * tstepA; const char* cB = (const char*)g.Bt + (size_t)cur.pn * tstep;
    S.a_ready(cur);
    if constexpr (SP2) {
        PG8_STAGE(PG8_SB(0, 0), cB, voffB); PG8_STAGE(PG8_SB(0, 1), cB + hstep, voffB); PG8_STAGE(PG8_SA(0, 0), cA, voffA); PG8_STAGE(PG8_SA(0, 1), cA + hstepA, voffA);
        if (wr == 1) PG8_BAR;
        PG8_WAIT_V(2); PG8_BAR;
        PG8_STAGE(PG8_SB(1, 0), cB + kstep, voffB); PG8_STAGE(PG8_SA(1, 0), cA + kstep, voffA); PG8_STAGE(PG8_SB(1, 1), cB + hstep + kstep, voffB);
        PG8_WAIT_V(6); PG8_BAR;
    } else {
        PG8_STAGE(PG8_SB(0, 0), cB, voffB); PG8_STAGE(PG8_SA(0, 0), cA, voffA); PG8_STAGE(PG8_SB(0, 1), cB + hstep, voffB); PG8_STAGE(PG8_SA(0, 1), cA + hstepA, voffA);
        if (wr == 1) PG8_BAR;
        PG8_WAIT_V(4); PG8_BAR;
        PG8_STAGE(PG8_SB(1, 0), cB + kstep, voffB); PG8_STAGE(PG8_SA(1, 0), cA + kstep, voffA); PG8_STAGE(PG8_SB(1, 1), cB + hstep + kstep, voffB);
        PG8_WAIT_V(6); PG8_BAR;
    }
    for (;;) {
        const bool has_next = S.next(ui + 1, nxt);
        const char* nA = has_next ? (const char*)g.A + (size_t)nxt.pm * tstepA : cA; const char* nB = has_next ? (const char*)g.Bt + (size_t)nxt.pn * tstep : cB;
        for (int t = 0; t < nt; t += 2) {
            const bool last = (t == nt - 2);
            const char* a1 = cA + PG8_KOFFA(t + 1);
            const char* a2 = last ? nA : cA + PG8_KOFFA(t + 2); const char* b2 = last ? nB : cB + (size_t)(t + 2) * kstep;
            const char* a3 = a2 + kstep; const char* b3 = b2 + kstep;
            if (last && has_next) S.a_ready(nxt);
            if constexpr (SP2) {
            PG8_LDB(B0, 0, 0); PG8_LDB(B1, 0, 1); PG8_SCHED; PG8_LDA(At, 0, 0); PG8_STAGE(PG8_SA(1, 1), a1 + hstepA, voffA);
            PG8_WAIT_V(8); PG8_WAIT_L(0); PG8_BAR; PG8_MMA(0, 0, At, B0); PG8_MMA(0, 1, At, B1); PG8_BAR; PG8_SCHED;
            PG8_LDA(At, 0, 1); PG8_STAGE(PG8_SB(0, 0), b2, voffB); PG8_STAGE(PG8_SB(0, 1), b2 + hstep, voffB); PG8_STAGE(PG8_SA(0, 0), a2, voffA);
            PG8_WAIT_V(8); PG8_WAIT_L(0); PG8_BAR; PG8_MMA(1, 0, At, B0); PG8_MMA(1, 1, At, B1); PG8_BAR; PG8_SCHED;
            PG8_LDB(B0, 1, 0); PG8_LDB(B1, 1, 1); PG8_SCHED; PG8_LDA(At, 1, 0); PG8_STAGE(PG8_SA(0, 1), a2 + hstepA, voffA);
            PG8_WAIT_V(8); PG8_WAIT_L(0); PG8_BAR; PG8_MMA(0, 0, At, B0); PG8_MMA(0, 1, At, B1); PG8_BAR; PG8_SCHED;
            PG8_LDA(At, 1, 1); PG8_STAGE(PG8_SB(1, 0), b3, voffB); PG8_STAGE(PG8_SB(1, 1), b3 + hstep, voffB); PG8_STAGE(PG8_SA(1, 0), a3, voffA);
            PG8_WAIT_V(8); PG8_WAIT_L(0); PG8_BAR; PG8_MMA(1, 0, At, B0); PG8_MMA(1, 1, At, B1); PG8_BAR; PG8_SCHED;
            } else {
            PG8_LDB(B0, 0, 0); PG8_SCHED; PG8_LDA(At, 0, 0); PG8_STAGE(PG8_SA(1, 1), a1 + hstepA, voffA);
            PG8_WAIT_L(8); PG8_BAR; PG8_WAIT_L(0); PG8_MMA(0, 0, At, B0); PG8_BAR; PG8_SCHED;
            PG8_LDB(B1, 0, 1); PG8_STAGE(PG8_SB(0, 0), b2, voffB);
            PG8_BAR; PG8_WAIT_L(0); PG8_MMA(0, 1, At, B1); PG8_BAR;
            PG8_LDA(At, 0, 1); PG8_STAGE(PG8_SA(0, 0), a2, voffA);
            PG8_BAR; PG8_WAIT_L(0); PG8_MMA(1, 0, At, B0); PG8_BAR; PG8_SCHED;
            PG8_STAGE(PG8_SB(0, 1), b2 + hstep, voffB);
            PG8_WAIT_V(6); PG8_BAR; PG8_MMA(1, 1, At, B1); PG8_BAR;
            PG8_LDB(B0, 1, 0); PG8_SCHED; PG8_LDA(At, 1, 0); PG8_STAGE(PG8_SA(0, 1), a2 + hstepA, voffA);
            PG8_WAIT_L(8); PG8_BAR; PG8_WAIT_L(0); PG8_MMA(0, 0, At, B0); PG8_BAR; PG8_SCHED;
            PG8_LDB(B1, 1, 1); PG8_STAGE(PG8_SB(1, 0), b3, voffB);
            PG8_BAR; PG8_WAIT_L(0); PG8_MMA(0, 1, At, B1); PG8_BAR;
            PG8_LDA(At, 1, 1); PG8_STAGE(PG8_SA(1, 0), a3, voffA);
            PG8_BAR; PG8_WAIT_L(0); PG8_MMA(1, 0, At, B0); PG8_BAR; PG8_SCHED;
            PG8_STAGE(PG8_SB(1, 1), b3 + hstep, voffB);
            PG8_WAIT_V(6); PG8_BAR; PG8_MMA(1, 1, At, B1); PG8_BAR;
            }
        }
        if constexpr (ALIGN_EPI) { if (wr == 0) PG8_BAR; }
        if constexpr (!Epi::AFTER_DRAIN) { E(acc, cur, ui, wr, wc, fr, fq); S.done(cur); }
        if (!has_next) break;
#pragma unroll
        for (int a = 0; a < 2; ++a)
#pragma unroll
            for (int b = 0; b < 2; ++b)
#pragma unroll
                for (int m = 0; m < 4; ++m)
#pragma unroll
                    for (int n = 0; n < 2; ++n) acc[a][b][m][n] = (f32x4){0.f, 0.f, 0.f, 0.f};
        cur = nxt; cA = nA; cB = nB; ++ui;
        if constexpr (ALIGN_EPI) { if (wr == 1) PG8_BAR; }
    }
    PG8_WAIT_V(0);
    if constexpr (!ALIGN_EPI) { if (wr == 0) PG8_BAR; }
    PG8_BAR;
    if constexpr (Epi::AFTER_DRAIN) { E.fused(acc, cur, wr, wc, fr, fq, lds, wid, lane); S.done(cur); }
#undef PG8_SA
#undef PG8_KOFFA
#undef PG8_SB
#undef PG8_STAGE
#undef PG8_LDA
#undef PG8_LDB
#undef PG8_MMA
#undef PG8_WAIT_V
#undef PG8_WAIT_L
#undef PG8_BAR
#undef PG8_SCHED
}
}

constexpr int NWAVES = 8;
constexpr int BATCH = 8, SEQ = 4096, DM = 1024, NHEAD = 16, FF = 4096, DEPTH = 2;
constexpr int M = BATCH * SEQ;
constexpr int NIN = 3462, NINP = 3584;
constexpr float EPS = 1e-6f, LOG2E = 1.4426950408889634f;
#ifndef MK_ONE_LAUNCH
#define MK_ONE_LAUNCH 1
#endif
constexpr int NPH = 1 + 6 * DEPTH;

constexpr size_t MiB = 1u << 20;
constexpr size_t WS_CTL = 0, CTL_ZERO_BYTES = 1 * MiB;
constexpr size_t WS_W = 2 * MiB, W_LAYER = 25 * MiB, W_IN = 0, W_OUT = 7 * MiB, W_UP = 9 * MiB, W_DOWN = 17 * MiB;
constexpr size_t WS_SSQ = 52 * MiB;
constexpr size_t WS_LS = 54 * MiB;
constexpr size_t WS_KMP = 55 * MiB;
constexpr size_t WS_XB = 64 * MiB;
constexpr size_t WS_QKVO = 128 * MiB;
constexpr size_t QKVO_BATCH_ADJ = 24 * MiB;
constexpr size_t QKVO_K = 8 * MiB, QKVO_V = 16 * MiB, QKVO_O = 24 * MiB;
constexpr size_t WS_H = 128 * MiB;
constexpr size_t WS_GF = 384 * MiB;
constexpr size_t WS_LD = 56 * MiB;
constexpr size_t WS_OD = 408 * MiB;
constexpr size_t WS_END = 480 * MiB;
constexpr int CW_BAR = 4096, CW_GBAR = 8192, CW_XCC = 12288, CW_QBAR = 16384;

constexpr int RING_OFF = 0, RING_BYTES = 131072;
constexpr int LDSCTL_OFF = RING_BYTES, MISC_OFF = LDSCTL_OFF + 320;
constexpr int LDS_BYTES = 147456;

#define GAS __attribute__((address_space(1)))
#define LAS __attribute__((address_space(3)))
typedef unsigned short bf16;
typedef unsigned v4u __attribute__((ext_vector_type(4)));
typedef float f32x4 __attribute__((ext_vector_type(4)));
typedef GAS unsigned gu32;
#define RLX_AGENT __ATOMIC_RELAXED, __HIP_MEMORY_SCOPE_AGENT
#define LDS_WAIT() asm volatile("s_waitcnt lgkmcnt(0)" ::: "memory")
#define VM_WAIT() asm volatile("s_waitcnt vmcnt(0)" ::: "memory")
__device__ __forceinline__ unsigned f2bf(float f) { unsigned u = __builtin_bit_cast(unsigned, f); return (u + 0x7fffu + ((u >> 16) & 1u)) >> 16; }
__device__ __forceinline__ unsigned pk2(float lo, float hi) { return f2bf(lo) | (f2bf(hi) << 16); }
__device__ __forceinline__ float bflo(unsigned w) { return __builtin_bit_cast(float, w << 16); }
__device__ __forceinline__ float bfhi(unsigned w) { return __builtin_bit_cast(float, w & 0xffff0000u); }
#define XB_TMO      128
#define XB_XCNT(j)  (256  + 64 * (j))
#define XB_XSUB(j)  (1280 + 64 * (j))
#define XB_XGEN(j)  (2304 + 64 * (j))
#define XB_TOP      3328
#define XB_TOPGEN   3392
#define XCD_BAR_WORDS 3456
#define XB_SPIN_CAP (1u << 18)

__device__ __forceinline__ unsigned xb_ld(unsigned* p)              { return __hip_atomic_load(p, __ATOMIC_RELAXED, __HIP_MEMORY_SCOPE_AGENT); }
__device__ __forceinline__ unsigned xb_add(unsigned* p, unsigned v) { return __hip_atomic_fetch_add(p, v, __ATOMIC_RELAXED, __HIP_MEMORY_SCOPE_AGENT); }
__device__ __forceinline__ unsigned xb_xcc_id() { return (unsigned)__builtin_amdgcn_s_getreg((3 << 11) | 20) & 0xFu; }
#define XB_SPIN(cond, bar) do { unsigned _sp = 0; while (cond) { __builtin_amdgcn_s_sleep(1); \
    if ((++_sp & 255u) == 0u) { if (xb_ld(&(bar)[XB_TMO])) break; if (_sp > XB_SPIN_CAP) { atomicAdd(&(bar)[XB_TMO], 1u); break; } } } } while (0)

struct XcdBarrier {
    unsigned* bar; unsigned x;
    volatile LAS unsigned* st;
};

__device__ __forceinline__ XcdBarrier xcd_barrier_post(unsigned* bar, volatile LAS unsigned* st) {
    XcdBarrier b; b.bar = bar; b.x = xb_xcc_id(); b.st = st;
    if (threadIdx.x == 0) (void)xb_add(&bar[XB_XCNT(b.x)], 1u);
    return b;
}
__device__ __forceinline__ void xcd_barrier_complete(unsigned* bar, unsigned x, unsigned& nloc, unsigned& nx) {
    const unsigned G = gridDim.x * gridDim.y * gridDim.z;
    unsigned sum, cnt, mine, sp = 0u;
    for (;;) {
        sum = 0u; cnt = 0u; mine = 0u;
#pragma unroll
        for (unsigned j = 0; j < 16; ++j) { const unsigned c = xb_ld(&bar[XB_XCNT(j)]); sum += c; cnt += (c > 0u) ? 1u : 0u; mine = (j == x) ? c : mine; }
        if (sum == G) break;
        __builtin_amdgcn_s_sleep(1);
        if ((++sp & 255u) == 0u) { if (xb_ld(&bar[XB_TMO])) break; if (sp > XB_SPIN_CAP) { atomicAdd(&bar[XB_TMO], 1u); break; } }
    }
    nloc = mine > 0u ? mine : 1u; nx = cnt > 0u ? cnt : 1u;
}

__device__ __forceinline__ void xcd_barrier(const XcdBarrier& b, const int tid_x) {
    asm volatile("s_waitcnt vmcnt(0)" ::: "memory");
    __syncthreads();
    if (tid_x == 0) {
        unsigned* bar = b.bar;
        __builtin_amdgcn_s_waitcnt(0);
        unsigned nloc = b.st[0], nx = b.st[1];
        if (nloc == 0u) { xcd_barrier_complete(bar, b.x, nloc, nx); b.st[0] = nloc; b.st[1] = nx; }
        const unsigned old = xb_add(&bar[XB_XSUB(b.x)], 1u);
        const unsigned gen = old / nloc;
        if (old + 1u == (gen + 1u) * nloc) {
            __builtin_amdgcn_fence(__ATOMIC_RELEASE, "agent");
            asm volatile("s_waitcnt vmcnt(0)" ::: "memory");
            const unsigned og = xb_add(&bar[XB_TOP], 1u);
            const unsigned tg = og / nx;
            if (og + 1u == (tg + 1u) * nx) xb_add(&bar[XB_TOPGEN], 1u);
            else XB_SPIN(xb_ld(&bar[XB_TOPGEN]) == tg, bar);
            __builtin_amdgcn_fence(__ATOMIC_ACQUIRE, "agent");
            xb_add(&bar[XB_XGEN(b.x)], 1u);
            asm volatile("s_waitcnt vmcnt(0)" ::: "memory");
        } else {
            XB_SPIN(xb_ld(&bar[XB_XGEN(b.x)]) == gen, bar);
            __builtin_amdgcn_fence(__ATOMIC_ACQUIRE, "agent");
            asm volatile("s_waitcnt vmcnt(0)" ::: "memory");
        }
    }
    __syncthreads();
}

namespace att {
typedef unsigned short bf16;
using bf16x8 = __attribute__((ext_vector_type(8))) short;
using s16x4 = __attribute__((ext_vector_type(4))) short;
using f32x16 = __attribute__((ext_vector_type(16))) float;
using f32x4 = __attribute__((ext_vector_type(4))) float;
using u32x4 = __attribute__((ext_vector_type(4))) unsigned;
typedef __attribute__((address_space(3))) const char* lds_cptr;
typedef __attribute__((address_space(3))) float* lds_fptr;
typedef short v4i16_t __attribute__((ext_vector_type(4)));
constexpr int SLOTB = 8192, LDS_K = 0, LDS_V = 3 * SLOTB, LDS_WS = 6 * SLOTB, LDS_OST = LDS_WS + 8 * 256, LDS_X = LDS_OST + 8 * 4096, LDS_X2 = LDS_X + 16384, LDS_END = LDS_X2 + 1024;
constexpr int DMP = 1024;
#define ATT_WAIT_BAR(N) asm volatile("s_waitcnt vmcnt(" #N ") lgkmcnt(0)\n\ts_barrier" ::: "memory")
#define ATT_WAIT_BAR_L() asm volatile("s_waitcnt lgkmcnt(0)\n\ts_barrier" ::: "memory")
__device__ __forceinline__ void glds16(const void* gsrc, unsigned lds_dst) { unsigned keep;
    asm volatile("s_mov_b32 %0, m0\n\ts_mov_b32 m0, %2\n\ts_nop 0\n\tglobal_load_lds_dwordx4 %1, off\n\ts_mov_b32 m0, %0" : "=&s"(keep) : "v"(gsrc), "s"(lds_dst) : "memory"); }
typedef float f32x2_t __attribute__((ext_vector_type(2))); typedef __bf16 bf16x2_t __attribute__((ext_vector_type(2)));
__device__ __forceinline__ unsigned cvtpk(float lo, float hi) { f32x2_t v = {lo, hi}; bf16x2_t b = __builtin_convertvector(v, bf16x2_t); return __builtin_bit_cast(unsigned, b); }
__device__ __forceinline__ s16x4 vtr(lds_cptr p) { return __builtin_bit_cast(s16x4, __builtin_amdgcn_ds_read_tr16_b64_v4i16((__attribute__((address_space(3))) v4i16_t*)p)); }
__device__ __forceinline__ int crow(int r, int hi) { return (r & 3) + 8 * (r >> 2) + 4 * hi; }
#define ATT_NEG (-INFINITY)
#define ATT_SBAR() __builtin_amdgcn_sched_barrier(0)

struct UnitIO {
    const bf16* Q; long qstride;
    const bf16* K0; const bf16* V0; long kstride;
    bf16* O; long ostride;
    float* L; long lstride;
    bool norm;
};
struct BiasMoba {
    float slope2, tqf; int qrel, hi, w, nb0, u; unsigned selmask;
    __device__ __forceinline__ bool active(int t) const { return t < nb0 || (t - nb0) <= (w >> 1); }
    __device__ __forceinline__ void init(f32x16& c0, f32x16& c1, int t) const {
        float base = slope2 * ((float)(64 * t + 4 * hi) - tqf);
        if (t < nb0) { if (!((selmask >> (t >> 2)) & 1u)) base = ATT_NEG; }
        const float d32 = 32.0f * slope2;
#pragma unroll
        for (int i = 0; i < 8; ++i) { const int r = 2 * i; const f32x2_t kc = (f32x2_t){slope2 * (float)((r & 3) + 8 * (r >> 2)), slope2 * (float)(((r + 1) & 3) + 8 * ((r + 1) >> 2))};
            const f32x2_t p = kc + base, q = p + d32; c0[r] = p[0]; c0[r + 1] = p[1]; c1[r] = q[0]; c1[r + 1] = q[1]; }
        if (t - nb0 == (w >> 1)) {
#pragma unroll
            for (int r = 0; r < 16; ++r) { const int ko = (r & 3) + 8 * (r >> 2); if (ko > u) c0[r] = ATT_NEG; if (ko > u - 32) c1[r] = ATT_NEG; }
        }
    }
};
struct BiasFox {
    lds_fptr cs2; float base; int qrel, hi, w, nb0, u;
    __device__ __forceinline__ bool active(int t) const { return t < nb0 || (t - nb0) <= (w >> 1); }
    __device__ __forceinline__ void init(f32x16& c0, f32x16& c1, int t) const {
        const lds_fptr p = cs2 + 64 * t + 4 * hi;
        f32x4 a[4], b[4];
#pragma unroll
        for (int g = 0; g < 4; ++g) { a[g] = *(const __attribute__((address_space(3))) f32x4*)(p + 8 * g); b[g] = *(const __attribute__((address_space(3))) f32x4*)(p + 32 + 8 * g); }
        asm volatile("" : "+v"(a[0]), "+v"(a[1]), "+v"(a[2]), "+v"(a[3]), "+v"(b[0]), "+v"(b[1]), "+v"(b[2]), "+v"(b[3]));
#pragma unroll
        for (int g = 0; g < 4; ++g) { const f32x2_t a0 = (f32x2_t){a[g][0], a[g][1]}, a1 = (f32x2_t){a[g][2], a[g][3]}, b0 = (f32x2_t){b[g][0], b[g][1]}, b1 = (f32x2_t){b[g][2], b[g][3]};
            const f32x2_t x0 = base - a0, x1 = base - a1, y0 = base - b0, y1 = base - b1;
            c0[4 * g] = x0[0]; c0[4 * g + 1] = x0[1]; c0[4 * g + 2] = x1[0]; c0[4 * g + 3] = x1[1]; c1[4 * g] = y0[0]; c1[4 * g + 1] = y0[1]; c1[4 * g + 2] = y1[0]; c1[4 * g + 3] = y1[1]; }
        if (t - nb0 == (w >> 1)) {
#pragma unroll
            for (int r = 0; r < 16; ++r) { const int ko = (r & 3) + 8 * (r >> 2); if (ko > u) c0[r] = ATT_NEG; if (ko > u - 32) c1[r] = ATT_NEG; }
        }
    }
};
struct BiasDil {
    float sd; int qrel, hi, w; f32x2_t kc[8]; float basel, d32, d64; int u;
    __device__ __forceinline__ void setup(int r32) { u = 32 * (w & 1) + r32 - 4 * hi; basel = -sd * (float)(128 + u); d32 = 32.0f * sd; d64 = 64.0f * sd;
#pragma unroll
        for (int i = 0; i < 8; ++i) { const int r = 2 * i; kc[i] = (f32x2_t){sd * (float)((r & 3) + 8 * (r >> 2)), sd * (float)(((r + 1) & 3) + 8 * ((r + 1) >> 2))}; } }
    __device__ __forceinline__ bool active(int t) const { return t >= (w >> 1) && t <= (w >> 1) + 2; }
    __device__ __forceinline__ void init(f32x16& c0, f32x16& c1, int t) const {
        const int dt = t - (w >> 1);
        const float base = basel + (float)dt * d64;
#pragma unroll
        for (int i = 0; i < 8; ++i) { const f32x2_t p = kc[i] + base, q = p + d32; c0[2 * i] = p[0]; c0[2 * i + 1] = p[1]; c1[2 * i] = q[0]; c1[2 * i + 1] = q[1]; }
        if (dt == 0) {
#pragma unroll
            for (int r = 0; r < 16; ++r) { const int ko = (r & 3) + 8 * (r >> 2); if (ko < u) c0[r] = ATT_NEG; if (ko < u - 32) c1[r] = ATT_NEG; }
        } else if (dt == 2) {
#pragma unroll
            for (int r = 0; r < 16; ++r) { const int ko = (r & 3) + 8 * (r >> 2); if (ko > u) c0[r] = ATT_NEG; if (ko > u - 32) c1[r] = ATT_NEG; }
        }
    }
};

template <class BIAS>
__device__ __forceinline__ void attn_tiles(char* shm, const UnitIO& io, int t_begin, int t_end, const BIAS& B, int tid) {
    const int lane = tid & 63, r32 = lane & 31, hi = lane >> 5; const int wid = __builtin_amdgcn_readfirstlane(tid >> 6);
    const unsigned lds0 = (unsigned)(uintptr_t)shm;
    const bf16* ksrc = io.K0 + (long)lane * io.kstride + wid * 8;
    const bf16* vsrc = io.V0 + (long)(16 * (wid & 3) + (lane >> 2)) * io.kstride + (wid >> 2) * 32 + (lane & 3) * 8;
    const unsigned kdst = lds0 + LDS_K + wid * 1024, vdst = lds0 + LDS_V + wid * 1024;
    const long tstep = 64 * io.kstride;
#define ATT_DMA(t, slot) do { glds16(ksrc + (long)(t) * tstep, (unsigned)__builtin_amdgcn_readfirstlane(kdst + (slot))); glds16(vsrc + (long)(t) * tstep, (unsigned)__builtin_amdgcn_readfirstlane(vdst + (slot))); } while (0)
    const lds_cptr shm3 = (lds_cptr)shm;
    const lds_cptr kp0 = shm3 + LDS_K + hi * 1024 + r32 * 16;
    const lds_cptr vp0 = shm3 + LDS_V + ((lane >> 4) & 1) * 32 + (lane & 3) * 8 + (4 * hi + ((lane & 15) >> 2)) * 64;
    float* wsf = (float*)(shm + LDS_WS) + wid * 64;
    bf16x8 qr[4];
    { const bf16* qp = io.Q + (long)r32 * io.qstride + hi * 8;
#pragma unroll
      for (int d0 = 0; d0 < 4; ++d0) qr[d0] = *reinterpret_cast<const bf16x8*>(qp + d0 * 16); }
    ATT_DMA(t_begin, 0);
    asm volatile("" :: "v"(qr[0]), "v"(qr[1]), "v"(qr[2]), "v"(qr[3]));
    const bool two = (t_begin + 1 < t_end); if (two) ATT_DMA(t_begin + 1, SLOTB);
    f32x16 o[2]; o[0] = f32x16{}; o[1] = f32x16{}; float l_reg = 0.f;
    if (two) ATT_WAIT_BAR(2); else ATT_WAIT_BAR(0);
    int sl_c = 0, sl_n = SLOTB, sl_nn = 2 * SLOTB;
#pragma unroll 1
    for (int t = t_begin; t < t_end; ++t) {
        const bool more = (t + 2 < t_end);
        const bool act = B.active(t);
        if (more) ATT_DMA(t + 2, sl_nn);
        u32x4 pw[4]; f32x16 c1x;
        if (act) {
            bf16x8 kf[8]; const lds_cptr kp = kp0 + sl_c;
#pragma unroll
            for (int j = 0; j < 4; ++j) { kf[2 * j] = *(const __attribute__((address_space(3))) bf16x8*)(kp + j * 2048); kf[2 * j + 1] = *(const __attribute__((address_space(3))) bf16x8*)(kp + j * 2048 + 512); }
            ATT_SBAR();
            f32x16 c0, c1; B.init(c0, c1, t);
            ATT_SBAR();
            asm volatile("" : "+v"(kf[0]), "+v"(kf[1]), "+v"(kf[2]), "+v"(kf[3]), "+v"(kf[4]), "+v"(kf[5]), "+v"(kf[6]), "+v"(kf[7]));
#pragma unroll
            for (int d0 = 0; d0 < 4; ++d0) { c0 = __builtin_amdgcn_mfma_f32_32x32x16_bf16(kf[2 * d0], qr[d0], c0, 0, 0, 0); c1 = __builtin_amdgcn_mfma_f32_32x32x16_bf16(kf[2 * d0 + 1], qr[d0], c1, 0, 0, 0); }
            float s0 = 0.f;
#pragma unroll
            for (int r = 0; r < 16; ++r) c0[r] = __builtin_amdgcn_exp2f(c0[r]);
            { f32x2_t s2 = (f32x2_t){c0[0], c0[1]};
#pragma unroll
              for (int i = 1; i < 8; ++i) s2 += (f32x2_t){c0[2 * i], c0[2 * i + 1]};
              s0 = s2[0] + s2[1]; }
            l_reg += s0;
#pragma unroll
            for (int i = 0; i < 4; ++i) { pw[0][i] = cvtpk(c0[2 * i], c0[2 * i + 1]); pw[1][i] = cvtpk(c0[8 + 2 * i], c0[9 + 2 * i]); }
            c1x = c1;
        }

        if (act) {
            const lds_cptr vp = vp0 + sl_c;
            s16x4 vlo[8], vhi[8];
#pragma unroll
            for (int i = 0; i < 8; ++i) { vlo[i] = vtr(vp + (i >> 2) * 4096 + (i & 3) * 1024); vhi[i] = vtr(vp + (i >> 2) * 4096 + (i & 3) * 1024 + 512); }
            ATT_SBAR();
            { float s1 = 0.f;
#pragma unroll
              for (int r = 0; r < 16; ++r) c1x[r] = __builtin_amdgcn_exp2f(c1x[r]);
              { f32x2_t s2 = (f32x2_t){c1x[0], c1x[1]};
#pragma unroll
                for (int i = 1; i < 8; ++i) s2 += (f32x2_t){c1x[2 * i], c1x[2 * i + 1]};
                s1 = s2[0] + s2[1]; }
              l_reg += s1;
#pragma unroll
              for (int i = 0; i < 4; ++i) { pw[2][i] = cvtpk(c1x[2 * i], c1x[2 * i + 1]); pw[3][i] = cvtpk(c1x[8 + 2 * i], c1x[9 + 2 * i]); } }
            ATT_SBAR();
            asm volatile("" : "+v"(vlo[0]), "+v"(vhi[0]), "+v"(vlo[1]), "+v"(vhi[1]), "+v"(vlo[2]), "+v"(vhi[2]), "+v"(vlo[3]), "+v"(vhi[3]));
#pragma unroll
            for (int ks = 0; ks < 4; ++ks) { const bf16x8 vf = (bf16x8){vlo[ks][0], vlo[ks][1], vlo[ks][2], vlo[ks][3], vhi[ks][0], vhi[ks][1], vhi[ks][2], vhi[ks][3]};
                o[0] = __builtin_amdgcn_mfma_f32_32x32x16_bf16(__builtin_bit_cast(bf16x8, pw[ks]), vf, o[0], 0, 0, 0); }
            ATT_SBAR();
            asm volatile("" : "+v"(vlo[4]), "+v"(vhi[4]), "+v"(vlo[5]), "+v"(vhi[5]), "+v"(vlo[6]), "+v"(vhi[6]), "+v"(vlo[7]), "+v"(vhi[7]));
#pragma unroll
            for (int ks = 0; ks < 4; ++ks) { const bf16x8 vf = (bf16x8){vlo[4 + ks][0], vlo[4 + ks][1], vlo[4 + ks][2], vlo[4 + ks][3], vhi[4 + ks][0], vhi[4 + ks][1], vhi[4 + ks][2], vhi[4 + ks][3]};
                o[1] = __builtin_amdgcn_mfma_f32_32x32x16_bf16(__builtin_bit_cast(bf16x8, pw[ks]), vf, o[1], 0, 0, 0); }
        }
        if (more) ATT_WAIT_BAR(2); else ATT_WAIT_BAR(0);
        const int tmp = sl_c; sl_c = sl_n; sl_n = sl_nn; sl_nn = tmp;
    }
#undef ATT_DMA
    { auto rr = __builtin_amdgcn_permlane32_swap(__float_as_uint(l_reg), __float_as_uint(l_reg), false, false); l_reg = __uint_as_float(rr[0]) + __uint_as_float(rr[1]); }
    if (hi == 0) wsf[32 + r32] = l_reg;
    asm volatile("s_waitcnt lgkmcnt(0)" ::: "memory");
    float rli[16];
#pragma unroll
    for (int r = 0; r < 16; ++r) rli[r] = io.norm ? __builtin_amdgcn_rcpf(wsf[32 + crow(r, hi)]) : 1.0f;
    if (!io.norm && hi == 0) io.L[(long)r32 * io.lstride] = l_reg;
    { bf16* stg = (bf16*)(shm + LDS_OST) + wid * 2048;
#pragma unroll
      for (int r = 0; r < 16; ++r) { const int orow = crow(r, hi);
#pragma unroll
          for (int d0 = 0; d0 < 2; ++d0) stg[orow * 64 + d0 * 32 + r32] = (bf16)(cvtpk(o[d0][r] * rli[r], 0.f) & 0xffffu); }
      asm volatile("s_waitcnt lgkmcnt(0)" ::: "memory");
#pragma unroll
      for (int i = 0; i < 4; ++i) { const int row = i * 8 + (lane >> 3), ch = lane & 7; const u32x4 v = *(const u32x4*)(stg + row * 64 + ch * 8); *(u32x4*)(io.O + (long)row * io.ostride + ch * 8) = v; } }
    asm volatile("s_waitcnt lgkmcnt(0)" ::: "memory");
}
}


struct Frame {
    LAS unsigned char* lds;
    volatile LAS unsigned* MISC;
    gu32* ctl;
    int tid, lane, wave;
    int vcu, G;
};
struct Ptrs {
    const float *x, *attn_norm, *w_in, *b_forget, *q_gain, *k_gain, *out_gain, *w_out, *mlp_norm, *w_up, *w_down;
    float* out; unsigned char* ws;
};

__device__ __forceinline__ float wave_sum(float v) {
#pragma unroll
    for (int o = 1; o < 64; o <<= 1) v += __shfl_xor(v, o);
    return v;
}

__device__ __forceinline__ int win_src(int cp) {
    const int tile = cp >> 8, within = cp & 255;
    if (tile < 12) { const int bj = within >> 7, wc = (within >> 5) & 3, j = within & 31; return tile * 256 + 64 * wc + 32 * bj + j; }
    if (tile == 12) return 3078 + within;
    if (within < 128) return 3078 + 256 + within;
    if (within < 134) return 3072 + (within - 128);
    return -1;
}
template <int MODE>
__device__ __forceinline__ void transpose_item(const float* W, int K, int N, const float* gain, bf16* WT, LAS float* scr, int item, int nblk, int lane) {
    const int kb = item / nblk, nb = item % nblk, k0 = 64 * kb, n0 = 32 * nb;
    const int sc = (MODE == 0) ? win_src(n0 + (lane & 31)) : (n0 + (lane & 31));
    const GAS float* src = (const GAS float*)W + (size_t)(k0 + (lane >> 5)) * N + (sc >= 0 ? sc : 0);
    const float keep = sc >= 0 ? 1.f : 0.f;
    float v[32];
#pragma unroll
    for (int i = 0; i < 32; ++i) v[i] = __builtin_nontemporal_load(src + (size_t)(2 * i) * N);
    const int c = lane & 7;
    f32x4 g0 = (f32x4){1.f, 1.f, 1.f, 1.f}, g1 = g0;
    if (gain) { g0 = *(const GAS f32x4*)(gain + k0 + 8 * c); g1 = *(const GAS f32x4*)(gain + k0 + 8 * c + 4); }
#pragma unroll
    for (int i = 0; i < 32; ++i) scr[(2 * i + (lane >> 5)) * 33 + (lane & 31)] = v[i] * keep;
    LDS_WAIT(); asm volatile("" ::: "memory");
#pragma unroll
    for (int j = 0; j < 4; ++j) { const int n = (lane >> 3) + 8 * j; const LAS float* s = scr + (8 * c) * 33 + n;
        v4u o; o.x = pk2(s[0 * 33] * g0[0], s[1 * 33] * g0[1]); o.y = pk2(s[2 * 33] * g0[2], s[3 * 33] * g0[3]); o.z = pk2(s[4 * 33] * g1[0], s[5 * 33] * g1[1]); o.w = pk2(s[6 * 33] * g1[2], s[7 * 33] * g1[3]);
        *(GAS v4u*)(WT + (size_t)(n0 + n) * K + k0 + 8 * c) = o; }
    LDS_WAIT(); asm volatile("" ::: "memory");
}
__device__ __forceinline__ void p0_prologue(Frame& F, const Ptrs& P) {
    LAS float* scr = (LAS float*)(F.lds + RING_OFF + F.wave * 16384);
    const int gw = F.vcu * NWAVES + F.wave, NGW = F.G * NWAVES;
    constexpr int I_IN = (DM / 64) * (NINP / 32), I_OUT = (DM / 64) * (DM / 32), I_UP = (DM / 64) * (FF / 32), I_DN = (FF / 64) * (DM / 32);
    constexpr int I_LAYER = I_IN + I_OUT + I_UP + I_DN;
    for (int it = gw; it < DEPTH * I_LAYER; it += NGW) {
        const int l = it / I_LAYER; int r = it % I_LAYER;
        unsigned char* wl = P.ws + WS_W + (size_t)l * W_LAYER;
        if (r < I_IN) { transpose_item<0>(P.w_in + (size_t)l * DM * NIN, DM, NIN, P.attn_norm + l * DM, (bf16*)(wl + W_IN), scr, r, NINP / 32, F.lane); continue; } r -= I_IN;
        if (r < I_OUT) { transpose_item<1>(P.w_out + (size_t)l * DM * DM, DM, DM, P.out_gain + l * DM, (bf16*)(wl + W_OUT), scr, r, DM / 32, F.lane); continue; } r -= I_OUT;
        if (r < I_UP) { transpose_item<1>(P.w_up + (size_t)l * DM * FF, DM, FF, P.mlp_norm + l * DM, (bf16*)(wl + W_UP), scr, r, FF / 32, F.lane); continue; } r -= I_UP;
        transpose_item<1>(P.w_down + (size_t)l * FF * DM, FF, DM, nullptr, (bf16*)(wl + W_DOWN), scr, r, DM / 32, F.lane);
    }
    bf16* XB = (bf16*)(P.ws + WS_XB); float* SSQ = (float*)(P.ws + WS_SSQ);
#pragma unroll 1
    for (int m0 = gw; m0 < M; m0 += 4 * NGW) {
        f32x4 v[4][4]; float s[4];
#pragma unroll
        for (int q = 0; q < 4; ++q) { const int m = m0 + q * NGW; const GAS f32x4* xr = (const GAS f32x4*)(P.x + (size_t)(m < M ? m : m0) * DM) + F.lane;
#pragma unroll
            for (int j = 0; j < 4; ++j) v[q][j] = __builtin_nontemporal_load(xr + 64 * j); }
#pragma unroll
        for (int q = 0; q < 4; ++q) { float t = 0.f;
#pragma unroll
            for (int j = 0; j < 4; ++j) t += (v[q][j].x * v[q][j].x + v[q][j].y * v[q][j].y) + (v[q][j].z * v[q][j].z + v[q][j].w * v[q][j].w);
            s[q] = wave_sum(t); }
#pragma unroll
        for (int q = 0; q < 4; ++q) { const int m = m0 + q * NGW; if (m < M) {
            GAS unsigned long long* o8 = (GAS unsigned long long*)(XB + (size_t)m * DM) + F.lane;
#pragma unroll
            for (int j = 0; j < 4; ++j) o8[64 * j] = (unsigned long long)pk2(v[q][j].x, v[q][j].y) | ((unsigned long long)pk2(v[q][j].z, v[q][j].w) << 32);
            if (F.lane < 16) SSQ[(size_t)m * 16 + F.lane] = F.lane == 0 ? s[q] : 0.f; } }
    }
}

__device__ __forceinline__ void unpack8(const v4u w, float* f) { f[0] = bflo(w.x); f[1] = bfhi(w.x); f[2] = bflo(w.y); f[3] = bfhi(w.y); f[4] = bflo(w.z); f[5] = bfhi(w.z); f[6] = bflo(w.w); f[7] = bfhi(w.w); }


struct AttnBufs { const bf16 *Q, *K, *V; bf16* O;     bf16* OD; float* LD; const float* LS; const float* KMP; };
constexpr size_t OD_BRANCH = (size_t)M * 384, LD_BRANCH = (size_t)M * 8, BADJ = QKVO_BATCH_ADJ / 2;

__device__ __forceinline__ void moba_unit(Frame& F, const AttnBufs& A, int b, int h, int qb) {
    char* shm = (char*)F.lds; const int tid = F.tid, lane = tid & 63, r32 = lane & 31, hi = lane >> 5, w = F.wave;
    LAS float* KM = (LAS float*)(F.lds + att::LDS_X);
    for (int i = tid; i < 1024; i += 512) { const int j = i >> 6, d = i & 63; float v = 0.f;
        if (j < qb) { const float* p = A.KMP + ((size_t)((b * 16 + j) * 4 + h) * 2) * 64 + d; v = p[0] + p[64]; } KM[i] = v; }
    const size_t row0 = (size_t)b * SEQ + qb * 256 + w * 32;
    const size_t bo = (size_t)b * BADJ;
    const bf16* Qw = A.Q + bo + row0 * DM + h * 64;
    float qf[32];
    { const bf16* qp = Qw + (size_t)r32 * DM + hi * 8;
#pragma unroll
      for (int d0 = 0; d0 < 4; ++d0) { const v4u wv = *(const v4u*)(qp + d0 * 16); unpack8(wv, qf + 8 * d0); } }
    __syncthreads();
    float g0 = -INFINITY, g1 = -INFINITY, g2 = -INFINITY; int i0 = -1, i1 = -1, i2 = -1;
#pragma unroll 1
    for (int j = 0; j < qb; ++j) {
        float dot = 0.f;
#pragma unroll
        for (int d0 = 0; d0 < 4; ++d0) { const f32x4 ka = *(const LAS f32x4*)(KM + j * 64 + d0 * 16 + hi * 8), kb = *(const LAS f32x4*)(KM + j * 64 + d0 * 16 + hi * 8 + 4);
#pragma unroll
            for (int e = 0; e < 4; ++e) { dot += qf[8 * d0 + e] * ka[e]; dot += qf[8 * d0 + 4 + e] * kb[e]; } }
        { auto rr = __builtin_amdgcn_permlane32_swap(__float_as_uint(dot), __float_as_uint(dot), false, false); dot = __uint_as_float(rr[0]) + __uint_as_float(rr[1]); }
        if (dot > g0) { g2 = g1; i2 = i1; g1 = g0; i1 = i0; g0 = dot; i0 = j; } else if (dot > g1) { g2 = g1; i2 = i1; g1 = dot; i1 = j; } else if (dot > g2) { g2 = dot; i2 = j; }
    }
    unsigned selmask = 0u; if (i0 >= 0) selmask |= 1u << i0; if (i1 >= 0) selmask |= 1u << i1; if (i2 >= 0) selmask |= 1u << i2;
    att::BiasMoba B; B.slope2 = exp2f(-8.0f * (float)(7 + h) / 10.0f) * LOG2E; B.qrel = w * 32 + r32; B.tqf = (float)(qb * 256 + B.qrel); B.hi = hi; B.w = w; B.nb0 = 4 * qb; B.selmask = selmask; B.u = 32 * (w & 1) + r32 - 4 * hi;
    att::UnitIO io; io.Q = Qw; io.qstride = DM; io.K0 = A.K + bo + (size_t)b * SEQ * DM + h * 64; io.V0 = A.V + bo + (size_t)b * SEQ * DM + h * 64; io.kstride = DM;
    io.O = A.O + bo + row0 * DM + h * 64; io.ostride = DM; io.L = nullptr; io.lstride = 0; io.norm = true;
#ifdef PROBE_UNIT_OVH
    att::attn_tiles(shm, io, 4 * qb + 3, 4 * qb + 4, B, tid);
#endif
    att::attn_tiles(shm, io, 0, 4 * qb + 4, B, tid);
}
__device__ __forceinline__ void fox_unit(Frame& F, const AttnBufs& A, int b, int h, int qb) {
    char* shm = (char*)F.lds; const int tid = F.tid, lane = tid & 63, r32 = lane & 31, hi = lane >> 5, w = F.wave;
    LAS float* CS = (LAS float*)(F.lds + att::LDS_X); LAS float* WT = (LAS float*)(F.lds + att::LDS_X2);
    const int n = 256 * (qb + 1);
    const float* ls = A.LS + (size_t)(h - 4) * M + (size_t)b * SEQ;
    float v[8]; float run = 0.f;
    if (8 * tid < n) { const f32x4 a = *(const f32x4*)(ls + 8 * tid), c = *(const f32x4*)(ls + 8 * tid + 4);
        v[0] = a[0]; v[1] = a[1]; v[2] = a[2]; v[3] = a[3]; v[4] = c[0]; v[5] = c[1]; v[6] = c[2]; v[7] = c[3];
#pragma unroll
        for (int e = 0; e < 8; ++e) { run += v[e] * LOG2E; v[e] = run; } }
    else {
#pragma unroll
        for (int e = 0; e < 8; ++e) v[e] = 0.f; }
    float inc = run;
#pragma unroll
    for (int o = 1; o < 64; o <<= 1) { const float up = __shfl_up(inc, o); if (lane >= o) inc += up; }
    if (lane == 63) WT[w] = inc;
    __syncthreads();
    float woff = 0.f;
#pragma unroll
    for (int k = 0; k < 8; ++k) { const float tk = WT[k]; if (k < w) woff += tk; }
    const float excl = woff + inc - run;
    if (8 * tid < n) {
        *(LAS f32x4*)(CS + 8 * tid) = (f32x4){v[0] + excl, v[1] + excl, v[2] + excl, v[3] + excl}; *(LAS f32x4*)(CS + 8 * tid + 4) = (f32x4){v[4] + excl, v[5] + excl, v[6] + excl, v[7] + excl}; }
    __syncthreads();
    const int nb0 = 4 * qb; const float c_first = CS[qb * 256];
    int t_begin = 0;
    { bool skip = false; if (lane < nb0) skip = (c_first - CS[64 * lane + 63]) < -70.0f;
      const unsigned long long bm = __ballot(skip); t_begin = (int)__builtin_ctzll(~bm); if (t_begin > nb0) t_begin = nb0; }
    t_begin = __builtin_amdgcn_readfirstlane(t_begin);
    att::BiasFox B; B.cs2 = CS; B.qrel = w * 32 + r32; B.base = CS[qb * 256 + B.qrel]; B.hi = hi; B.w = w; B.nb0 = nb0; B.u = 32 * (w & 1) + r32 - 4 * hi;
    const size_t row0 = (size_t)b * SEQ + qb * 256 + w * 32;
    const size_t bo = (size_t)b * BADJ;
    att::UnitIO io; io.Q = A.Q + bo + row0 * DM + h * 64; io.qstride = DM; io.K0 = A.K + bo + (size_t)b * SEQ * DM + h * 64; io.V0 = A.V + bo + (size_t)b * SEQ * DM + h * 64; io.kstride = DM;
    io.O = A.O + bo + row0 * DM + h * 64; io.ostride = DM; io.L = nullptr; io.lstride = 0; io.norm = true;
#ifdef PROBE_UNIT_OVH
    att::attn_tiles(shm, io, nb0 + 3, nb0 + 4, B, tid);
#endif
    att::attn_tiles(shm, io, t_begin, nb0 + 4, B, tid);
}
__device__ __forceinline__ void dil_unit(Frame& F, const AttnBufs& A, int b, int h, int g, int r, int c) {
    char* shm = (char*)F.lds; const int tid = F.tid, lane = tid & 63, r32 = lane & 31, hi = lane >> 5, w = F.wave;
    const int dil = (g == 0) ? 1 : (g == 1 ? 4 : 16);
    const int i0 = 256 * c;
    att::BiasDil B; B.sd = exp2f(-8.0f * (float)(h - 10 + 1) / 10.0f) * LOG2E * (float)dil; B.qrel = 128 + w * 32 + r32; B.hi = hi; B.w = w; B.setup(r32);
    const long tok_q0 = (long)b * SEQ + r + (long)dil * (i0 + w * 32);
    const long tok_k0 = (long)b * SEQ + r + (long)dil * (i0 - 128);
    const long bo = (long)b * (long)BADJ;
    att::UnitIO io; io.Q = A.Q + bo + tok_q0 * DM + h * 64; io.qstride = (long)DM * dil; io.K0 = A.K + bo + tok_k0 * DM + h * 64; io.V0 = A.V + bo + tok_k0 * DM + h * 64; io.kstride = (long)DM * dil;
    io.O = A.OD + (size_t)g * OD_BRANCH + tok_q0 * 384 + (h - 10) * 64; io.ostride = (long)384 * dil; io.L = A.LD + (size_t)g * LD_BRANCH + tok_q0 * 8 + (h - 10); io.lstride = (long)8 * dil; io.norm = false;
#ifdef PROBE_UNIT_OVH
    att::attn_tiles(shm, io, 5, 6, B, tid);
#endif
    att::attn_tiles(shm, io, c == 0 ? 2 : 0, 6, B, tid);
}
__device__ __forceinline__ void attn_phase(Frame& F, const AttnBufs& A) {
#ifndef PROBE_DUP_ATT
#define PROBE_DUP_ATT 0
#endif
    const int g = F.vcu >> 5, r = F.vcu & 31;
    for (int rep = 0; rep < ((PROBE_DUP_ATT & 1) ? 2 : 1); ++rep)
    for (int k = 0; k < 2; ++k) { const int h = r >> 3, s = r & 7; moba_unit(F, A, g, h, k == 0 ? s : 15 - s); }
    for (int rep = 0; rep < ((PROBE_DUP_ATT & 2) ? 2 : 1); ++rep)
    for (int k = 0; k < 3; ++k) { const int idx = r + 32 * k, hf = idx >> 4, qb = ((idx & 15) + 5 * k) & 15; fox_unit(F, A, g, 4 + hf, qb); }
    for (int rep = 0; rep < ((PROBE_DUP_ATT & 4) ? 2 : 1); ++rep)
    for (int k = 0; k < 9; ++k) { const int idx = r + 32 * k, h6 = idx / 48, rest = idx % 48, br = rest >> 4, i16 = rest & 15;
        const int rr = (br == 0) ? 0 : (br == 1 ? (i16 >> 2) : i16), c = (br == 0) ? i16 : (br == 1 ? (i16 & 3) : 0);
        dil_unit(F, A, g, 10 + h6, br, rr, c); }
}
struct NormRow { v4u oa, oc, d0, d1, d2, ga, gc; float l0, l1, l2; };
__device__ __forceinline__ void norm_load(NormRow& R, int m, int lane, const bf16* O, const bf16* GF, const bf16* OD, const float* LD) {
    R.oa = *(const GAS v4u*)(O + (size_t)m * DM + 8 * lane);
    if (lane < 16) { R.oc = *(const GAS v4u*)(O + (size_t)m * DM + 512 + 8 * lane); R.gc = *(const GAS v4u*)(GF + (size_t)m * 384 + 256 + 8 * lane); }
    else { const int dc = 8 * lane - 128, hd = dc >> 6;
        R.d0 = *(const GAS v4u*)(OD + (size_t)m * 384 + dc); R.d1 = *(const GAS v4u*)(OD + OD_BRANCH + (size_t)m * 384 + dc); R.d2 = *(const GAS v4u*)(OD + 2 * OD_BRANCH + (size_t)m * 384 + dc);
        R.l0 = LD[(size_t)m * 8 + hd]; R.l1 = LD[LD_BRANCH + (size_t)m * 8 + hd]; R.l2 = LD[2 * LD_BRANCH + (size_t)m * 8 + hd]; }
    if (lane >= 32) R.ga = *(const GAS v4u*)(GF + (size_t)m * 384 + 8 * lane - 256);
}
__device__ __forceinline__ void norm_finish(const NormRow& R, int m, int lane, bf16* Y) {
    float fa[8], fc[8];
    unpack8(R.oa, fa);
    if (lane < 16) unpack8(R.oc, fc);
    else { float f0[8], f1[8], f2[8]; unpack8(R.d0, f0); unpack8(R.d1, f1); unpack8(R.d2, f2);
        const float inv = 1.0f / (R.l0 + R.l1 + R.l2);
#pragma unroll
        for (int e = 0; e < 8; ++e) fc[e] = (f0[e] + f1[e] + f2[e]) * inv; }
    float sa = 0.f, sc = 0.f;
#pragma unroll
    for (int e = 0; e < 8; ++e) { sa += fa[e] * fa[e]; sc += fc[e] * fc[e]; }
    const float s_moba = wave_sum(lane < 32 ? sa : 0.f), s_fox = wave_sum((lane >= 32 ? sa : 0.f) + (lane < 16 ? sc : 0.f)), s_dil = wave_sum(lane >= 16 ? sc : 0.f);
    const float r_moba = 1.0f / sqrtf(s_moba * (1.0f / 256.0f) + EPS), r_fox = 1.0f / sqrtf(s_fox * (1.0f / 384.0f) + EPS), r_dil = 1.0f / sqrtf(s_dil * (1.0f / 384.0f) + EPS);
    float ga[8], gc[8];
#pragma unroll
    for (int e = 0; e < 8; ++e) { ga[e] = 1.f; gc[e] = 1.f; }
    if (lane >= 32) unpack8(R.ga, ga);
    if (lane < 16) unpack8(R.gc, gc);
    const float ra = lane < 32 ? r_moba : r_fox, rc = lane < 16 ? r_fox : r_dil;
    v4u ya, yc;
    ya.x = pk2(fa[0] * ra * ga[0], fa[1] * ra * ga[1]); ya.y = pk2(fa[2] * ra * ga[2], fa[3] * ra * ga[3]); ya.z = pk2(fa[4] * ra * ga[4], fa[5] * ra * ga[5]); ya.w = pk2(fa[6] * ra * ga[6], fa[7] * ra * ga[7]);
    yc.x = pk2(fc[0] * rc * gc[0], fc[1] * rc * gc[1]); yc.y = pk2(fc[2] * rc * gc[2], fc[3] * rc * gc[3]); yc.z = pk2(fc[4] * rc * gc[4], fc[5] * rc * gc[5]); yc.w = pk2(fc[6] * rc * gc[6], fc[7] * rc * gc[7]);
    *(GAS v4u*)(Y + (size_t)m * DM + 8 * lane) = ya; *(GAS v4u*)(Y + (size_t)m * DM + 512 + 8 * lane) = yc;
}
__device__ __forceinline__ void norm_phase(Frame& F, const bf16* O, const bf16* GF, const bf16* OD, const float* LD, bf16* Y) {
    const int g = F.vcu >> 5, r = F.vcu & 31, lane = F.lane;
    const int base = g * SEQ + ((r & 7) + ((r >> 4) << 3)) * 256 + ((r >> 3) & 1) * 128 + F.wave * 16;
#pragma unroll 1
    for (int j = 0; j < 16; j += 4) {
        const int m = base + j;
        NormRow R0, R1, R2, R3;
        norm_load(R0, m, lane, O, GF, OD, LD); norm_load(R1, m + 1, lane, O, GF, OD, LD); norm_load(R2, m + 2, lane, O, GF, OD, LD); norm_load(R3, m + 3, lane, O, GF, OD, LD);
        norm_finish(R0, m, lane, Y); norm_finish(R1, m + 1, lane, Y); norm_finish(R2, m + 2, lane, Y); norm_finish(R3, m + 3, lane, Y);
    }
}
__device__ __forceinline__ void group_barrier(unsigned* cnt, volatile LAS unsigned* epoch  , volatile LAS unsigned* fast, const unsigned nwg, int tid) {
    asm volatile("s_waitcnt vmcnt(0)" ::: "memory");
    __syncthreads();
    if (tid == 0) {
        if (fast[0] == 0u) __builtin_amdgcn_fence(__ATOMIC_RELEASE, "agent");
        asm volatile("s_waitcnt vmcnt(0)" ::: "memory");
        const unsigned e = epoch[0] + 1u; epoch[0] = e; const unsigned target = nwg * e;
        (void)__hip_atomic_fetch_add(cnt, 1u, __ATOMIC_RELAXED, __HIP_MEMORY_SCOPE_AGENT);
        unsigned sp = 0;
        while (__hip_atomic_load(cnt, __ATOMIC_RELAXED, __HIP_MEMORY_SCOPE_AGENT) < target) { __builtin_amdgcn_s_sleep(1); if (++sp > (1u << 22)) break; }
        __builtin_amdgcn_fence(__ATOMIC_ACQUIRE, "agent");
        asm volatile("s_waitcnt vmcnt(0)" ::: "memory");
    }
    __syncthreads();
}

struct Args { const float* in[11]; float* out; unsigned char* ws; int ph_lo, ph_hi; };
__global__ void __launch_bounds__(NWAVES * 64, 2) mk_fwd(Args args) {
    __shared__ __attribute__((aligned(16))) unsigned char lds[LDS_BYTES];
    for (int u = threadIdx.x; u < (LDS_BYTES - LDSCTL_OFF) / 4; u += NWAVES * 64) ((LAS unsigned*)((LAS unsigned char*)lds + LDSCTL_OFF))[u] = 0u;
    __syncthreads();
    const int lo = args.ph_lo, hi = args.ph_hi;
    const int wave_id0 = __builtin_amdgcn_readfirstlane((int)threadIdx.x >> 6);
    XcdBarrier bar; bar.bar = (unsigned*)(args.ws + WS_CTL) + CW_BAR; bar.x = 0; bar.st = nullptr;
    if (hi - lo > 1) bar = xcd_barrier_post((unsigned*)(args.ws + WS_CTL) + CW_BAR, (volatile LAS unsigned*)((LAS unsigned char*)lds + MISC_OFF) + 8);
#ifndef PROBE_DUP_PHASE
#define PROBE_DUP_PHASE -1
#endif
    int dup_left = 1;
#pragma unroll 1
    for (int ph = lo; ph < hi; ++ph) {
        const int ph_exec = ph;
        unsigned char* ws = args.ws; asm volatile("" : "+s"(ws));
        int wv_ = wave_id0; asm volatile("" : "+s"(wv_));
        int tid_ = (wv_ << 6) | (int)__builtin_amdgcn_mbcnt_hi(~0u, __builtin_amdgcn_mbcnt_lo(~0u, 0u)); asm volatile("" : "+v"(tid_));
        int bid_ = blockIdx.x, G_ = gridDim.x; asm volatile("" : "+s"(bid_), "+s"(G_));
        Frame F;
        F.lds = (LAS unsigned char*)lds;
        F.MISC = (volatile LAS unsigned*)(F.lds + MISC_OFF);
        F.tid = tid_; F.lane = F.tid & 63; F.wave = __builtin_amdgcn_readfirstlane(F.tid >> 6);
        F.G = G_; F.vcu = (F.G % 8 == 0) ? (bid_ % 8) * (F.G / 8) + bid_ / 8 : bid_;
        F.ctl = (gu32*)(ws + WS_CTL);
        Ptrs P;
        P.x = args.in[0]; P.attn_norm = args.in[1]; P.w_in = args.in[2]; P.b_forget = args.in[3]; P.q_gain = args.in[4]; P.k_gain = args.in[5];
        P.out_gain = args.in[6]; P.w_out = args.in[7]; P.mlp_norm = args.in[8]; P.w_up = args.in[9]; P.w_down = args.in[10]; P.out = args.out; P.ws = ws;
        PG8_LAS float* tab = (PG8_LAS float*)(F.lds + pg8::TAB_OFF);
        if (ph == 0) {
            if (F.tid == 0) __hip_atomic_store((unsigned*)(ws + WS_CTL) + CW_XCC + F.vcu, ((unsigned)__builtin_amdgcn_s_getreg((3 << 11) | 20) & 0xFu) + 1u, __ATOMIC_RELAXED, __HIP_MEMORY_SCOPE_AGENT);
            p0_prologue(F, P); }
        else {
            const int l = (ph - 1) / 6, k = (ph - 1) % 6;
            unsigned char* wl = ws + WS_W + (size_t)l * W_LAYER;
            bf16* XB = (bf16*)(ws + WS_XB);
            if (k == 0) {
                pg8::Gemm g{XB, (const bf16*)(wl + W_IN), M, NINP, DM, DM, 0}; pg8::StaticOrder S; S.init(M, NINP, F.G, bid_);
                pg8::EpiIn E{ws, P.b_forget + l * 6, tab};
                pg8::prep_tables(S, tab, ws, P.q_gain + l * 1024, P.k_gain + l * 1024, F.tid); __syncthreads();
                pg8::gemm_phase<pg8::EpiIn, pg8::StaticOrder, true, true>(F.lds + RING_OFF, g, S, E, F.tid);
            } else if (k == 1) {
                const AttnBufs AB{(const bf16*)(ws + WS_QKVO), (const bf16*)(ws + WS_QKVO + QKVO_K), (const bf16*)(ws + WS_QKVO + QKVO_V), (bf16*)(ws + WS_QKVO + QKVO_O), (bf16*)(ws + WS_OD), (float*)(ws + WS_LD), (const float*)(ws + WS_LS), (const float*)(ws + WS_KMP)};
                attn_phase(F, AB);
            } else if (k == 2) {
                unsigned char* qb_ = ws + WS_QKVO + (size_t)(F.vcu >> 5) * QKVO_BATCH_ADJ;
                norm_phase(F, (const bf16*)(qb_ + QKVO_O), (const bf16*)(ws + WS_GF), (const bf16*)(ws + WS_OD), (const float*)(ws + WS_LD), (bf16*)qb_);
            } else if (k == 4) {
                pg8::Gemm g{XB, (const bf16*)(wl + W_UP), M, FF, DM, DM, 0}; pg8::StaticOrder S; S.init(M, FF, F.G, bid_);
#ifdef PROBE_EPI_UP
                pg8::EpiUp E{ws, tab, (ph == PROBE_DUP_PHASE && dup_left == 1) ? PROBE_EPI_UP : 0};
#else
                pg8::EpiUp E{ws, tab, 0};
#endif
                pg8::prep_tables(S, tab, ws, nullptr, nullptr, F.tid); __syncthreads();
                pg8::gemm_phase<pg8::EpiUp, pg8::StaticOrder, true, true>(F.lds + RING_OFF, g, S, E, F.tid);
            } else {
                const bool dn = (k == 5);
                pg8::Gemm g{(const bf16*)(ws + WS_QKVO + (size_t)(F.vcu >> 5) * QKVO_BATCH_ADJ), (const bf16*)(wl + (dn ? W_DOWN : W_OUT)), M, DM, dn ? FF : DM, DM, (long)(8 * MiB) - 2048};
                pg8::StaticOrder S; S.init(M, DM, F.G, bid_);
                pg8::EpiRes E{P.out, ws, ph == NPH - 1};
                pg8::gemm_phase<pg8::EpiRes, pg8::StaticOrder, true, true>(F.lds + RING_OFF, g, S, E, F.tid);
            }
        }
        if (ph == PROBE_DUP_PHASE && dup_left > 0) { --dup_left; --ph; }
        if (ph + 1 < hi) {
            if (ph_exec == 0 || F.G != 256) { XcdBarrier b2 = bar; asm volatile("" : "+s"(b2.bar)); xcd_barrier(b2, F.tid);
#ifndef GROUP_STAGGER
#define GROUP_STAGGER 0
#endif
#ifndef NO_XCD_FAST
                if (F.G == 256 && F.tid < 64) {
                    const unsigned mine = ((unsigned)__builtin_amdgcn_s_getreg((3 << 11) | 20) & 0xFu) + 1u;
                    const unsigned v = __hip_atomic_load((unsigned*)(ws + WS_CTL) + CW_XCC + (F.vcu & ~31) + (F.tid & 31), __ATOMIC_RELAXED, __HIP_MEMORY_SCOPE_AGENT);
                    const unsigned long long eq = __ballot(v == mine);
                    if (F.tid == 0) F.MISC[11] = (eq == ~0ull) ? 1u : 0u; }
#endif
                if (GROUP_STAGGER > 0 && F.G == 256) { const unsigned long long t0 = __builtin_amdgcn_s_memrealtime(); const unsigned long long dl = (unsigned long long)(F.vcu >> 5) * GROUP_STAGGER;
                    while (__builtin_amdgcn_s_memrealtime() - t0 < dl) __builtin_amdgcn_s_sleep(8); } }
            else {
                const int kk = (ph_exec - 1) % 6;
                if (kk >= 2) { unsigned* qc = (unsigned*)(ws + WS_CTL) + CW_QBAR + 64 * ((F.vcu >> 5) * 8 + (F.vcu & 7)); group_barrier(qc, F.MISC + 12, F.MISC + 11, 4u, F.tid); }
                else { unsigned* gc = (unsigned*)(ws + WS_CTL) + CW_GBAR + 64 * (F.vcu >> 5); group_barrier(gc, F.MISC + 10, F.MISC + 11, 32u, F.tid); }
            }
        }
    }
}

extern "C" void kernel_launch(void* const* d_in, const int* in_sizes, int n_in, void* d_out, int out_size, void* d_ws, size_t ws_size, hipStream_t stream) {
    static int grid = 0;
    if (grid == 0) {
        if (n_in != 11 || in_sizes[0] != M * DM || out_size != M * DM || ws_size < WS_END) { fprintf(stderr, "kernel_launch: unexpected shapes (n_in %d in0 %d out %d ws %zu)\n", n_in, n_in > 0 ? in_sizes[0] : -1, out_size, ws_size); grid = -1; return; }
        int dev = 0, cus = 0, per_cu = 0;
        if (hipGetDevice(&dev) != hipSuccess || hipDeviceGetAttribute(&cus, hipDeviceAttributeMultiprocessorCount, dev) != hipSuccess) { grid = -1; return; }
        if (hipOccupancyMaxActiveBlocksPerMultiprocessor(&per_cu, (const void*)mk_fwd, NWAVES * 64, 0) != hipSuccess || per_cu < 1) { fprintf(stderr, "kernel_launch: occupancy query says %d blocks per CU\n", per_cu); (void)hipGetLastError(); grid = -1; return; }
        if (cus != 256) { fprintf(stderr, "kernel_launch: built for a 256-CU device (8 groups of 32 workgroups, one batch element each); found %d CUs\n", cus); grid = -1; return; }
        grid = cus;
    }
    if (grid < 0) return;
    (void)hipMemsetAsync((char*)d_ws + WS_CTL, 0, CTL_ZERO_BYTES, stream);
    Args a{};
    for (int i = 0; i < 11; ++i) a.in[i] = (const float*)d_in[i];
    a.out = (float*)d_out; a.ws = (unsigned char*)d_ws;
#if MK_ONE_LAUNCH
    a.ph_lo = 0; a.ph_hi = NPH;
    hipLaunchKernelGGL(mk_fwd, dim3(grid), dim3(NWAVES * 64), 0, stream, a);
#else
    for (int p = 0; p < NPH; ++p) { a.ph_lo = p; a.ph_hi = p + 1; hipLaunchKernelGGL(mk_fwd, dim3(grid), dim3(NWAVES * 64), 0, stream, a); }
#endif
}
```
